# Optimizing an MI355X kernel written in HIP

```python
import math
import jax, jax.numpy as jnp
from jax import lax
import numpy as np

D_MODEL = 1024
BATCH = 8
SEQ = 2048
DEPTH = 4

CHUNK = 64
N_META = 16
N_MIXERS = 2
N_FOX = (DEPTH + 1) // 2
N_RWKV = DEPTH // 2
D_INNER = D_MODEL
FOX_HEAD_DIM = 64
FOX_HEADS = D_INNER // FOX_HEAD_DIM
Q_BLOCK = 128
FOX_IN = 4 * D_INNER + FOX_HEADS
RWKV_HEAD = 64
RWKV_HEADS = D_INNER // RWKV_HEAD
LORA_W = 64
LORA_A = 64
RWKV_IN = 4 * D_INNER + LORA_W + LORA_A
NORM_EPS = 1e-6
GN_EPS = 64e-5
DECAY_SCALE = math.exp(-0.5)

kernel_name = 'fox_rwkv7_meta_hybrid'


def _rmsnorm(x, g):
    xf = x.astype(jnp.float32)
    y = xf * lax.rsqrt(jnp.mean(xf * xf, axis=-1, keepdims=True) + NORM_EPS)
    return (y * g.astype(jnp.float32)).astype(x.dtype)


def _heads(t, n_heads, head_dim):
    B, L, _ = t.shape
    return t.reshape(B, L, n_heads, head_dim).transpose(0, 2, 1, 3)


def _fox_mixer(u, w_in, b_f, w_out):
    B, L, _ = u.shape
    p = u @ w_in
    q, k, v, gate, f_logit = jnp.split(p, [D_INNER, 2 * D_INNER, 3 * D_INNER, 4 * D_INNER], axis=-1)
    q = _heads(q, FOX_HEADS, FOX_HEAD_DIM) * (FOX_HEAD_DIM ** -0.5)
    k = _heads(k, FOX_HEADS, FOX_HEAD_DIM)
    v = _heads(v, FOX_HEADS, FOX_HEAD_DIM)
    log_f = jax.nn.log_sigmoid((f_logit + b_f).astype(jnp.float32))
    cum = jnp.cumsum(log_f, axis=1).transpose(0, 2, 1)
    outs = []
    for start in range(0, L, Q_BLOCK):
        stop = min(start + Q_BLOCK, L)
        logits = jnp.einsum('bhqd,bhkd->bhqk', q[:, :, start:stop], k[:, :, :stop]).astype(jnp.float32)
        logits = logits + cum[:, :, start:stop, None] - cum[:, :, None, :stop]
        causal = jnp.arange(stop)[None, :] <= jnp.arange(start, stop)[:, None]
        logits = jnp.where(causal, logits, -jnp.inf)
        prob = jax.nn.softmax(logits, axis=-1).astype(v.dtype)
        outs.append(jnp.einsum('bhqk,bhkd->bhqd', prob, v[:, :, :stop]))
    o = jnp.concatenate(outs, axis=2).transpose(0, 2, 1, 3).reshape(B, L, D_INNER)
    return (o * jax.nn.silu(gate)) @ w_out


def _wkv7_scan(r, decay, k, v, a_vec, b_vec):
    B, L, H, N = r.shape

    def step(S, inp):
        r_t, w_t, k_t, v_t, a_t, b_t = inp
        sa = jnp.einsum('bhvk,bhk->bhv', S, a_t)
        S = S * w_t[:, :, None, :] + sa[..., None] * b_t[:, :, None, :] + v_t[..., None] * k_t[:, :, None, :]
        return S, jnp.einsum('bhvk,bhk->bhv', S, r_t)

    seq = tuple(jnp.moveaxis(t, 1, 0) for t in (r, decay, k, v, a_vec, b_vec))
    S0 = jnp.zeros((B, H, N, N), jnp.float32)
    _, y = lax.scan(step, S0, seq)
    return jnp.moveaxis(y, 0, 1)


def _rwkv7_mixer(u, w_in, mu, w0, w_up, a0, a_up, k_k, k_a, r_k, ln_w, ln_b, w_out):
    B, L, _ = u.shape
    f32 = jnp.float32
    p = u @ w_in
    p_prev = jnp.pad(p, ((0, 0), (1, 0), (0, 0)))[:, :L]
    p = p + (p_prev - p) * mu
    r, k, v, gate, wd, ad = jnp.split(
        p, [D_INNER, 2 * D_INNER, 3 * D_INNER, 4 * D_INNER, 4 * D_INNER + LORA_W], axis=-1)
    w_log = (w0 + jnp.tanh(wd) @ w_up).astype(f32)
    decay = jnp.exp(-DECAY_SCALE * jax.nn.sigmoid(w_log))
    a = jax.nn.sigmoid((a0 + ad @ a_up).astype(f32))
    r = r.astype(f32)
    k = k.astype(f32)
    v = v.astype(f32)
    hs = lambda t: t.reshape(B, L, RWKV_HEADS, RWKV_HEAD)
    kk = hs(k * k_k.astype(f32))
    kk = kk / jnp.maximum(jnp.linalg.norm(kk, axis=-1, keepdims=True), 1e-12)
    k = k * (1.0 + (a - 1.0) * k_a.astype(f32))
    r_h, k_h, v_h = hs(r), hs(k), hs(v)
    y = _wkv7_scan(r_h, hs(decay), k_h, v_h, -kk, kk * hs(a))
    mean = jnp.mean(y, axis=-1, keepdims=True)
    var = jnp.mean(jnp.square(y - mean), axis=-1, keepdims=True)
    y = (y - mean) * lax.rsqrt(var + GN_EPS)
    y = y * ln_w.astype(f32).reshape(RWKV_HEADS, RWKV_HEAD) + ln_b.astype(f32).reshape(RWKV_HEADS, RWKV_HEAD)
    bonus = jnp.sum(r_h * k_h * r_k.astype(f32), axis=-1, keepdims=True) * v_h
    y = (y + bonus).reshape(B, L, D_INNER).astype(u.dtype)
    return (y * jax.nn.silu(gate)) @ w_out


def setup_inputs(seed: int = 0) -> dict:
    key = jax.random.key(seed)
    ks = jax.random.split(key, 20)
    f32 = jnp.float32
    D = D_MODEL
    nrm = lambda kk, shape, s: jax.random.normal(kk, shape, f32) * s
    return {
        'x': nrm(ks[0], (BATCH, SEQ, D), 1.0),
        'meta_tokens': nrm(ks[1], (N_META, D), 1.0),
        'norm_pre': 1.0 + nrm(ks[2], (DEPTH, D), 0.02),
        'norm_post': 1.0 + nrm(ks[3], (DEPTH, D), 0.02),
        'fox_w_in': nrm(ks[4], (N_FOX, D, FOX_IN), D ** -0.5),
        'fox_b_f': jax.random.uniform(ks[5], (N_FOX, FOX_HEADS), f32, 1.0, 5.0),
        'fox_w_out': nrm(ks[6], (N_FOX, D_INNER, D), D_INNER ** -0.5),
        'rwkv_w_in': nrm(ks[7], (N_RWKV, D, RWKV_IN), D ** -0.5),
        'rwkv_mu': jax.random.uniform(ks[8], (N_RWKV, RWKV_IN), f32, 0.0, 1.0),
        'rwkv_w0': -0.5 + nrm(ks[9], (N_RWKV, D_INNER), 0.5),
        'rwkv_w_up': nrm(ks[10], (N_RWKV, LORA_W, D_INNER), 0.5 * LORA_W ** -0.5),
        'rwkv_a0': nrm(ks[11], (N_RWKV, D_INNER), 0.1),
        'rwkv_a_up': nrm(ks[12], (N_RWKV, LORA_A, D_INNER), 0.5 * LORA_A ** -0.5),
        'rwkv_k_k': 0.85 + nrm(ks[13], (N_RWKV, D_INNER), 0.05),
        'rwkv_k_a': 1.0 + nrm(ks[14], (N_RWKV, D_INNER), 0.05),
        'rwkv_r_k': nrm(ks[15], (N_RWKV, RWKV_HEADS, RWKV_HEAD), 0.1),
        'rwkv_ln_w': 1.0 + nrm(ks[16], (N_RWKV, D_INNER), 0.02),
        'rwkv_ln_b': nrm(ks[17], (N_RWKV, D_INNER), 0.02),
        'rwkv_w_out': nrm(ks[18], (N_RWKV, D_INNER, D), D_INNER ** -0.5),
    }


def reference(x, meta_tokens, norm_pre, norm_post, fox_w_in, fox_b_f, fox_w_out,
              rwkv_w_in, rwkv_mu, rwkv_w0, rwkv_w_up, rwkv_a0, rwkv_a_up, rwkv_k_k,
              rwkv_k_a, rwkv_r_k, rwkv_ln_w, rwkv_ln_b, rwkv_w_out):
    B = x.shape[0]
    meta = jnp.broadcast_to(meta_tokens[None].astype(x.dtype), (B, N_META, D_MODEL))
    h = jnp.concatenate([meta, x], axis=1)
    for i in range(DEPTH):
        j = i // N_MIXERS
        u = _rmsnorm(h, norm_pre[i])
        if i % N_MIXERS == 0:
            m = _fox_mixer(u, fox_w_in[j], fox_b_f[j], fox_w_out[j])
        else:
            m = _rwkv7_mixer(u, rwkv_w_in[j], rwkv_mu[j], rwkv_w0[j], rwkv_w_up[j], rwkv_a0[j],
                             rwkv_a_up[j], rwkv_k_k[j], rwkv_k_a[j], rwkv_r_k[j], rwkv_ln_w[j],
                             rwkv_ln_b[j], rwkv_w_out[j])
        h = h + _rmsnorm(m, norm_post[i])
    return h[:, N_META:]
```

```cpp
#include <hip/hip_runtime.h>
#include <hip/hip_cooperative_groups.h>
#include <cstdio>
#include <cstdint>
namespace cg = cooperative_groups;
__device__ __forceinline__ int opaque_tid() { int t = threadIdx.x; asm volatile("" : "+v"(t)); return t; }
__device__ __forceinline__ int opaque_bid() { int t = blockIdx.x; asm volatile("" : "+s"(t)); return t; }
__device__ __forceinline__ int opaque_grid() { int t = gridDim.x; asm volatile("" : "+s"(t)); return t; }
namespace pg8 {
#define PG8_LAS __attribute__((address_space(3)))
typedef unsigned short bf16_t;
typedef short bf16x8 __attribute__((ext_vector_type(8)));
typedef float f32x4 __attribute__((ext_vector_type(4)));
typedef unsigned u32x4 __attribute__((ext_vector_type(4)));
constexpr int BM = 256, BK = 64, HALF = 128, HTB = HALF * BK * 2  , STAGE_BYTES = 8 * HTB, NXCD = 8, WGM = 8;

__host__ __device__ __forceinline__ int lds_byte(int r, int c) { const int st = (r >> 4) * 2 + (c >> 5), rr = r & 15, cc = c & 31, ob = rr * 64 + cc * 2; return st * 1024 + (ob ^ (((ob >> 9) & 1) << 5)); }
__host__ __device__ __forceinline__ void stage_rc(int b, int& R, int& C) { const int st = b / 1024, sb = b % 1024, swz = sb ^ (((sb >> 9) & 1) << 5); R = (st >> 1) * 16 + swz / 64; C = (st & 1) * 32 + (swz % 64) / 2; }
__host__ __device__ __forceinline__ int perm32(int rho) { const int n = rho >> 4, i = rho & 15; return 8 * (i >> 2) + 4 * n + (i & 3); }

struct Unit { int pm, pn; };
struct Gemm { const bf16_t* A; const bf16_t* Bt; int M, N, K; };

struct StaticOrder {
    int nM, nN, nwg, G, c;
    __host__ __device__ void init(int M, int N, int G_, int c_) { nM = M / BM; nN = N / BM; nwg = nM * nN; G = G_; c = c_; }
    __host__ __device__ bool next(int i, Unit& u) const {
        const long L = (long)i * G + c; if (L >= nwg) return false;
        int wgid = (int)L; { const int q = nwg / NXCD, r = nwg % NXCD, xcd = wgid % NXCD, off = wgid / NXCD; wgid = (xcd < r ? xcd * (q + 1) : r * (q + 1) + (xcd - r) * q) + off; }
        const int nig = WGM * nN, gid = wgid / nig, fm = gid * WGM, gsz = (nM - fm) < WGM ? (nM - fm) : WGM;
        u.pm = fm + ((wgid % nig) % gsz); u.pn = (wgid % nig) / gsz; return true;
    }
    __device__ __forceinline__ void a_ready(const Unit&) const {}
    __device__ __forceinline__ void done(const Unit&) const {}
};

__device__ __forceinline__ unsigned cvt_pk_bf16(float lo, float hi) { unsigned r; asm volatile("v_cvt_pk_bf16_f32 %0, %1, %2" : "=v"(r) : "v"(lo), "v"(hi)); return r; }
typedef float f32x2 __attribute__((ext_vector_type(2)));
typedef __bf16 bf16x2_t __attribute__((ext_vector_type(2)));
__device__ __forceinline__ unsigned pk2(float lo, float hi) { f32x2 v = {lo, hi}; bf16x2_t b = __builtin_convertvector(v, bf16x2_t); return __builtin_bit_cast(unsigned, b); }
struct EpiP {
    static constexpr bool PERM = true, AFTER_DRAIN = false;
    bf16_t* P; bf16_t* PL; float qscale; int qcols;
    __device__ __forceinline__ void operator()(const f32x4 (&acc)[2][2][4][2], const Unit& u, int wr, int wc, int fr, int fq) const {
        const int row0 = u.pm * BM + wr * 64 + fr; const int colt = u.pn * BM;
        bf16_t* base; int ldc, c0;
        if (colt < 4096) { base = P; ldc = 4096; c0 = colt; } else { base = PL; ldc = 256; c0 = colt - 4096; }
        const float sc = (colt < qcols) ? qscale : 1.f;
        const int col0 = c0 + wc * 32 + 8 * fq;
#pragma unroll
        for (int ai = 0; ai < 2; ++ai)
#pragma unroll
            for (int m = 0; m < 4; ++m) { bf16_t* rowp = base + (size_t)(row0 + ai * HALF + m * 16) * ldc + col0;
#pragma unroll
                for (int bj = 0; bj < 2; ++bj) { const f32x4 v0 = acc[ai][bj][m][0] * sc, v1 = acc[ai][bj][m][1] * sc;
                    u32x4 w; w.x = pk2(v0[0], v0[1]); w.y = pk2(v0[2], v0[3]); w.z = pk2(v1[0], v1[1]); w.w = pk2(v1[2], v1[3]);
                    *(u32x4*)(rowp + bj * HALF) = w; } }
    }
};
struct EpiF32 {
    static constexpr bool PERM = false, AFTER_DRAIN = false;
    float* O; int ldc;
    __device__ __forceinline__ void operator()(const f32x4 (&acc)[2][2][4][2], const Unit& u, int wr, int wc, int fr, int fq) const {
        const int row0 = u.pm * BM + wr * 64 + fr; const int col0 = u.pn * BM + wc * 32 + 4 * fq;
#pragma unroll
        for (int ai = 0; ai < 2; ++ai)
#pragma unroll
            for (int m = 0; m < 4; ++m) { float* rowp = O + (size_t)(row0 + ai * HALF + m * 16) * ldc + col0;
#pragma unroll
                for (int bj = 0; bj < 2; ++bj)
#pragma unroll
                    for (int n = 0; n < 2; ++n) *(f32x4*)(rowp + bj * HALF + n * 16) = acc[ai][bj][m][n]; }
    }
};
template <class Epi, class Sched, bool ALIGN_EPI = false, bool SP2 = false>
__device__ __forceinline__ void gemm_phase(PG8_LAS unsigned char* lds, const Gemm g, const Sched& S, const Epi& E) {
    const int tid = opaque_tid(), wid = __builtin_amdgcn_readfirstlane(tid >> 6), lane = tid & 63, wr = wid >> 2, wc = wid & 3, fr = lane & 15, fq = lane >> 4;
    const int K = g.K, nt = K / BK;
    unsigned voffA[2], voffB[2];
#pragma unroll
    for (int i = 0; i < 2; ++i) { int R, C; stage_rc(tid * 16 + i * 8192, R, C); const int Rb = Epi::PERM ? ((R & ~31) + perm32(R & 31)) : R;
        voffA[i] = (unsigned)(R * K + C) * 2u; voffB[i] = (unsigned)(Rb * K + C) * 2u; }
    const size_t kstep = (size_t)(BK * 2);
    const size_t hstep = (size_t)HALF * K * 2;
    const size_t tstep = 2 * hstep;
    const unsigned ldsw = (unsigned)wid * 1024u;
    const int aoff = lds_byte(wr * 64 + fr, fq * 8), boff = lds_byte(wc * 32 + fr, fq * 8);
#define PG8_SA(b, h) (((b) * 2 + (h)) * HTB)
#define PG8_SB(b, h) ((4 + (b) * 2 + (h)) * HTB)
#define PG8_STAGE(bufoff, gbase, voff) do { _Pragma("unroll") for (int _i = 0; _i < 2; ++_i) \
        __builtin_amdgcn_global_load_lds((const unsigned*)((const char*)(gbase) + (voff)[_i]), (PG8_LAS unsigned*)(lds + (bufoff) + ldsw + _i * 8192), 16, 0, 0); } while (0)
#define PG8_LDA(dst, b, h) do { _Pragma("unroll") for (int m = 0; m < 4; ++m) _Pragma("unroll") for (int k = 0; k < 2; ++k) dst[m][k] = *(const PG8_LAS bf16x8*)(lds + PG8_SA(b, h) + aoff + m * 2048 + k * 1024); } while (0)
#define PG8_LDB(dst, b, h) do { _Pragma("unroll") for (int n = 0; n < 2; ++n) _Pragma("unroll") for (int k = 0; k < 2; ++k) dst[n][k] = *(const PG8_LAS bf16x8*)(lds + PG8_SB(b, h) + boff + n * 2048 + k * 1024); } while (0)
#define PG8_MMA(ai, bj, At, Bt) do { __builtin_amdgcn_s_setprio(1); _Pragma("unroll") for (int m = 0; m < 4; ++m) _Pragma("unroll") for (int n = 0; n < 2; ++n) _Pragma("unroll") for (int k = 0; k < 2; ++k) \
        acc[ai][bj][m][n] = __builtin_amdgcn_mfma_f32_16x16x32_bf16(Bt[n][k], At[m][k], acc[ai][bj][m][n], 0, 0, 0); __builtin_amdgcn_s_setprio(0); } while (0)
#define PG8_WAIT_V(n) asm volatile("s_waitcnt vmcnt(" #n ")" ::: "memory")
#define PG8_WAIT_L(n) asm volatile("s_waitcnt lgkmcnt(" #n ")" ::: "memory")
#define PG8_BAR __builtin_amdgcn_s_barrier()
#define PG8_SCHED __builtin_amdgcn_sched_barrier(0)
    Unit cur, nxt; int ui = 0;
    if (!S.next(0, cur)) return;
    f32x4 acc[2][2][4][2];
#pragma unroll
    for (int a = 0; a < 2; ++a)
#pragma unroll
        for (int b = 0; b < 2; ++b)
#pragma unroll
            for (int m = 0; m < 4; ++m)
#pragma unroll
                for (int n = 0; n < 2; ++n) acc[a][b][m][n] = (f32x4){0.f, 0.f, 0.f, 0.f};
    bf16x8 At[4][2], B0[2][2], B1[2][2];
    const char* cA = (const char*)g.A + (size_t)cur.pm * tstep; const char* cB = (const char*)g.Bt + (size_t)cur.pn * tstep;
    S.a_ready(cur);
    if constexpr (SP2) {
        PG8_STAGE(PG8_SB(0, 0), cB, voffB); PG8_STAGE(PG8_SB(0, 1), cB + hstep, voffB); PG8_STAGE(PG8_SA(0, 0), cA, voffA); PG8_STAGE(PG8_SA(0, 1), cA + hstep, voffA);
        if (wr == 1) PG8_BAR;
        PG8_WAIT_V(2); PG8_BAR;
        PG8_STAGE(PG8_SB(1, 0), cB + kstep, voffB); PG8_STAGE(PG8_SA(1, 0), cA + kstep, voffA); PG8_STAGE(PG8_SB(1, 1), cB + hstep + kstep, voffB);
        PG8_WAIT_V(6); PG8_BAR;
    } else {
        PG8_STAGE(PG8_SB(0, 0), cB, voffB); PG8_STAGE(PG8_SA(0, 0), cA, voffA); PG8_STAGE(PG8_SB(0, 1), cB + hstep, voffB); PG8_STAGE(PG8_SA(0, 1), cA + hstep, voffA);
        if (wr == 1) PG8_BAR;
        PG8_WAIT_V(4); PG8_BAR;
        PG8_STAGE(PG8_SB(1, 0), cB + kstep, voffB); PG8_STAGE(PG8_SA(1, 0), cA + kstep, voffA); PG8_STAGE(PG8_SB(1, 1), cB + hstep + kstep, voffB);
        PG8_WAIT_V(6); PG8_BAR;
    }
    for (;;) {
        const bool has_next = S.next(ui + 1, nxt);
        const char* nA = has_next ? (const char*)g.A + (size_t)nxt.pm * tstep : cA; const char* nB = has_next ? (const char*)g.Bt + (size_t)nxt.pn * tstep : cB;
        for (int t = 0; t < nt; t += 2) {
            const bool last = (t == nt - 2);
            const char* a1 = cA + (size_t)(t + 1) * kstep;
            const char* a2 = last ? nA : cA + (size_t)(t + 2) * kstep; const char* b2 = last ? nB : cB + (size_t)(t + 2) * kstep;
            const char* a3 = a2 + kstep; const char* b3 = b2 + kstep;
            if (last && has_next) S.a_ready(nxt);
            if constexpr (SP2) {
            PG8_LDB(B0, 0, 0); PG8_LDB(B1, 0, 1); PG8_SCHED; PG8_LDA(At, 0, 0); PG8_STAGE(PG8_SA(1, 1), a1 + hstep, voffA);
            PG8_WAIT_V(8); PG8_WAIT_L(0); PG8_BAR; PG8_MMA(0, 0, At, B0); PG8_MMA(0, 1, At, B1); PG8_BAR; PG8_SCHED;
            PG8_LDA(At, 0, 1); PG8_STAGE(PG8_SB(0, 0), b2, voffB); PG8_STAGE(PG8_SB(0, 1), b2 + hstep, voffB); PG8_STAGE(PG8_SA(0, 0), a2, voffA);
            PG8_WAIT_V(8); PG8_WAIT_L(0); PG8_BAR; PG8_MMA(1, 0, At, B0); PG8_MMA(1, 1, At, B1); PG8_BAR; PG8_SCHED;
            PG8_LDB(B0, 1, 0); PG8_LDB(B1, 1, 1); PG8_SCHED; PG8_LDA(At, 1, 0); PG8_STAGE(PG8_SA(0, 1), a2 + hstep, voffA);
            PG8_WAIT_V(8); PG8_WAIT_L(0); PG8_BAR; PG8_MMA(0, 0, At, B0); PG8_MMA(0, 1, At, B1); PG8_BAR; PG8_SCHED;
            PG8_LDA(At, 1, 1); PG8_STAGE(PG8_SB(1, 0), b3, voffB); PG8_STAGE(PG8_SB(1, 1), b3 + hstep, voffB); PG8_STAGE(PG8_SA(1, 0), a3, voffA);
            PG8_WAIT_V(8); PG8_WAIT_L(0); PG8_BAR; PG8_MMA(1, 0, At, B0); PG8_MMA(1, 1, At, B1); PG8_BAR; PG8_SCHED;
            } else {
            PG8_LDB(B0, 0, 0); PG8_SCHED; PG8_LDA(At, 0, 0); PG8_STAGE(PG8_SA(1, 1), a1 + hstep, voffA);
            PG8_WAIT_L(8); PG8_BAR; PG8_WAIT_L(0); PG8_MMA(0, 0, At, B0); PG8_BAR; PG8_SCHED;
            PG8_LDB(B1, 0, 1); PG8_STAGE(PG8_SB(0, 0), b2, voffB);
            PG8_BAR; PG8_WAIT_L(0); PG8_MMA(0, 1, At, B1); PG8_BAR;
            PG8_LDA(At, 0, 1); PG8_STAGE(PG8_SA(0, 0), a2, voffA);
            PG8_BAR; PG8_WAIT_L(0); PG8_MMA(1, 0, At, B0); PG8_BAR; PG8_SCHED;
            PG8_STAGE(PG8_SB(0, 1), b2 + hstep, voffB);
            PG8_WAIT_V(6); PG8_BAR; PG8_MMA(1, 1, At, B1); PG8_BAR;
            PG8_LDB(B0, 1, 0); PG8_SCHED; PG8_LDA(At, 1, 0); PG8_STAGE(PG8_SA(0, 1), a2 + hstep, voffA);
            PG8_WAIT_L(8); PG8_BAR; PG8_WAIT_L(0); PG8_MMA(0, 0, At, B0); PG8_BAR; PG8_SCHED;
            PG8_LDB(B1, 1, 1); PG8_STAGE(PG8_SB(1, 0), b3, voffB);
            PG8_BAR; PG8_WAIT_L(0); PG8_MMA(0, 1, At, B1); PG8_BAR;
            PG8_LDA(At, 1, 1); PG8_STAGE(PG8_SA(1, 0), a3, voffA);
            PG8_BAR; PG8_WAIT_L(0); PG8_MMA(1, 0, At, B0); PG8_BAR; PG8_SCHED;
            PG8_STAGE(PG8_SB(1, 1), b3 + hstep, voffB);
            PG8_WAIT_V(6); PG8_BAR; PG8_MMA(1, 1, At, B1); PG8_BAR;
            }
        }
        if constexpr (ALIGN_EPI) { if (wr == 0) PG8_BAR; }
        if constexpr (!Epi::AFTER_DRAIN) { E(acc, cur, wr, wc, fr, fq); S.done(cur); }
        if (!has_next) break;
#pragma unroll
        for (int a = 0; a < 2; ++a)
#pragma unroll
            for (int b = 0; b < 2; ++b)
#pragma unroll
                for (int m = 0; m < 4; ++m)
#pragma unroll
                    for (int n = 0; n < 2; ++n) acc[a][b][m][n] = (f32x4){0.f, 0.f, 0.f, 0.f};
        cur = nxt; cA = nA; cB = nB; ++ui;
        if constexpr (ALIGN_EPI) { if (wr == 1) PG8_BAR; }
    }
    PG8_WAIT_V(0);
    if constexpr (!ALIGN_EPI) { if (wr == 0) PG8_BAR; }
    PG8_BAR;
    if constexpr (Epi::AFTER_DRAIN) { E.fused(acc, cur, wr, wc, fr, fq, lds, wid, lane); S.done(cur); }
#undef PG8_SA
#undef PG8_SB
#undef PG8_STAGE
#undef PG8_LDA
#undef PG8_LDB
#undef PG8_MMA
#undef PG8_WAIT_V
#undef PG8_WAIT_L
#undef PG8_BAR
#undef PG8_SCHED
}
}
#define LAS __attribute__((address_space(3)))
#define BID opaque_bid()
#define GRD opaque_grid()
typedef unsigned short bf16_t;
typedef short bf16x8 __attribute__((ext_vector_type(8)));
typedef short s16x4 __attribute__((ext_vector_type(4)));
typedef float f32x4 __attribute__((ext_vector_type(4)));
typedef float f32x16 __attribute__((ext_vector_type(16)));
typedef unsigned u32x4 __attribute__((ext_vector_type(4)));
typedef unsigned u32x2 __attribute__((ext_vector_type(2)));

constexpr int NB = 8, SEQ = 2048, NMETA = 16, LSEQ = SEQ + NMETA  , LP = 2112  , DM = 1024;
constexpr int MROWS = NB * LP;
constexpr int FOX_IN = 4112, RWKV_IN = 4224;
constexpr float NORM_EPS = 1e-6f, GN_EPS = 64e-5f, LOG2E = 1.4426950408889634f;
constexpr float DECAY_SCALE = 0.6065306597126334f;
constexpr int LDS_BYTES = 147456;
constexpr size_t MiB = 1u << 20;
constexpr size_t WS_WIN = 1 * MiB;
constexpr size_t WS_WOUT = 10 * MiB;
constexpr size_t WS_HMETA = 12 * MiB;
constexpr size_t WS_CUM = 13 * MiB;
constexpr size_t WS_PL = 15 * MiB;
constexpr size_t WS_B = 24 * MiB;
constexpr size_t WS_C = 57 * MiB;
constexpr size_t WS_LD = 189 * MiB;
constexpr size_t WS_AA = 222 * MiB;
constexpr size_t WS_END = 255 * MiB;
static_assert(WS_B + (size_t)MROWS * 1024 * 2 <= WS_C && WS_C + (size_t)MROWS * 4096 * 2 <= WS_LD && WS_LD + (size_t)MROWS * 2048 <= WS_AA && WS_AA + (size_t)MROWS * 2048 <= WS_END, "ws map");
static_assert(WS_PL + (size_t)MROWS * 512 <= WS_B && WS_CUM + (size_t)MROWS * 64 <= WS_PL, "ws map 2");

struct Params {
    const float *x, *meta, *norm_pre, *norm_post, *fox_w_in, *fox_b_f, *fox_w_out, *rwkv_w_in, *rwkv_mu, *rwkv_w0, *rwkv_w_up, *rwkv_a0, *rwkv_a_up,
        *rwkv_k_k, *rwkv_k_a, *rwkv_r_k, *rwkv_ln_w, *rwkv_ln_b, *rwkv_w_out;
    float* out; unsigned char* ws;
};

__device__ __forceinline__ float wave_sum(float v) {
#pragma unroll
    for (int o = 1; o < 64; o <<= 1) v += __shfl_xor(v, o);
    return v;
}
__device__ __forceinline__ unsigned pk2(float lo, float hi) { return pg8::pk2(lo, hi); }
__device__ __forceinline__ float bflo(unsigned w) { return __uint_as_float(w << 16); }
__device__ __forceinline__ float bfhi(unsigned w) { return __uint_as_float(w & 0xffff0000u); }
template <int CTRL> __device__ __forceinline__ float dppf(float v) { return __int_as_float(__builtin_amdgcn_update_dpp(0, __float_as_int(v), CTRL, 0xF, 0xF, true)); }
__device__ __forceinline__ float red16(float v) {
    v += dppf<0xB1>(v); v += dppf<0x4E>(v); v += dppf<0x141>(v); v += dppf<0x140>(v); return v;
}
__device__ __forceinline__ float sigmoidf_(float x) { return 1.f / (1.f + __expf(-x)); }
#define LDS_WAIT() asm volatile("s_waitcnt lgkmcnt(0)" ::: "memory")

__device__ __forceinline__ void transpose_item(const float* W, int ldw, bf16_t* WT, LAS float* scr, int kb, int nb, int lane) {
    const int k0 = 64 * kb, n0 = 32 * nb;
#pragma unroll 8
    for (int i = 0; i < 32; ++i) { const int kk = 2 * i + (lane >> 5); scr[kk * 33 + (lane & 31)] = W[(size_t)(k0 + kk) * ldw + n0 + (lane & 31)]; }
    LDS_WAIT();
    const int c = lane & 7;
#pragma unroll
    for (int j = 0; j < 4; ++j) { const int n = (lane >> 3) + 8 * j; const LAS float* s = scr + (8 * c) * 33 + n;
        u32x4 o; o.x = pk2(s[0 * 33], s[1 * 33]); o.y = pk2(s[2 * 33], s[3 * 33]); o.z = pk2(s[4 * 33], s[5 * 33]); o.w = pk2(s[6 * 33], s[7 * 33]);
        *(u32x4*)(WT + (size_t)(n0 + n) * 1024 + k0 + 8 * c) = o; }
    LDS_WAIT();
}

template <int MODE>
__device__ __forceinline__ void phase_e(const Params& p, LAS unsigned char* lds, int next, int prev) {
    const int tid = opaque_tid(), lane = tid & 63, wave = __builtin_amdgcn_readfirstlane(tid >> 6);
    const int G = GRD, gw = BID * 8 + wave, NGW = G * 8;
    bf16_t* U = (bf16_t*)(p.ws + WS_B);
    float* CUM = (float*)(p.ws + WS_CUM);
    float* HMETA = (float*)(p.ws + WS_HMETA);
    const float* MB = (const float*)(p.ws + WS_C);
    const bool next_fox = (next >= 0) && ((next & 1) == 0);
    LAS float* WfT = (LAS float*)lds;
    LAS float* scr = (LAS float*)(lds + 65536 + wave * 8448);
    if (next >= 0) {
        const int jn = next >> 1;
        bf16_t* WIN = (bf16_t*)(p.ws + WS_WIN); bf16_t* WOUT = (bf16_t*)(p.ws + WS_WOUT);
        if (next_fox) {
            const float* Wf = p.fox_w_in + (size_t)jn * 1024 * FOX_IN + 4096;
            for (int i = tid; i < 4096; i += 512) { const int k = i >> 2, q = i & 3; const f32x4 v = *(const f32x4*)(Wf + (size_t)k * FOX_IN + 4 * q);
                WfT[(4 * q + 0) * 1024 + k] = v[0]; WfT[(4 * q + 1) * 1024 + k] = v[1]; WfT[(4 * q + 2) * 1024 + k] = v[2]; WfT[(4 * q + 3) * 1024 + k] = v[3]; }
            const float* W = p.fox_w_in + (size_t)jn * 1024 * FOX_IN; const float* Wo = p.fox_w_out + (size_t)jn * 1024 * 1024;
            for (int it = gw; it < 16 * 128 + 16 * 32; it += NGW) {
                if (it < 16 * 128) transpose_item(W, FOX_IN, WIN, scr, it / 128, it % 128, lane);
                else { const int r = it - 16 * 128; transpose_item(Wo, 1024, WOUT, scr, r / 32, r % 32, lane); }
            }
        } else {
            const float* W = p.rwkv_w_in + (size_t)jn * 1024 * RWKV_IN; const float* Wo = p.rwkv_w_out + (size_t)jn * 1024 * 1024;
            for (int it = gw; it < 16 * 132 + 16 * 32; it += NGW) {
                if (it < 16 * 132) transpose_item(W, RWKV_IN, WIN, scr, it / 132, it % 132, lane);
                else { const int r = it - 16 * 132; transpose_item(Wo, 1024, WOUT, scr, r / 32, r % 32, lane); }
            }
            for (int i = BID * 512 + tid; i < 16384; i += G * 512) *(u32x4*)(WIN + (size_t)4224 * 1024 + (size_t)i * 8) = (u32x4){0u, 0u, 0u, 0u};
        }
    }
    __syncthreads();
    f32x4 gpo[4], gpr[4];
#pragma unroll
    for (int j = 0; j < 4; ++j) {
        gpo[j] = (MODE == 1) ? *((const f32x4*)(p.norm_post + (size_t)prev * 1024) + lane + 64 * j) : (f32x4){0.f, 0.f, 0.f, 0.f};
        gpr[j] = (next >= 0) ? *((const f32x4*)(p.norm_pre + (size_t)next * 1024) + lane + 64 * j) : (f32x4){0.f, 0.f, 0.f, 0.f};
    }
    const float bfv = (next_fox && lane < 16) ? p.fox_b_f[(next >> 1) * 16 + lane] : 0.f;
    for (int m = gw; m < MROWS; m += NGW) {
        const int b = m / LP, t = m - b * LP;
        if (t >= LSEQ) {
            if (next >= 0) { u32x2* o8 = (u32x2*)(U + (size_t)m * 1024) + lane;
#pragma unroll
                for (int j = 0; j < 4; ++j) o8[64 * j] = (u32x2){0u, 0u};
                if (next_fox && lane < 16) CUM[(size_t)m * 16 + lane] = 0.f; }
            continue;
        }
        float* hrow = (t < NMETA) ? HMETA + (size_t)(b * NMETA + t) * 1024 : p.out + ((size_t)b * SEQ + (t - NMETA)) * 1024;
        f32x4 v[4];
        if (MODE == 0) {
            const float* src = (t < NMETA) ? p.meta + (size_t)t * 1024 : p.x + ((size_t)b * SEQ + (t - NMETA)) * 1024;
#pragma unroll
            for (int j = 0; j < 4; ++j) v[j] = *((const f32x4*)src + lane + 64 * j);
        } else {
            f32x4 mv[4]; float ss = 0.f;
#pragma unroll
            for (int j = 0; j < 4; ++j) { v[j] = *((const f32x4*)hrow + lane + 64 * j); mv[j] = *((const f32x4*)(MB + (size_t)m * 1024) + lane + 64 * j);
                ss += (mv[j][0] * mv[j][0] + mv[j][1] * mv[j][1]) + (mv[j][2] * mv[j][2] + mv[j][3] * mv[j][3]); }
            const float rs = 1.0f / sqrtf(wave_sum(ss) * (1.f / 1024.f) + NORM_EPS);
#pragma unroll
            for (int j = 0; j < 4; ++j) v[j] = v[j] + mv[j] * rs * gpo[j];
        }
#pragma unroll
        for (int j = 0; j < 4; ++j) *((f32x4*)hrow + lane + 64 * j) = v[j];
        if (next >= 0) {
            float ss = 0.f;
#pragma unroll
            for (int j = 0; j < 4; ++j) ss += (v[j][0] * v[j][0] + v[j][1] * v[j][1]) + (v[j][2] * v[j][2] + v[j][3] * v[j][3]);
            const float rs = 1.0f / sqrtf(wave_sum(ss) * (1.f / 1024.f) + NORM_EPS);
            u32x2* o8 = (u32x2*)(U + (size_t)m * 1024) + lane;
#pragma unroll
            for (int j = 0; j < 4; ++j) { v[j] = v[j] * rs * gpr[j]; o8[64 * j] = (u32x2){pk2(v[j][0], v[j][1]), pk2(v[j][2], v[j][3])}; }
            if (next_fox) {
                float mine = 0.f;
#pragma unroll
                for (int hd = 0; hd < 16; ++hd) { float s = 0.f;
#pragma unroll
                    for (int j = 0; j < 4; ++j) { const f32x4 w = *((const LAS f32x4*)(WfT + hd * 1024) + lane + 64 * j); s += (v[j][0] * w[0] + v[j][1] * w[1]) + (v[j][2] * w[2] + v[j][3] * w[3]); }
                    s = wave_sum(s); if (lane == hd) mine = s; }
                if (lane < 16) { const float xx = mine + bfv; const float lf = fminf(xx, 0.f) - log1pf(__expf(-fabsf(xx))); CUM[(size_t)m * 16 + lane] = lf * LOG2E; }
            }
        }
    }
}

__device__ __forceinline__ void phase_cumsum(const Params& p, LAS unsigned char* lds) {
    const int tid = opaque_tid(); LAS float* s = (LAS float*)lds;
    float* CUM = (float*)(p.ws + WS_CUM);
    for (int j = BID; j < 128; j += GRD) {
        const int b = j >> 4, hd = j & 15; float* base = CUM + (size_t)b * LP * 16 + hd;
        float v[5]; float tot = 0.f;
#pragma unroll
        for (int e = 0; e < 5; ++e) { const int t = tid * 5 + e; v[e] = (t < LP) ? base[(size_t)t * 16] : 0.f; tot += v[e]; }
        s[tid] = tot; __syncthreads();
        for (int off = 1; off < 512; off <<= 1) { const float a = (tid >= off) ? s[tid - off] : 0.f; __syncthreads(); s[tid] += a; __syncthreads(); }
        float run = s[tid] - tot;
#pragma unroll
        for (int e = 0; e < 5; ++e) { const int t = tid * 5 + e; run += v[e]; if (t < LP) base[(size_t)t * 16] = run; }
        __syncthreads();
    }
}

__device__ __forceinline__ void phase_attn(const Params& p, LAS unsigned char* lds) {
    const int tid = opaque_tid(), lane = tid & 63, wid = __builtin_amdgcn_readfirstlane(tid >> 6), r32 = lane & 31, hi = lane >> 5;
    LAS bf16_t* Ks = (LAS bf16_t*)lds;
    LAS bf16_t* Vt = Ks + 2 * 64 * 72;
    LAS float* cks = (LAS float*)(lds + 2 * 2 * 64 * 72 * 2);
    const bf16_t* P = (const bf16_t*)(p.ws + WS_C);
    const float* CUM = (const float*)(p.ws + WS_CUM);
    bf16_t* OG = (bf16_t*)(p.ws + WS_B);
    const int kr = tid >> 3, kc = tid & 7;
    for (int u = BID; u < 1152; u += GRD) {
        const int qb = 8 - u / 128, bh = u % 128, b = bh >> 4, h = bh & 15;
        const int q0 = qb * 256;
        int NT = (q0 + 256) / 64; if (NT > LP / 64) NT = LP / 64;
        const int qw0 = q0 + 32 * wid;
        const bool active = qw0 < LP;
        const int jmax = (qw0 + 31) >> 6;
        const size_t rowb = (size_t)b * LP;
        bf16x8 qr[4];
#pragma unroll
        for (int d0 = 0; d0 < 4; ++d0) qr[d0] = active ? *(const bf16x8*)(P + (rowb + qw0 + r32) * 4096 + h * 64 + d0 * 16 + hi * 8) : (bf16x8){0, 0, 0, 0, 0, 0, 0, 0};
        const bf16_t* kg = P + (rowb + kr) * 4096 + 1024 + h * 64 + kc * 8;
        const bf16_t* vg = kg + 1024;
        const float* cgp = CUM + (rowb + (tid & 63)) * 16 + h;
        u32x4 kreg = *(const u32x4*)kg, vreg = *(const u32x4*)vg; float creg = (tid < 64) ? cgp[0] : 0.f;
#define STORE_TILE(buf) do { *(LAS u32x4*)(Ks + (buf) * 4608 + kr * 72 + kc * 8) = kreg; \
        LAS bf16_t* vt_ = Vt + (buf) * 4608 + (kc * 8) * 72 + kr; \
        vt_[0 * 72] = (bf16_t)(vreg.x & 0xffffu); vt_[1 * 72] = (bf16_t)(vreg.x >> 16); vt_[2 * 72] = (bf16_t)(vreg.y & 0xffffu); vt_[3 * 72] = (bf16_t)(vreg.y >> 16); \
        vt_[4 * 72] = (bf16_t)(vreg.z & 0xffffu); vt_[5 * 72] = (bf16_t)(vreg.z >> 16); vt_[6 * 72] = (bf16_t)(vreg.w & 0xffffu); vt_[7 * 72] = (bf16_t)(vreg.w >> 16); \
        if (tid < 64) cks[(buf) * 64 + tid] = creg; } while (0)
        STORE_TILE(0);
        __syncthreads();
        float m_run = -INFINITY, l_run = 0.f;
        f32x16 o0, o1;
#pragma unroll
        for (int r = 0; r < 16; ++r) { o0[r] = 0.f; o1[r] = 0.f; }
        for (int j = 0; j < NT; ++j) {
            const int buf = j & 1;
            if (j + 1 < NT) { kreg = *(const u32x4*)(kg + (size_t)(j + 1) * 64 * 4096); vreg = *(const u32x4*)(vg + (size_t)(j + 1) * 64 * 4096); if (tid < 64) creg = cgp[(size_t)(j + 1) * 64 * 16]; }
            if (active && j <= jmax) {
                const LAS bf16_t* Kb = Ks + buf * 4608; const LAS bf16_t* Vb = Vt + buf * 4608; const LAS float* cb = cks + buf * 64;
                f32x16 p0, p1;
#pragma unroll
                for (int i = 0; i < 4; ++i) { const f32x4 c0 = *(const LAS f32x4*)(cb + 8 * i + 4 * hi), c1 = *(const LAS f32x4*)(cb + 32 + 8 * i + 4 * hi);
#pragma unroll
                    for (int e = 0; e < 4; ++e) { p0[4 * i + e] = -c0[e]; p1[4 * i + e] = -c1[e]; } }
#pragma unroll
                for (int d0 = 0; d0 < 4; ++d0) {
                    const bf16x8 a0 = *(const LAS bf16x8*)(Kb + r32 * 72 + d0 * 16 + hi * 8), a1 = *(const LAS bf16x8*)(Kb + (32 + r32) * 72 + d0 * 16 + hi * 8);
                    p0 = __builtin_amdgcn_mfma_f32_32x32x16_bf16(a0, qr[d0], p0, 0, 0, 0); p1 = __builtin_amdgcn_mfma_f32_32x32x16_bf16(a1, qr[d0], p1, 0, 0, 0);
                }
                if (64 * j + 63 > qw0) {
                    const int qpos = qw0 + r32;
#pragma unroll
                    for (int r = 0; r < 16; ++r) { const int kv = 64 * j + (r & 3) + 8 * (r >> 2) + 4 * hi; if (kv > qpos) p0[r] = -INFINITY; if (kv + 32 > qpos) p1[r] = -INFINITY; }
                }
                float mx = fmaxf(p0[0], p1[0]);
#pragma unroll
                for (int r = 1; r < 16; ++r) mx = fmaxf(mx, fmaxf(p0[r], p1[r]));
                mx = fmaxf(mx, __shfl_xor(mx, 32));
                const float m_new = fmaxf(m_run, mx);
                const float alpha = __builtin_amdgcn_exp2f(m_run - m_new);
                m_run = m_new;
                float sum = 0.f;
#pragma unroll
                for (int r = 0; r < 16; ++r) { p0[r] = __builtin_amdgcn_exp2f(p0[r] - m_new); p1[r] = __builtin_amdgcn_exp2f(p1[r] - m_new); sum += p0[r] + p1[r]; }
                l_run = l_run * alpha + sum;
#pragma unroll
                for (int r = 0; r < 16; ++r) { o0[r] *= alpha; o1[r] *= alpha; }
#pragma unroll
                for (int c = 0; c < 4; ++c) {
                    u32x4 pw;
                    if (c < 2) { pw.x = pk2(p0[8 * c + 0], p0[8 * c + 1]); pw.y = pk2(p0[8 * c + 2], p0[8 * c + 3]); pw.z = pk2(p0[8 * c + 4], p0[8 * c + 5]); pw.w = pk2(p0[8 * c + 6], p0[8 * c + 7]); }
                    else { const int c2 = c - 2; pw.x = pk2(p1[8 * c2 + 0], p1[8 * c2 + 1]); pw.y = pk2(p1[8 * c2 + 2], p1[8 * c2 + 3]); pw.z = pk2(p1[8 * c2 + 4], p1[8 * c2 + 5]); pw.w = pk2(p1[8 * c2 + 6], p1[8 * c2 + 7]); }
                    const bf16x8 pf = __builtin_bit_cast(bf16x8, pw);
                    {   const s16x4 lo = *(const LAS s16x4*)(Vb + r32 * 72 + 16 * c + 4 * hi), h4 = *(const LAS s16x4*)(Vb + r32 * 72 + 16 * c + 4 * hi + 8);
                        const bf16x8 vf = (bf16x8){lo[0], lo[1], lo[2], lo[3], h4[0], h4[1], h4[2], h4[3]};
                        o0 = __builtin_amdgcn_mfma_f32_32x32x16_bf16(vf, pf, o0, 0, 0, 0); }
                    {   const s16x4 lo = *(const LAS s16x4*)(Vb + (32 + r32) * 72 + 16 * c + 4 * hi), h4 = *(const LAS s16x4*)(Vb + (32 + r32) * 72 + 16 * c + 4 * hi + 8);
                        const bf16x8 vf = (bf16x8){lo[0], lo[1], lo[2], lo[3], h4[0], h4[1], h4[2], h4[3]};
                        o1 = __builtin_amdgcn_mfma_f32_32x32x16_bf16(vf, pf, o1, 0, 0, 0); }
                }
            }
            if (j + 1 < NT) STORE_TILE(buf ^ 1);
            __syncthreads();
        }
#undef STORE_TILE
        if (active) {
            const float l = l_run + __shfl_xor(l_run, 32); const float inv = 1.f / l;
            const size_t row = rowb + qw0 + r32;
#pragma unroll
            for (int dh = 0; dh < 2; ++dh)
#pragma unroll
                for (int i = 0; i < 4; ++i) {
                    const int dcol = h * 64 + 32 * dh + 8 * i + 4 * hi;
                    const u32x2 gw_ = *(const u32x2*)(P + row * 4096 + 3072 + dcol);
                    const float g0 = bflo(gw_.x), g1 = bfhi(gw_.x), g2 = bflo(gw_.y), g3 = bfhi(gw_.y);
                    const float a0 = (dh ? o1[4 * i + 0] : o0[4 * i + 0]) * inv, a1 = (dh ? o1[4 * i + 1] : o0[4 * i + 1]) * inv, a2 = (dh ? o1[4 * i + 2] : o0[4 * i + 2]) * inv, a3 = (dh ? o1[4 * i + 3] : o0[4 * i + 3]) * inv;
                    u32x2 w; w.x = pk2(a0 * g0 * sigmoidf_(g0), a1 * g1 * sigmoidf_(g1)); w.y = pk2(a2 * g2 * sigmoidf_(g2), a3 * g3 * sigmoidf_(g3));
                    *(u32x2*)(OG + row * 1024 + dcol) = w;
                }
        }
    }
}

__device__ __forceinline__ void phase_lora(const Params& p, LAS unsigned char* lds, int jr) {
    const int tid = opaque_tid();
    LAS float* tw = (LAS float*)lds;
    LAS float* ad = tw + 1024;
    const bf16_t* PL = (const bf16_t*)(p.ws + WS_PL);
    bf16_t* LD = (bf16_t*)(p.ws + WS_LD); bf16_t* AA = (bf16_t*)(p.ws + WS_AA);
    const float* mu = p.rwkv_mu + (size_t)jr * RWKV_IN + 4096;
    const float* w_up = p.rwkv_w_up + (size_t)jr * 64 * 1024; const float* a_up = p.rwkv_a_up + (size_t)jr * 64 * 1024;
    const int c0 = tid, c1 = tid + 512;
    const float w00 = p.rwkv_w0[jr * 1024 + c0], w01 = p.rwkv_w0[jr * 1024 + c1], a00 = p.rwkv_a0[jr * 1024 + c0], a01 = p.rwkv_a0[jr * 1024 + c1];
    const int st = tid >> 5, scq = tid & 31;
    const f32x4 mu4 = *(const f32x4*)(mu + 4 * scq);
    for (int tile = BID; tile < MROWS / 16; tile += GRD) {
        const int m0 = tile * 16;
        {   const int row = m0 + st, tpos = row % LP;
            const u32x2 cw = *(const u32x2*)(PL + (size_t)row * 256 + 4 * scq);
            u32x2 pw = (u32x2){0u, 0u}; if (tpos > 0) pw = *(const u32x2*)(PL + (size_t)(row - 1) * 256 + 4 * scq);
            float cv[4] = {bflo(cw.x), bfhi(cw.x), bflo(cw.y), bfhi(cw.y)}, pv[4] = {bflo(pw.x), bfhi(pw.x), bflo(pw.y), bfhi(pw.y)};
#pragma unroll
            for (int e = 0; e < 4; ++e) { const int c = 4 * scq + e; const float val = cv[e] + (pv[e] - cv[e]) * mu4[e];
                if (c < 64) tw[c * 16 + st] = tanhf(val); else ad[(c - 64) * 16 + st] = val; }
        }
        __syncthreads();
        float wa0[16], wa1[16], aa0[16], aa1[16];
#pragma unroll
        for (int t = 0; t < 16; ++t) { wa0[t] = 0.f; wa1[t] = 0.f; aa0[t] = 0.f; aa1[t] = 0.f; }
#pragma unroll 2
        for (int j = 0; j < 64; ++j) {
            const float wu0 = w_up[j * 1024 + c0], wu1 = w_up[j * 1024 + c1], au0 = a_up[j * 1024 + c0], au1 = a_up[j * 1024 + c1];
#pragma unroll
            for (int q = 0; q < 4; ++q) { const f32x4 t4 = *(const LAS f32x4*)(tw + j * 16 + 4 * q), a4 = *(const LAS f32x4*)(ad + j * 16 + 4 * q);
#pragma unroll
                for (int e = 0; e < 4; ++e) { wa0[4 * q + e] += t4[e] * wu0; wa1[4 * q + e] += t4[e] * wu1; aa0[4 * q + e] += a4[e] * au0; aa1[4 * q + e] += a4[e] * au1; } }
        }
#pragma unroll
        for (int t = 0; t < 16; ++t) { const size_t row = (size_t)(m0 + t);
            LD[row * 1024 + c0] = (bf16_t)(pk2(-DECAY_SCALE * LOG2E * sigmoidf_(w00 + wa0[t]), 0.f) & 0xffffu);
            LD[row * 1024 + c1] = (bf16_t)(pk2(-DECAY_SCALE * LOG2E * sigmoidf_(w01 + wa1[t]), 0.f) & 0xffffu);
            AA[row * 1024 + c0] = (bf16_t)(pk2(sigmoidf_(a00 + aa0[t]), 0.f) & 0xffffu);
            AA[row * 1024 + c1] = (bf16_t)(pk2(sigmoidf_(a01 + aa1[t]), 0.f) & 0xffffu); }
        __syncthreads();
    }
}

__device__ __forceinline__ void phase_scan(const Params& p, LAS unsigned char* lds, int jr) {
    const int tid = opaque_tid(), lane = tid & 63, wid = __builtin_amdgcn_readfirstlane(tid >> 6);
    LAS float* vec = (LAS float*)lds;
    LAS float* ybuf = vec + 32 * 384;
    const bf16_t* P = (const bf16_t*)(p.ws + WS_C);
    const bf16_t* LD = (const bf16_t*)(p.ws + WS_LD); const bf16_t* AA = (const bf16_t*)(p.ws + WS_AA);
    bf16_t* Y = (bf16_t*)(p.ws + WS_B);
    const int ds = tid >> 4, kq = tid & 15;
    const int rl = lane >> 4, skq = lane & 15;
    for (int u = BID; u < 256; u += GRD) {
        const int bh = u >> 1, half = u & 1, b = bh >> 4, h = bh & 15;
        const int kcol = h * 64 + 4 * kq;
        const float* mu = p.rwkv_mu + (size_t)jr * RWKV_IN;
        const f32x4 mur = *(const f32x4*)(mu + kcol), muk = *(const f32x4*)(mu + 1024 + kcol), muv = *(const f32x4*)(mu + 2048 + kcol);
        const f32x4 kk4 = *(const f32x4*)(p.rwkv_k_k + jr * 1024 + kcol), ka4 = *(const f32x4*)(p.rwkv_k_a + jr * 1024 + kcol);
        const int vrow = 32 * half + 4 * wid + rl;
        float S0 = 0.f, S1 = 0.f, S2 = 0.f, S3 = 0.f;
        for (int ch = 0; ch < 65; ++ch) {
            {   const int t = ch * 32 + ds; const size_t row = (size_t)b * LP + t;
                const bf16_t* pr = P + row * 4096 + kcol;
                const u32x2 rw = *(const u32x2*)pr, kw = *(const u32x2*)(pr + 1024), vw = *(const u32x2*)(pr + 2048);
                u32x2 rp = (u32x2){0u, 0u}, kp_ = rp, vp = rp;
                if (t > 0) { rp = *(const u32x2*)(pr - 4096); kp_ = *(const u32x2*)(pr - 4096 + 1024); vp = *(const u32x2*)(pr - 4096 + 2048); }
                const u32x2 lw = *(const u32x2*)(LD + row * 1024 + kcol), aw = *(const u32x2*)(AA + row * 1024 + kcol);
                const f32x4 rc = {bflo(rw.x), bfhi(rw.x), bflo(rw.y), bfhi(rw.y)}, kc_ = {bflo(kw.x), bfhi(kw.x), bflo(kw.y), bfhi(kw.y)}, vc = {bflo(vw.x), bfhi(vw.x), bflo(vw.y), bfhi(vw.y)};
                const f32x4 rpv = {bflo(rp.x), bfhi(rp.x), bflo(rp.y), bfhi(rp.y)}, kpv = {bflo(kp_.x), bfhi(kp_.x), bflo(kp_.y), bfhi(kp_.y)}, vpv = {bflo(vp.x), bfhi(vp.x), bflo(vp.y), bfhi(vp.y)};
                const f32x4 ldv = {bflo(lw.x), bfhi(lw.x), bflo(lw.y), bfhi(lw.y)}, av = {bflo(aw.x), bfhi(aw.x), bflo(aw.y), bfhi(aw.y)};
                const f32x4 rlp = rc + (rpv - rc) * mur, klp = kc_ + (kpv - kc_) * muk, vlp = vc + (vpv - vc) * muv;
                const f32x4 kkv = klp * kk4;
                float ss = (kkv[0] * kkv[0] + kkv[1] * kkv[1]) + (kkv[2] * kkv[2] + kkv[3] * kkv[3]);
                ss = red16(ss);
                const float inv = 1.f / fmaxf(sqrtf(ss), 1e-12f);
                const f32x4 kkn = kkv * inv;
                const f32x4 kpr = klp * (1.f + (av - 1.f) * ka4);
                f32x4 wv; wv[0] = __builtin_amdgcn_exp2f(ldv[0]); wv[1] = __builtin_amdgcn_exp2f(ldv[1]); wv[2] = __builtin_amdgcn_exp2f(ldv[2]); wv[3] = __builtin_amdgcn_exp2f(ldv[3]);
                LAS float* vs = vec + ds * 384 + 4 * kq;
                *(LAS f32x4*)(vs) = wv; *(LAS f32x4*)(vs + 64) = -kkn; *(LAS f32x4*)(vs + 128) = kkn * av; *(LAS f32x4*)(vs + 192) = kpr; *(LAS f32x4*)(vs + 256) = rlp; *(LAS f32x4*)(vs + 320) = vlp;
            }
            __syncthreads();
#pragma unroll 4
            for (int s = 0; s < 32; ++s) {
                const LAS float* q = vec + s * 384 + 4 * skq;
                const f32x4 w4 = *(const LAS f32x4*)q, a4 = *(const LAS f32x4*)(q + 64), b4 = *(const LAS f32x4*)(q + 128), k4 = *(const LAS f32x4*)(q + 192), r4 = *(const LAS f32x4*)(q + 256);
                const float vv = vec[s * 384 + 320 + vrow];
                float sa = (S0 * a4[0] + S1 * a4[1]) + (S2 * a4[2] + S3 * a4[3]);
                sa = red16(sa);
                S0 = S0 * w4[0] + sa * b4[0] + vv * k4[0]; S1 = S1 * w4[1] + sa * b4[1] + vv * k4[1];
                S2 = S2 * w4[2] + sa * b4[2] + vv * k4[2]; S3 = S3 * w4[3] + sa * b4[3] + vv * k4[3];
                float y = (S0 * r4[0] + S1 * r4[1]) + (S2 * r4[2] + S3 * r4[3]);
                y = red16(y);
                if (skq == 0) ybuf[s * 32 + 4 * wid + rl] = y;
            }
            __syncthreads();
            {   const int s = tid >> 4, rp2 = tid & 15;
                const float y0 = ybuf[s * 32 + 2 * rp2], y1 = ybuf[s * 32 + 2 * rp2 + 1];
                *(unsigned*)(Y + ((size_t)b * LP + ch * 32 + s) * 1024 + h * 64 + 32 * half + 2 * rp2) = pk2(y0, y1);
            }
        }
        __syncthreads();
    }
}

__device__ __forceinline__ void phase_r4(const Params& p, int jr) {
    const int tid = opaque_tid(), lane = tid & 63, wave = __builtin_amdgcn_readfirstlane(tid >> 6);
    const int gw = BID * 8 + wave, NGW = GRD * 8;
    const bf16_t* P = (const bf16_t*)(p.ws + WS_C); const bf16_t* AA = (const bf16_t*)(p.ws + WS_AA); const bf16_t* Y = (const bf16_t*)(p.ws + WS_B);
    bf16_t* YG = (bf16_t*)(p.ws + WS_LD);
    const float* mu = p.rwkv_mu + (size_t)jr * RWKV_IN;
    for (int it = gw; it < 2048; it += NGW) {
        const int tile = it >> 2, q = it & 3, c = 256 * q + 4 * lane;
        const f32x4 mur = *(const f32x4*)(mu + c), muk = *(const f32x4*)(mu + 1024 + c), muv = *(const f32x4*)(mu + 2048 + c), mug = *(const f32x4*)(mu + 3072 + c);
        const f32x4 ka4 = *(const f32x4*)(p.rwkv_k_a + jr * 1024 + c), rk4 = *(const f32x4*)(p.rwkv_r_k + jr * 1024 + c);
        const f32x4 lnw = *(const f32x4*)(p.rwkv_ln_w + jr * 1024 + c), lnb = *(const f32x4*)(p.rwkv_ln_b + jr * 1024 + c);
        const int m0 = tile * 33;
        f32x4 rp = {0.f, 0.f, 0.f, 0.f}, kp = rp, vp = rp, gp = rp;
        if (m0 % LP != 0) { const bf16_t* pr = P + (size_t)(m0 - 1) * 4096 + c;
            const u32x2 a = *(const u32x2*)pr, b2 = *(const u32x2*)(pr + 1024), c2 = *(const u32x2*)(pr + 2048), d2 = *(const u32x2*)(pr + 3072);
            rp = (f32x4){bflo(a.x), bfhi(a.x), bflo(a.y), bfhi(a.y)}; kp = (f32x4){bflo(b2.x), bfhi(b2.x), bflo(b2.y), bfhi(b2.y)};
            vp = (f32x4){bflo(c2.x), bfhi(c2.x), bflo(c2.y), bfhi(c2.y)}; gp = (f32x4){bflo(d2.x), bfhi(d2.x), bflo(d2.y), bfhi(d2.y)}; }
#pragma unroll 3
        for (int i = 0; i < 33; ++i) {
            const size_t row = (size_t)(m0 + i);
            const bf16_t* pr = P + row * 4096 + c;
            const u32x2 a = *(const u32x2*)pr, b2 = *(const u32x2*)(pr + 1024), c2 = *(const u32x2*)(pr + 2048), d2 = *(const u32x2*)(pr + 3072);
            const u32x2 aw = *(const u32x2*)(AA + row * 1024 + c), yw = *(const u32x2*)(Y + row * 1024 + c);
            const f32x4 rc = {bflo(a.x), bfhi(a.x), bflo(a.y), bfhi(a.y)}, kc = {bflo(b2.x), bfhi(b2.x), bflo(b2.y), bfhi(b2.y)};
            const f32x4 vc = {bflo(c2.x), bfhi(c2.x), bflo(c2.y), bfhi(c2.y)}, gc = {bflo(d2.x), bfhi(d2.x), bflo(d2.y), bfhi(d2.y)};
            const f32x4 av = {bflo(aw.x), bfhi(aw.x), bflo(aw.y), bfhi(aw.y)}, yv = {bflo(yw.x), bfhi(yw.x), bflo(yw.y), bfhi(yw.y)};
            const f32x4 rl = rc + (rp - rc) * mur, kl = kc + (kp - kc) * muk, vl = vc + (vp - vc) * muv, gl = gc + (gp - gc) * mug;
            rp = rc; kp = kc; vp = vc; gp = gc;
            const f32x4 kpr = kl * (1.f + (av - 1.f) * ka4);
            const f32x4 bt = rl * kpr * rk4;
            const float bonus = red16((bt[0] + bt[1]) + (bt[2] + bt[3]));
            const float mean = red16((yv[0] + yv[1]) + (yv[2] + yv[3])) * (1.f / 64.f);
            const f32x4 d = yv - mean;
            const float var = red16((d[0] * d[0] + d[1] * d[1]) + (d[2] * d[2] + d[3] * d[3])) * (1.f / 64.f);
            const float rstd = 1.0f / sqrtf(var + GN_EPS);
            const f32x4 o = (d * rstd * lnw + lnb) + bonus * vl;
            u32x2 w; w.x = pk2(o[0] * gl[0] * sigmoidf_(gl[0]), o[1] * gl[1] * sigmoidf_(gl[1])); w.y = pk2(o[2] * gl[2] * sigmoidf_(gl[2]), o[3] * gl[3] * sigmoidf_(gl[3]));
            *(u32x2*)(YG + row * 1024 + c) = w;
        }
    }
}

__global__ void __launch_bounds__(512, 2) fwd_megakernel(Params p) {
    extern __shared__ __attribute__((aligned(16))) unsigned char lds_raw[];
    LAS unsigned char* lds = (LAS unsigned char*)lds_raw;
    cg::grid_group grid = cg::this_grid();
    bf16_t* U = (bf16_t*)(p.ws + WS_B); bf16_t* WIN = (bf16_t*)(p.ws + WS_WIN); bf16_t* WOUT = (bf16_t*)(p.ws + WS_WOUT);
    bf16_t* P = (bf16_t*)(p.ws + WS_C); bf16_t* PL = (bf16_t*)(p.ws + WS_PL); float* MB = (float*)(p.ws + WS_C);
    phase_e<0>(p, lds, 0, -1);
    grid.sync();
#pragma unroll 1
    for (int layer = 0; layer < 4; ++layer) {
        const int jr = layer >> 1; const bool rw = (layer & 1) != 0;
        if (!rw) phase_cumsum(p, lds);
        {   pg8::Gemm g{U, WIN, MROWS, rw ? 4352 : 4096, 1024}; pg8::StaticOrder S; S.init(MROWS, rw ? 4352 : 4096, (int)GRD, (int)BID);
            pg8::EpiP E{P, PL, rw ? 1.f : 0.125f * LOG2E, rw ? 0 : 1024};
            pg8::gemm_phase<pg8::EpiP, pg8::StaticOrder, true, true>(lds, g, S, E); }
        grid.sync();
        if (!rw) { phase_attn(p, lds); grid.sync(); }
        else { phase_lora(p, lds, jr); grid.sync(); phase_scan(p, lds, jr); grid.sync(); phase_r4(p, jr); grid.sync(); }
        {   pg8::Gemm g{rw ? (const bf16_t*)(p.ws + WS_LD) : (const bf16_t*)(p.ws + WS_B), WOUT, MROWS, 1024, 1024}; pg8::StaticOrder S; S.init(MROWS, 1024, (int)GRD, (int)BID);
            pg8::EpiF32 E{MB, 1024};
            pg8::gemm_phase<pg8::EpiF32, pg8::StaticOrder, true, true>(lds, g, S, E); }
        grid.sync();
        phase_e<1>(p, lds, layer < 3 ? layer + 1 : -1, layer);
        if (layer < 3) grid.sync();
    }
}

extern "C" void kernel_launch(void* const* d_in, const int* in_sizes, int n_in, void* d_out, int out_size, void* d_ws, size_t ws_size, hipStream_t stream) {
    static int grid_blocks = 0;
    if (grid_blocks == 0) {
        if (n_in != 19 || ws_size < WS_END) { fprintf(stderr, "kernel_launch: unexpected inputs (n_in %d, ws %zu)\n", n_in, ws_size); grid_blocks = -1; return; }
        int dev = 0, cus = 0, per_cu = 0;
        hipGetDevice(&dev); hipDeviceGetAttribute(&cus, hipDeviceAttributeMultiprocessorCount, dev);
        if (hipFuncSetAttribute((const void*)fwd_megakernel, hipFuncAttributeMaxDynamicSharedMemorySize, LDS_BYTES) != hipSuccess) { fprintf(stderr, "kernel_launch: hipFuncSetAttribute failed\n"); grid_blocks = -1; return; }
        if (hipOccupancyMaxActiveBlocksPerMultiprocessor(&per_cu, (const void*)fwd_megakernel, 512, LDS_BYTES) != hipSuccess || per_cu < 1) { fprintf(stderr, "kernel_launch: occupancy query failed (%d)\n", per_cu); (void)hipGetLastError(); grid_blocks = -1; return; }
        grid_blocks = cus * (per_cu > 1 ? 1 : per_cu);
    }
    if (grid_blocks < 0) return;
    Params p{};
    const float** f = (const float**)&p;
    for (int i = 0; i < 19; ++i) f[i] = (const float*)d_in[i];
    p.out = (float*)d_out; p.ws = (unsigned char*)d_ws;
    void* args[] = {&p};
    hipError_t e = hipLaunchCooperativeKernel((const void*)fwd_megakernel, dim3(grid_blocks), dim3(512), args, LDS_BYTES, stream);
    if (e != hipSuccess) fprintf(stderr, "cooperative launch failed: %s (grid %d)\n", hipGetErrorString(e), grid_blocks);
}
```

```cpp
#include <hip/hip_runtime.h>
#include <hip/hip_cooperative_groups.h>
#include <cstdio>
#include <cstdint>
namespace cg = cooperative_groups;
__device__ __forceinline__ int opaque_tid() { int t = threadIdx.x; asm volatile("" : "+v"(t)); return t; }
__device__ __forceinline__ int opaque_bid() { int t = blockIdx.x; asm volatile("" : "+s"(t)); return t; }
__device__ __forceinline__ int opaque_grid() { int t = gridDim.x; asm volatile("" : "+s"(t)); return t; }
namespace pg8 {
#define PG8_LAS __attribute__((address_space(3)))
typedef unsigned short bf16_t;
typedef short bf16x8 __attribute__((ext_vector_type(8)));
typedef float f32x4 __attribute__((ext_vector_type(4)));
typedef unsigned u32x4 __attribute__((ext_vector_type(4)));
constexpr int BM = 256, BK = 64, HALF = 128, HTB = HALF * BK * 2  , STAGE_BYTES = 8 * HTB, NXCD = 8, WGM = 8;

__host__ __device__ __forceinline__ int lds_byte(int r, int c) { const int st = (r >> 4) * 2 + (c >> 5), rr = r & 15, cc = c & 31, ob = rr * 64 + cc * 2; return st * 1024 + (ob ^ (((ob >> 9) & 1) << 5)); }
__host__ __device__ __forceinline__ void stage_rc(int b, int& R, int& C) { const int st = b / 1024, sb = b % 1024, swz = sb ^ (((sb >> 9) & 1) << 5); R = (st >> 1) * 16 + swz / 64; C = (st & 1) * 32 + (swz % 64) / 2; }
__host__ __device__ __forceinline__ int perm32(int rho) { const int n = rho >> 4, i = rho & 15; return 8 * (i >> 2) + 4 * n + (i & 3); }

struct Unit { int pm, pn; };
struct Gemm { const bf16_t* A; const bf16_t* Bt; int M, N, K; };

struct StaticOrder {
    int nM, nN, nwg, G, c;
    __host__ __device__ void init(int M, int N, int G_, int c_) { nM = M / BM; nN = N / BM; nwg = nM * nN; G = G_; c = c_; }
    __host__ __device__ bool next(int i, Unit& u) const {
        const long L = (long)i * G + c; if (L >= nwg) return false;
        int wgid = (int)L; { const int q = nwg / NXCD, r = nwg % NXCD, xcd = wgid % NXCD, off = wgid / NXCD; wgid = (xcd < r ? xcd * (q + 1) : r * (q + 1) + (xcd - r) * q) + off; }
        const int nig = WGM * nN, gid = wgid / nig, fm = gid * WGM, gsz = (nM - fm) < WGM ? (nM - fm) : WGM;
        u.pm = fm + ((wgid % nig) % gsz); u.pn = (wgid % nig) / gsz; return true;
    }
    __device__ __forceinline__ void a_ready(const Unit&) const {}
    __device__ __forceinline__ void done(const Unit&) const {}
};

__device__ __forceinline__ unsigned cvt_pk_bf16(float lo, float hi) { unsigned r; asm volatile("v_cvt_pk_bf16_f32 %0, %1, %2" : "=v"(r) : "v"(lo), "v"(hi)); return r; }
typedef float f32x2 __attribute__((ext_vector_type(2)));
typedef __bf16 bf16x2_t __attribute__((ext_vector_type(2)));
__device__ __forceinline__ unsigned pk2(float lo, float hi) { f32x2 v = {lo, hi}; bf16x2_t b = __builtin_convertvector(v, bf16x2_t); return __builtin_bit_cast(unsigned, b); }
struct EpiP {
    static constexpr bool PERM = true, AFTER_DRAIN = false;
    bf16_t* P; bf16_t* PL; float qscale; int qcols;
    __device__ __forceinline__ void operator()(const f32x4 (&acc)[2][2][4][2], const Unit& u, int wr, int wc, int fr, int fq) const {
        const int row0 = u.pm * BM + wr * 64 + fr; const int colt = u.pn * BM;
        bf16_t* base; int ldc, c0;
        if (colt < 4096) { base = P; ldc = 4096; c0 = colt; } else { base = PL; ldc = 256; c0 = colt - 4096; }
        const float sc = (colt < qcols) ? qscale : 1.f;
        const int col0 = c0 + wc * 32 + 8 * fq;
#pragma unroll
        for (int ai = 0; ai < 2; ++ai)
#pragma unroll
            for (int m = 0; m < 4; ++m) { bf16_t* rowp = base + (size_t)(row0 + ai * HALF + m * 16) * ldc + col0;
#pragma unroll
                for (int bj = 0; bj < 2; ++bj) { const f32x4 v0 = acc[ai][bj][m][0] * sc, v1 = acc[ai][bj][m][1] * sc;
                    u32x4 w; w.x = pk2(v0[0], v0[1]); w.y = pk2(v0[2], v0[3]); w.z = pk2(v1[0], v1[1]); w.w = pk2(v1[2], v1[3]);
                    *(u32x4*)(rowp + bj * HALF) = w; } }
    }
};
struct EpiF32 {
    static constexpr bool PERM = false, AFTER_DRAIN = false;
    float* O; int ldc;
    __device__ __forceinline__ void operator()(const f32x4 (&acc)[2][2][4][2], const Unit& u, int wr, int wc, int fr, int fq) const {
        const int row0 = u.pm * BM + wr * 64 + fr; const int col0 = u.pn * BM + wc * 32 + 4 * fq;
#pragma unroll
        for (int ai = 0; ai < 2; ++ai)
#pragma unroll
            for (int m = 0; m < 4; ++m) { float* rowp = O + (size_t)(row0 + ai * HALF + m * 16) * ldc + col0;
#pragma unroll
                for (int bj = 0; bj < 2; ++bj)
#pragma unroll
                    for (int n = 0; n < 2; ++n) *(f32x4*)(rowp + bj * HALF + n * 16) = acc[ai][bj][m][n]; }
    }
};
template <class Epi, class Sched, bool ALIGN_EPI = false, bool SP2 = false>
__device__ __forceinline__ void gemm_phase(PG8_LAS unsigned char* lds, const Gemm g, const Sched& S, const Epi& E) {
    const int tid = opaque_tid(), wid = __builtin_amdgcn_readfirstlane(tid >> 6), lane = tid & 63, wr = wid >> 2, wc = wid & 3, fr = lane & 15, fq = lane >> 4;
    const int K = g.K, nt = K / BK;
    unsigned voffA[2], voffB[2];
#pragma unroll
    for (int i = 0; i < 2; ++i) { int R, C; stage_rc(tid * 16 + i * 8192, R, C); const int Rb = Epi::PERM ? ((R & ~31) + perm32(R & 31)) : R;
        voffA[i] = (unsigned)(R * K + C) * 2u; voffB[i] = (unsigned)(Rb * K + C) * 2u; }
    const size_t kstep = (size_t)(BK * 2);
    const size_t hstep = (size_t)HALF * K * 2;
    const size_t tstep = 2 * hstep;
    const unsigned ldsw = (unsigned)wid * 1024u;
    const int aoff = lds_byte(wr * 64 + fr, fq * 8), boff = lds_byte(wc * 32 + fr, fq * 8);
#define PG8_SA(b, h) (((b) * 2 + (h)) * HTB)
#define PG8_SB(b, h) ((4 + (b) * 2 + (h)) * HTB)
#define PG8_STAGE(bufoff, gbase, voff) do { _Pragma("unroll") for (int _i = 0; _i < 2; ++_i) \
        __builtin_amdgcn_global_load_lds((const unsigned*)((const char*)(gbase) + (voff)[_i]), (PG8_LAS unsigned*)(lds + (bufoff) + ldsw + _i * 8192), 16, 0, 0); } while (0)
#define PG8_LDA(dst, b, h) do { _Pragma("unroll") for (int m = 0; m < 4; ++m) _Pragma("unroll") for (int k = 0; k < 2; ++k) dst[m][k] = *(const PG8_LAS bf16x8*)(lds + PG8_SA(b, h) + aoff + m * 2048 + k * 1024); } while (0)
#define PG8_LDB(dst, b, h) do { _Pragma("unroll") for (int n = 0; n < 2; ++n) _Pragma("unroll") for (int k = 0; k < 2; ++k) dst[n][k] = *(const PG8_LAS bf16x8*)(lds + PG8_SB(b, h) + boff + n * 2048 + k * 1024); } while (0)
#define PG8_MMA(ai, bj, At, Bt) do { __builtin_amdgcn_s_setprio(1); _Pragma("unroll") for (int m = 0; m < 4; ++m) _Pragma("unroll") for (int n = 0; n < 2; ++n) _Pragma("unroll") for (int k = 0; k < 2; ++k) \
        acc[ai][bj][m][n] = __builtin_amdgcn_mfma_f32_16x16x32_bf16(Bt[n][k], At[m][k], acc[ai][bj][m][n], 0, 0, 0); __builtin_amdgcn_s_setprio(0); } while (0)
#define PG8_WAIT_V(n) asm volatile("s_waitcnt vmcnt(" #n ")" ::: "memory")
#define PG8_WAIT_L(n) asm volatile("s_waitcnt lgkmcnt(" #n ")" ::: "memory")
#define PG8_BAR __builtin_amdgcn_s_barrier()
#define PG8_SCHED __builtin_amdgcn_sched_barrier(0)
    Unit cur, nxt; int ui = 0;
    if (!S.next(0, cur)) return;
    f32x4 acc[2][2][4][2];
#pragma unroll
    for (int a = 0; a < 2; ++a)
#pragma unroll
        for (int b = 0; b < 2; ++b)
#pragma unroll
            for (int m = 0; m < 4; ++m)
#pragma unroll
                for (int n = 0; n < 2; ++n) acc[a][b][m][n] = (f32x4){0.f, 0.f, 0.f, 0.f};
    bf16x8 At[4][2], B0[2][2], B1[2][2];
    const char* cA = (const char*)g.A + (size_t)cur.pm * tstep; const char* cB = (const char*)g.Bt + (size_t)cur.pn * tstep;
    S.a_ready(cur);
    if constexpr (SP2) {
        PG8_STAGE(PG8_SB(0, 0), cB, voffB); PG8_STAGE(PG8_SB(0, 1), cB + hstep, voffB); PG8_STAGE(PG8_SA(0, 0), cA, voffA); PG8_STAGE(PG8_SA(0, 1), cA + hstep, voffA);
        if (wr == 1) PG8_BAR;
        PG8_WAIT_V(2); PG8_BAR;
        PG8_STAGE(PG8_SB(1, 0), cB + kstep, voffB); PG8_STAGE(PG8_SA(1, 0), cA + kstep, voffA); PG8_STAGE(PG8_SB(1, 1), cB + hstep + kstep, voffB);
        PG8_WAIT_V(6); PG8_BAR;
    } else {
        PG8_STAGE(PG8_SB(0, 0), cB, voffB); PG8_STAGE(PG8_SA(0, 0), cA, voffA); PG8_STAGE(PG8_SB(0, 1), cB + hstep, voffB); PG8_STAGE(PG8_SA(0, 1), cA + hstep, voffA);
        if (wr == 1) PG8_BAR;
        PG8_WAIT_V(4); PG8_BAR;
        PG8_STAGE(PG8_SB(1, 0), cB + kstep, voffB); PG8_STAGE(PG8_SA(1, 0), cA + kstep, voffA); PG8_STAGE(PG8_SB(1, 1), cB + hstep + kstep, voffB);
        PG8_WAIT_V(6); PG8_BAR;
    }
    for (;;) {
        const bool has_next = S.next(ui + 1, nxt);
        const char* nA = has_next ? (const char*)g.A + (size_t)nxt.pm * tstep : cA; const char* nB = has_next ? (const char*)g.Bt + (size_t)nxt.pn * tstep : cB;
        for (int t = 0; t < nt; t += 2) {
            const bool last = (t == nt - 2);
            const char* a1 = cA + (size_t)(t + 1) * kstep;
            const char* a2 = last ? nA : cA + (size_t)(t + 2) * kstep; const char* b2 = last ? nB : cB + (size_t)(t + 2) * kstep;
            const char* a3 = a2 + kstep; const char* b3 = b2 + kstep;
            if (last && has_next) S.a_ready(nxt);
            if constexpr (SP2) {
            PG8_LDB(B0, 0, 0); PG8_LDB(B1, 0, 1); PG8_SCHED; PG8_LDA(At, 0, 0); PG8_STAGE(PG8_SA(1, 1), a1 + hstep, voffA);
            PG8_WAIT_V(8); PG8_WAIT_L(0); PG8_BAR; PG8_MMA(0, 0, At, B0); PG8_MMA(0, 1, At, B1); PG8_BAR; PG8_SCHED;
            PG8_LDA(At, 0, 1); PG8_STAGE(PG8_SB(0, 0), b2, voffB); PG8_STAGE(PG8_SB(0, 1), b2 + hstep, voffB); PG8_STAGE(PG8_SA(0, 0), a2, voffA);
            PG8_WAIT_V(8); PG8_WAIT_L(0); PG8_BAR; PG8_MMA(1, 0, At, B0); PG8_MMA(1, 1, At, B1); PG8_BAR; PG8_SCHED;
            PG8_LDB(B0, 1, 0); PG8_LDB(B1, 1, 1); PG8_SCHED; PG8_LDA(At, 1, 0); PG8_STAGE(PG8_SA(0, 1), a2 + hstep, voffA);
            PG8_WAIT_V(8); PG8_WAIT_L(0); PG8_BAR; PG8_MMA(0, 0, At, B0); PG8_MMA(0, 1, At, B1); PG8_BAR; PG8_SCHED;
            PG8_LDA(At, 1, 1); PG8_STAGE(PG8_SB(1, 0), b3, voffB); PG8_STAGE(PG8_SB(1, 1), b3 + hstep, voffB); PG8_STAGE(PG8_SA(1, 0), a3, voffA);
            PG8_WAIT_V(8); PG8_WAIT_L(0); PG8_BAR; PG8_MMA(1, 0, At, B0); PG8_MMA(1, 1, At, B1); PG8_BAR; PG8_SCHED;
            } else {
            PG8_LDB(B0, 0, 0); PG8_SCHED; PG8_LDA(At, 0, 0); PG8_STAGE(PG8_SA(1, 1), a1 + hstep, voffA);
            PG8_WAIT_L(8); PG8_BAR; PG8_WAIT_L(0); PG8_MMA(0, 0, At, B0); PG8_BAR; PG8_SCHED;
            PG8_LDB(B1, 0, 1); PG8_STAGE(PG8_SB(0, 0), b2, voffB);
            PG8_BAR; PG8_WAIT_L(0); PG8_MMA(0, 1, At, B1); PG8_BAR;
            PG8_LDA(At, 0, 1); PG8_STAGE(PG8_SA(0, 0), a2, voffA);
            PG8_BAR; PG8_WAIT_L(0); PG8_MMA(1, 0, At, B0); PG8_BAR; PG8_SCHED;
            PG8_STAGE(PG8_SB(0, 1), b2 + hstep, voffB);
            PG8_WAIT_V(6); PG8_BAR; PG8_MMA(1, 1, At, B1); PG8_BAR;
            PG8_LDB(B0, 1, 0); PG8_SCHED; PG8_LDA(At, 1, 0); PG8_STAGE(PG8_SA(0, 1), a2 + hstep, voffA);
            PG8_WAIT_L(8); PG8_BAR; PG8_WAIT_L(0); PG8_MMA(0, 0, At, B0); PG8_BAR; PG8_SCHED;
            PG8_LDB(B1, 1, 1); PG8_STAGE(PG8_SB(1, 0), b3, voffB);
            PG8_BAR; PG8_WAIT_L(0); PG8_MMA(0, 1, At, B1); PG8_BAR;
            PG8_LDA(At, 1, 1); PG8_STAGE(PG8_SA(1, 0), a3, voffA);
            PG8_BAR; PG8_WAIT_L(0); PG8_MMA(1, 0, At, B0); PG8_BAR; PG8_SCHED;
            PG8_STAGE(PG8_SB(1, 1), b3 + hstep, voffB);
            PG8_WAIT_V(6); PG8_BAR; PG8_MMA(1, 1, At, B1); PG8_BAR;
            }
        }
        if constexpr (ALIGN_EPI) { if (wr == 0) PG8_BAR; }
        if constexpr (!Epi::AFTER_DRAIN) { E(acc, cur, wr, wc, fr, fq); S.done(cur); }
        if (!has_next) break;
#pragma unroll
        for (int a = 0; a < 2; ++a)
#pragma unroll
            for (int b = 0; b < 2; ++b)
#pragma unroll
                for (int m = 0; m < 4; ++m)
#pragma unroll
                    for (int n = 0; n < 2; ++n) acc[a][b][m][n] = (f32x4){0.f, 0.f, 0.f, 0.f};
        cur = nxt; cA = nA; cB = nB; ++ui;
        if constexpr (ALIGN_EPI) { if (wr == 1) PG8_BAR; }
    }
    PG8_WAIT_V(0);
    if constexpr (!ALIGN_EPI) { if (wr == 0) PG8_BAR; }
    PG8_BAR;
    if constexpr (Epi::AFTER_DRAIN) { E.fused(acc, cur, wr, wc, fr, fq, lds, wid, lane); S.done(cur); }
#undef PG8_SA
#undef PG8_SB
#undef PG8_STAGE
#undef PG8_LDA
#undef PG8_LDB
#undef PG8_MMA
#undef PG8_WAIT_V
#undef PG8_WAIT_L
#undef PG8_BAR
#undef PG8_SCHED
}
}
#define LAS __attribute__((address_space(3)))
#define BID opaque_bid()
#define GRD opaque_grid()
typedef unsigned short bf16_t;
typedef short bf16x8 __attribute__((ext_vector_type(8)));
typedef short s16x4 __attribute__((ext_vector_type(4)));
typedef float f32x4 __attribute__((ext_vector_type(4)));
typedef float f32x2 __attribute__((ext_vector_type(2)));
typedef float f32x16 __attribute__((ext_vector_type(16)));
typedef unsigned u32x4 __attribute__((ext_vector_type(4)));
typedef unsigned u32x2 __attribute__((ext_vector_type(2)));

constexpr int NB = 8, SEQ = 2048, NMETA = 16, LSEQ = SEQ + NMETA  , LP = 2112  , DM = 1024;
constexpr int MROWS = NB * LP;
constexpr int FOX_IN = 4112, RWKV_IN = 4224;
constexpr float NORM_EPS = 1e-6f, GN_EPS = 64e-5f, LOG2E = 1.4426950408889634f;
constexpr float DECAY_SCALE = 0.6065306597126334f;
constexpr int LDS_BYTES = 147456;
constexpr size_t MiB = 1u << 20;
constexpr size_t WS_WIN = 1 * MiB;
constexpr size_t WS_WOUT = 10 * MiB;
constexpr size_t WS_HMETA = 12 * MiB;
constexpr size_t WS_CUM = 13 * MiB;
constexpr size_t WS_PL = 15 * MiB;
constexpr size_t WS_B = 24 * MiB;
constexpr size_t WS_C = 57 * MiB;
constexpr size_t WS_LD = 189 * MiB;
constexpr size_t WS_AA = 222 * MiB;
constexpr size_t WS_END = 255 * MiB;
static_assert(WS_B + (size_t)MROWS * 1024 * 2 <= WS_C && WS_C + (size_t)MROWS * 4096 * 2 <= WS_LD && WS_LD + (size_t)MROWS * 2048 <= WS_AA && WS_AA + (size_t)MROWS * 2048 <= WS_END, "ws map");
static_assert(WS_PL + (size_t)MROWS * 512 <= WS_B && WS_CUM + (size_t)MROWS * 64 <= WS_PL, "ws map 2");

struct Params {
    const float *x, *meta, *norm_pre, *norm_post, *fox_w_in, *fox_b_f, *fox_w_out, *rwkv_w_in, *rwkv_mu, *rwkv_w0, *rwkv_w_up, *rwkv_a0, *rwkv_a_up,
        *rwkv_k_k, *rwkv_k_a, *rwkv_r_k, *rwkv_ln_w, *rwkv_ln_b, *rwkv_w_out;
    float* out; unsigned char* ws;
};

__device__ __forceinline__ float wave_sum(float v) {
#pragma unroll
    for (int o = 1; o < 64; o <<= 1) v += __shfl_xor(v, o);
    return v;
}
__device__ __forceinline__ unsigned pk2(float lo, float hi) { return pg8::pk2(lo, hi); }
__device__ __forceinline__ float bflo(unsigned w) { return __uint_as_float(w << 16); }
__device__ __forceinline__ float bfhi(unsigned w) { return __uint_as_float(w & 0xffff0000u); }
template <int CTRL> __device__ __forceinline__ float dppf(float v) { return __int_as_float(__builtin_amdgcn_update_dpp(0, __float_as_int(v), CTRL, 0xF, 0xF, true)); }
__device__ __forceinline__ float red16(float v) {
    v += dppf<0xB1>(v); v += dppf<0x4E>(v); v += dppf<0x141>(v); v += dppf<0x140>(v); return v;
}
__device__ __forceinline__ float sigmoidf_(float x) { return 1.f / (1.f + __expf(-x)); }
#define LDS_WAIT() asm volatile("s_waitcnt lgkmcnt(0)" ::: "memory")

__device__ __forceinline__ void transpose_item(const float* W, int ldw, bf16_t* WT, LAS float* scr, int kb, int nb, int lane) {
    const int k0 = 64 * kb, n0 = 32 * nb;
#pragma unroll 8
    for (int i = 0; i < 32; ++i) { const int kk = 2 * i + (lane >> 5); scr[kk * 33 + (lane & 31)] = W[(size_t)(k0 + kk) * ldw + n0 + (lane & 31)]; }
    LDS_WAIT();
    const int c = lane & 7;
#pragma unroll
    for (int j = 0; j < 4; ++j) { const int n = (lane >> 3) + 8 * j; const LAS float* s = scr + (8 * c) * 33 + n;
        u32x4 o; o.x = pk2(s[0 * 33], s[1 * 33]); o.y = pk2(s[2 * 33], s[3 * 33]); o.z = pk2(s[4 * 33], s[5 * 33]); o.w = pk2(s[6 * 33], s[7 * 33]);
        *(u32x4*)(WT + (size_t)(n0 + n) * 1024 + k0 + 8 * c) = o; }
    LDS_WAIT();
}

template <int MODE>
__device__ __forceinline__ void phase_e(const Params& p, LAS unsigned char* lds, int next, int prev) {
    const int tid = opaque_tid(), lane = tid & 63, wave = __builtin_amdgcn_readfirstlane(tid >> 6);
    const int G = GRD, gw = BID * 8 + wave, NGW = G * 8;
    bf16_t* U = (bf16_t*)(p.ws + WS_B);
    float* CUM = (float*)(p.ws + WS_CUM);
    float* HMETA = (float*)(p.ws + WS_HMETA);
    const float* MB = (const float*)(p.ws + WS_C);
    const bool next_fox = (next >= 0) && ((next & 1) == 0);
    LAS float* WfT = (LAS float*)lds;
    LAS float* scr = (LAS float*)(lds + 65536 + wave * 8448);
    if (next >= 0) {
        const int jn = next >> 1;
        bf16_t* WIN = (bf16_t*)(p.ws + WS_WIN); bf16_t* WOUT = (bf16_t*)(p.ws + WS_WOUT);
        if (next_fox) {
            const float* Wf = p.fox_w_in + (size_t)jn * 1024 * FOX_IN + 4096;
            for (int i = tid; i < 4096; i += 512) { const int k = i >> 2, q = i & 3; const f32x4 v = *(const f32x4*)(Wf + (size_t)k * FOX_IN + 4 * q);
                WfT[(4 * q + 0) * 1024 + k] = v[0]; WfT[(4 * q + 1) * 1024 + k] = v[1]; WfT[(4 * q + 2) * 1024 + k] = v[2]; WfT[(4 * q + 3) * 1024 + k] = v[3]; }
            const float* W = p.fox_w_in + (size_t)jn * 1024 * FOX_IN; const float* Wo = p.fox_w_out + (size_t)jn * 1024 * 1024;
            for (int it = gw; it < 16 * 128 + 16 * 32; it += NGW) {
                if (it < 16 * 128) transpose_item(W, FOX_IN, WIN, scr, it / 128, it % 128, lane);
                else { const int r = it - 16 * 128; transpose_item(Wo, 1024, WOUT, scr, r / 32, r % 32, lane); }
            }
        } else {
            const float* W = p.rwkv_w_in + (size_t)jn * 1024 * RWKV_IN; const float* Wo = p.rwkv_w_out + (size_t)jn * 1024 * 1024;
            for (int it = gw; it < 16 * 132 + 16 * 32; it += NGW) {
                if (it < 16 * 132) transpose_item(W, RWKV_IN, WIN, scr, it / 132, it % 132, lane);
                else { const int r = it - 16 * 132; transpose_item(Wo, 1024, WOUT, scr, r / 32, r % 32, lane); }
            }
            for (int i = BID * 512 + tid; i < 16384; i += G * 512) *(u32x4*)(WIN + (size_t)4224 * 1024 + (size_t)i * 8) = (u32x4){0u, 0u, 0u, 0u};
        }
    }
    __syncthreads();
    f32x4 gpo[4], gpr[4];
#pragma unroll
    for (int j = 0; j < 4; ++j) {
        gpo[j] = (MODE == 1) ? *((const f32x4*)(p.norm_post + (size_t)prev * 1024) + lane + 64 * j) : (f32x4){0.f, 0.f, 0.f, 0.f};
        gpr[j] = (next >= 0) ? *((const f32x4*)(p.norm_pre + (size_t)next * 1024) + lane + 64 * j) : (f32x4){0.f, 0.f, 0.f, 0.f};
    }
    const float bfv = (next_fox && lane < 16) ? p.fox_b_f[(next >> 1) * 16 + lane] : 0.f;
    for (int m = gw; m < MROWS; m += NGW) {
        const int b = m / LP, t = m - b * LP;
        if (t >= LSEQ) {
            if (next >= 0) { u32x2* o8 = (u32x2*)(U + (size_t)m * 1024) + lane;
#pragma unroll
                for (int j = 0; j < 4; ++j) o8[64 * j] = (u32x2){0u, 0u};
                if (next_fox && lane < 16) CUM[(size_t)m * 16 + lane] = 0.f; }
            continue;
        }
        float* hrow = (t < NMETA) ? HMETA + (size_t)(b * NMETA + t) * 1024 : p.out + ((size_t)b * SEQ + (t - NMETA)) * 1024;
        f32x4 v[4];
        if (MODE == 0) {
            const float* src = (t < NMETA) ? p.meta + (size_t)t * 1024 : p.x + ((size_t)b * SEQ + (t - NMETA)) * 1024;
#pragma unroll
            for (int j = 0; j < 4; ++j) v[j] = *((const f32x4*)src + lane + 64 * j);
        } else {
            f32x4 mv[4]; float ss = 0.f;
#pragma unroll
            for (int j = 0; j < 4; ++j) { v[j] = *((const f32x4*)hrow + lane + 64 * j); mv[j] = *((const f32x4*)(MB + (size_t)m * 1024) + lane + 64 * j);
                ss += (mv[j][0] * mv[j][0] + mv[j][1] * mv[j][1]) + (mv[j][2] * mv[j][2] + mv[j][3] * mv[j][3]); }
            const float rs = 1.0f / sqrtf(wave_sum(ss) * (1.f / 1024.f) + NORM_EPS);
#pragma unroll
            for (int j = 0; j < 4; ++j) v[j] = v[j] + mv[j] * rs * gpo[j];
        }
#pragma unroll
        for (int j = 0; j < 4; ++j) *((f32x4*)hrow + lane + 64 * j) = v[j];
        if (next >= 0) {
            float ss = 0.f;
#pragma unroll
            for (int j = 0; j < 4; ++j) ss += (v[j][0] * v[j][0] + v[j][1] * v[j][1]) + (v[j][2] * v[j][2] + v[j][3] * v[j][3]);
            const float rs = 1.0f / sqrtf(wave_sum(ss) * (1.f / 1024.f) + NORM_EPS);
            u32x2* o8 = (u32x2*)(U + (size_t)m * 1024) + lane;
#pragma unroll
            for (int j = 0; j < 4; ++j) { v[j] = v[j] * rs * gpr[j]; o8[64 * j] = (u32x2){pk2(v[j][0], v[j][1]), pk2(v[j][2], v[j][3])}; }
            if (next_fox) {
                float mine = 0.f;
#pragma unroll
                for (int hd = 0; hd < 16; ++hd) { float s = 0.f;
#pragma unroll
                    for (int j = 0; j < 4; ++j) { const f32x4 w = *((const LAS f32x4*)(WfT + hd * 1024) + lane + 64 * j); s += (v[j][0] * w[0] + v[j][1] * w[1]) + (v[j][2] * w[2] + v[j][3] * w[3]); }
                    s = wave_sum(s); if (lane == hd) mine = s; }
                if (lane < 16) { const float xx = mine + bfv; const float lf = fminf(xx, 0.f) - log1pf(__expf(-fabsf(xx))); CUM[(size_t)m * 16 + lane] = lf * LOG2E; }
            }
        }
    }
}

__device__ __forceinline__ void phase_cumsum(const Params& p, LAS unsigned char* lds) {
    const int tid = opaque_tid(); LAS float* s = (LAS float*)lds;
    float* CUM = (float*)(p.ws + WS_CUM);
    for (int j = BID; j < 128; j += GRD) {
        const int b = j >> 4, hd = j & 15; float* base = CUM + (size_t)b * LP * 16 + hd;
        float v[5]; float tot = 0.f;
#pragma unroll
        for (int e = 0; e < 5; ++e) { const int t = tid * 5 + e; v[e] = (t < LP) ? base[(size_t)t * 16] : 0.f; tot += v[e]; }
        s[tid] = tot; __syncthreads();
        for (int off = 1; off < 512; off <<= 1) { const float a = (tid >= off) ? s[tid - off] : 0.f; __syncthreads(); s[tid] += a; __syncthreads(); }
        float run = s[tid] - tot;
#pragma unroll
        for (int e = 0; e < 5; ++e) { const int t = tid * 5 + e; run += v[e]; if (t < LP) base[(size_t)t * 16] = run; }
        __syncthreads();
    }
}

__device__ __forceinline__ void phase_attn(const Params& p, LAS unsigned char* lds) {
    const int tid = opaque_tid(), lane = tid & 63, wid = __builtin_amdgcn_readfirstlane(tid >> 6), r32 = lane & 31, hi = lane >> 5;
    LAS bf16_t* Ks = (LAS bf16_t*)lds;
    LAS bf16_t* Vt = Ks + 2 * 64 * 72;
    LAS float* cks = (LAS float*)(lds + 2 * 2 * 64 * 72 * 2);
    const bf16_t* P = (const bf16_t*)(p.ws + WS_C);
    const float* CUM = (const float*)(p.ws + WS_CUM);
    bf16_t* OG = (bf16_t*)(p.ws + WS_B);
    const int kr = tid >> 3, kc = tid & 7;
    for (int u = BID; u < 1152; u += GRD) {
        const int qb = 8 - u / 128, bh = u % 128, b = bh >> 4, h = bh & 15;
        const int q0 = qb * 256;
        int NT = (q0 + 256) / 64; if (NT > LP / 64) NT = LP / 64;
        const int qw0 = q0 + 32 * wid;
        const bool active = qw0 < LP;
        const int jmax = (qw0 + 31) >> 6;
        const size_t rowb = (size_t)b * LP;
        bf16x8 qr[4];
#pragma unroll
        for (int d0 = 0; d0 < 4; ++d0) qr[d0] = active ? *(const bf16x8*)(P + (rowb + qw0 + r32) * 4096 + h * 64 + d0 * 16 + hi * 8) : (bf16x8){0, 0, 0, 0, 0, 0, 0, 0};
        const bf16_t* kg = P + (rowb + kr) * 4096 + 1024 + h * 64 + kc * 8;
        const bf16_t* vg = kg + 1024;
        const float* cgp = CUM + (rowb + (tid & 63)) * 16 + h;
        u32x4 kreg = *(const u32x4*)kg, vreg = *(const u32x4*)vg; float creg = (tid < 64) ? cgp[0] : 0.f;
#define STORE_TILE(buf) do { *(LAS u32x4*)(Ks + (buf) * 4608 + kr * 72 + kc * 8) = kreg; \
        LAS bf16_t* vt_ = Vt + (buf) * 4608 + (kc * 8) * 72 + kr; \
        vt_[0 * 72] = (bf16_t)(vreg.x & 0xffffu); vt_[1 * 72] = (bf16_t)(vreg.x >> 16); vt_[2 * 72] = (bf16_t)(vreg.y & 0xffffu); vt_[3 * 72] = (bf16_t)(vreg.y >> 16); \
        vt_[4 * 72] = (bf16_t)(vreg.z & 0xffffu); vt_[5 * 72] = (bf16_t)(vreg.z >> 16); vt_[6 * 72] = (bf16_t)(vreg.w & 0xffffu); vt_[7 * 72] = (bf16_t)(vreg.w >> 16); \
        if (tid < 64) cks[(buf) * 64 + tid] = creg; } while (0)
        STORE_TILE(0);
        __syncthreads();
        float m_run = -INFINITY, l_run = 0.f;
        f32x16 o0, o1;
#pragma unroll
        for (int r = 0; r < 16; ++r) { o0[r] = 0.f; o1[r] = 0.f; }
        for (int j = 0; j < NT; ++j) {
            const int buf = j & 1;
            if (j + 1 < NT) { kreg = *(const u32x4*)(kg + (size_t)(j + 1) * 64 * 4096); vreg = *(const u32x4*)(vg + (size_t)(j + 1) * 64 * 4096); if (tid < 64) creg = cgp[(size_t)(j + 1) * 64 * 16]; }
            if (active && j <= jmax) {
                const LAS bf16_t* Kb = Ks + buf * 4608; const LAS bf16_t* Vb = Vt + buf * 4608; const LAS float* cb = cks + buf * 64;
                f32x16 p0, p1;
#pragma unroll
                for (int i = 0; i < 4; ++i) { const f32x4 c0 = *(const LAS f32x4*)(cb + 8 * i + 4 * hi), c1 = *(const LAS f32x4*)(cb + 32 + 8 * i + 4 * hi);
#pragma unroll
                    for (int e = 0; e < 4; ++e) { p0[4 * i + e] = -c0[e]; p1[4 * i + e] = -c1[e]; } }
#pragma unroll
                for (int d0 = 0; d0 < 4; ++d0) {
                    const bf16x8 a0 = *(const LAS bf16x8*)(Kb + r32 * 72 + d0 * 16 + hi * 8), a1 = *(const LAS bf16x8*)(Kb + (32 + r32) * 72 + d0 * 16 + hi * 8);
                    p0 = __builtin_amdgcn_mfma_f32_32x32x16_bf16(a0, qr[d0], p0, 0, 0, 0); p1 = __builtin_amdgcn_mfma_f32_32x32x16_bf16(a1, qr[d0], p1, 0, 0, 0);
                }
                if (64 * j + 63 > qw0) {
                    const int qpos = qw0 + r32;
#pragma unroll
                    for (int r = 0; r < 16; ++r) { const int kv = 64 * j + (r & 3) + 8 * (r >> 2) + 4 * hi; if (kv > qpos) p0[r] = -INFINITY; if (kv + 32 > qpos) p1[r] = -INFINITY; }
                }
                float mx = fmaxf(p0[0], p1[0]);
#pragma unroll
                for (int r = 1; r < 16; ++r) mx = fmaxf(mx, fmaxf(p0[r], p1[r]));
                mx = fmaxf(mx, __shfl_xor(mx, 32));
                const float m_new = fmaxf(m_run, mx);
                const float alpha = __builtin_amdgcn_exp2f(m_run - m_new);
                m_run = m_new;
                float sum = 0.f;
#pragma unroll
                for (int r = 0; r < 16; ++r) { p0[r] = __builtin_amdgcn_exp2f(p0[r] - m_new); p1[r] = __builtin_amdgcn_exp2f(p1[r] - m_new); sum += p0[r] + p1[r]; }
                l_run = l_run * alpha + sum;
#pragma unroll
                for (int r = 0; r < 16; ++r) { o0[r] *= alpha; o1[r] *= alpha; }
#pragma unroll
                for (int c = 0; c < 4; ++c) {
                    u32x4 pw;
                    if (c < 2) { pw.x = pk2(p0[8 * c + 0], p0[8 * c + 1]); pw.y = pk2(p0[8 * c + 2], p0[8 * c + 3]); pw.z = pk2(p0[8 * c + 4], p0[8 * c + 5]); pw.w = pk2(p0[8 * c + 6], p0[8 * c + 7]); }
                    else { const int c2 = c - 2; pw.x = pk2(p1[8 * c2 + 0], p1[8 * c2 + 1]); pw.y = pk2(p1[8 * c2 + 2], p1[8 * c2 + 3]); pw.z = pk2(p1[8 * c2 + 4], p1[8 * c2 + 5]); pw.w = pk2(p1[8 * c2 + 6], p1[8 * c2 + 7]); }
                    const bf16x8 pf = __builtin_bit_cast(bf16x8, pw);
                    {   const s16x4 lo = *(const LAS s16x4*)(Vb + r32 * 72 + 16 * c + 4 * hi), h4 = *(const LAS s16x4*)(Vb + r32 * 72 + 16 * c + 4 * hi + 8);
                        const bf16x8 vf = (bf16x8){lo[0], lo[1], lo[2], lo[3], h4[0], h4[1], h4[2], h4[3]};
                        o0 = __builtin_amdgcn_mfma_f32_32x32x16_bf16(vf, pf, o0, 0, 0, 0); }
                    {   const s16x4 lo = *(const LAS s16x4*)(Vb + (32 + r32) * 72 + 16 * c + 4 * hi), h4 = *(const LAS s16x4*)(Vb + (32 + r32) * 72 + 16 * c + 4 * hi + 8);
                        const bf16x8 vf = (bf16x8){lo[0], lo[1], lo[2], lo[3], h4[0], h4[1], h4[2], h4[3]};
                        o1 = __builtin_amdgcn_mfma_f32_32x32x16_bf16(vf, pf, o1, 0, 0, 0); }
                }
            }
            if (j + 1 < NT) STORE_TILE(buf ^ 1);
            __syncthreads();
        }
#undef STORE_TILE
        if (active) {
            const float l = l_run + __shfl_xor(l_run, 32); const float inv = 1.f / l;
            const size_t row = rowb + qw0 + r32;
#pragma unroll
            for (int dh = 0; dh < 2; ++dh)
#pragma unroll
                for (int i = 0; i < 4; ++i) {
                    const int dcol = h * 64 + 32 * dh + 8 * i + 4 * hi;
                    const u32x2 gw_ = *(const u32x2*)(P + row * 4096 + 3072 + dcol);
                    const float g0 = bflo(gw_.x), g1 = bfhi(gw_.x), g2 = bflo(gw_.y), g3 = bfhi(gw_.y);
                    const float a0 = (dh ? o1[4 * i + 0] : o0[4 * i + 0]) * inv, a1 = (dh ? o1[4 * i + 1] : o0[4 * i + 1]) * inv, a2 = (dh ? o1[4 * i + 2] : o0[4 * i + 2]) * inv, a3 = (dh ? o1[4 * i + 3] : o0[4 * i + 3]) * inv;
                    u32x2 w; w.x = pk2(a0 * g0 * sigmoidf_(g0), a1 * g1 * sigmoidf_(g1)); w.y = pk2(a2 * g2 * sigmoidf_(g2), a3 * g3 * sigmoidf_(g3));
                    *(u32x2*)(OG + row * 1024 + dcol) = w;
                }
        }
    }
}

__device__ __forceinline__ void phase_lora(const Params& p, LAS unsigned char* lds, int jr) {
    const int tid = opaque_tid();
    LAS float* tw = (LAS float*)lds;
    LAS float* ad = tw + 1024;
    const bf16_t* PL = (const bf16_t*)(p.ws + WS_PL);
    bf16_t* LD = (bf16_t*)(p.ws + WS_LD); bf16_t* AA = (bf16_t*)(p.ws + WS_AA);
    const float* mu = p.rwkv_mu + (size_t)jr * RWKV_IN + 4096;
    const float* w_up = p.rwkv_w_up + (size_t)jr * 64 * 1024; const float* a_up = p.rwkv_a_up + (size_t)jr * 64 * 1024;
    const int c0 = tid, c1 = tid + 512;
    const float w00 = p.rwkv_w0[jr * 1024 + c0], w01 = p.rwkv_w0[jr * 1024 + c1], a00 = p.rwkv_a0[jr * 1024 + c0], a01 = p.rwkv_a0[jr * 1024 + c1];
    const int st = tid >> 5, scq = tid & 31;
    const f32x4 mu4 = *(const f32x4*)(mu + 4 * scq);
    for (int tile = BID; tile < MROWS / 16; tile += GRD) {
        const int m0 = tile * 16;
        {   const int row = m0 + st, tpos = row % LP;
            const u32x2 cw = *(const u32x2*)(PL + (size_t)row * 256 + 4 * scq);
            u32x2 pw = (u32x2){0u, 0u}; if (tpos > 0) pw = *(const u32x2*)(PL + (size_t)(row - 1) * 256 + 4 * scq);
            float cv[4] = {bflo(cw.x), bfhi(cw.x), bflo(cw.y), bfhi(cw.y)}, pv[4] = {bflo(pw.x), bfhi(pw.x), bflo(pw.y), bfhi(pw.y)};
#pragma unroll
            for (int e = 0; e < 4; ++e) { const int c = 4 * scq + e; const float val = cv[e] + (pv[e] - cv[e]) * mu4[e];
                if (c < 64) tw[c * 16 + st] = tanhf(val); else ad[(c - 64) * 16 + st] = val; }
        }
        __syncthreads();
        float wa0[16], wa1[16], aa0[16], aa1[16];
#pragma unroll
        for (int t = 0; t < 16; ++t) { wa0[t] = 0.f; wa1[t] = 0.f; aa0[t] = 0.f; aa1[t] = 0.f; }
#pragma unroll 2
        for (int j = 0; j < 64; ++j) {
            const float wu0 = w_up[j * 1024 + c0], wu1 = w_up[j * 1024 + c1], au0 = a_up[j * 1024 + c0], au1 = a_up[j * 1024 + c1];
#pragma unroll
            for (int q = 0; q < 4; ++q) { const f32x4 t4 = *(const LAS f32x4*)(tw + j * 16 + 4 * q), a4 = *(const LAS f32x4*)(ad + j * 16 + 4 * q);
#pragma unroll
                for (int e = 0; e < 4; ++e) { wa0[4 * q + e] += t4[e] * wu0; wa1[4 * q + e] += t4[e] * wu1; aa0[4 * q + e] += a4[e] * au0; aa1[4 * q + e] += a4[e] * au1; } }
        }
#pragma unroll
        for (int t = 0; t < 16; ++t) { const size_t row = (size_t)(m0 + t);
            LD[row * 1024 + c0] = (bf16_t)(pk2(-DECAY_SCALE * LOG2E * sigmoidf_(w00 + wa0[t]), 0.f) & 0xffffu);
            LD[row * 1024 + c1] = (bf16_t)(pk2(-DECAY_SCALE * LOG2E * sigmoidf_(w01 + wa1[t]), 0.f) & 0xffffu);
            AA[row * 1024 + c0] = (bf16_t)(pk2(sigmoidf_(a00 + aa0[t]), 0.f) & 0xffffu);
            AA[row * 1024 + c1] = (bf16_t)(pk2(sigmoidf_(a01 + aa1[t]), 0.f) & 0xffffu); }
        __syncthreads();
    }
}

__device__ __forceinline__ void phase_scan(const Params& p, LAS unsigned char* lds, int jr) {
    const int tid = opaque_tid(), lane = tid & 63, wid = __builtin_amdgcn_readfirstlane(tid >> 6);
    LAS float* vec = (LAS float*)lds;
    LAS float* ypart = vec + 2 * 6144;
    const bf16_t* P = (const bf16_t*)(p.ws + WS_C);
    const bf16_t* LD = (const bf16_t*)(p.ws + WS_LD); const bf16_t* AA = (const bf16_t*)(p.ws + WS_AA);
    bf16_t* Y = (bf16_t*)(p.ws + WS_B);
    constexpr int NCH = 130;
    const int ht = tid & 255, ds = ht >> 4, kq = lane & 15, rl = lane >> 4;
    for (int u = BID; u < 256; u += GRD) {
        const int bh = u >> 1, half = u & 1, b = bh >> 4, h = bh & 15;
        const int kcol = h * 64 + 4 * kq;
        const float* mu = p.rwkv_mu + (size_t)jr * RWKV_IN;
        f32x4 mur, muk, muv, kk4, ka4;
        u32x2 rw, kw, vw, rp, kp_, vp, lw, aw;
        if (wid >= 4) { mur = *(const f32x4*)(mu + kcol); muk = *(const f32x4*)(mu + 1024 + kcol); muv = *(const f32x4*)(mu + 2048 + kcol);
            kk4 = *(const f32x4*)(p.rwkv_k_k + jr * 1024 + kcol); ka4 = *(const f32x4*)(p.rwkv_k_a + jr * 1024 + kcol); }
#define SC_LOADRAW(ch) do { const int t_ = (ch) * 16 + ds; const size_t row_ = (size_t)b * LP + t_; const bf16_t* pr_ = P + row_ * 4096 + kcol; \
        rw = *(const u32x2*)pr_; kw = *(const u32x2*)(pr_ + 1024); vw = *(const u32x2*)(pr_ + 2048); \
        rp = (u32x2){0u, 0u}; kp_ = rp; vp = rp; \
        if (t_ > 0) { rp = *(const u32x2*)(pr_ - 4096); kp_ = *(const u32x2*)(pr_ - 4096 + 1024); vp = *(const u32x2*)(pr_ - 4096 + 2048); } \
        lw = *(const u32x2*)(LD + row_ * 1024 + kcol); aw = *(const u32x2*)(AA + row_ * 1024 + kcol); } while (0)
#define SC_DERIVE(buf) do { \
        const f32x4 rc = {bflo(rw.x), bfhi(rw.x), bflo(rw.y), bfhi(rw.y)}, kc_ = {bflo(kw.x), bfhi(kw.x), bflo(kw.y), bfhi(kw.y)}, vc = {bflo(vw.x), bfhi(vw.x), bflo(vw.y), bfhi(vw.y)}; \
        const f32x4 rpv = {bflo(rp.x), bfhi(rp.x), bflo(rp.y), bfhi(rp.y)}, kpv = {bflo(kp_.x), bfhi(kp_.x), bflo(kp_.y), bfhi(kp_.y)}, vpv = {bflo(vp.x), bfhi(vp.x), bflo(vp.y), bfhi(vp.y)}; \
        const f32x4 ldv = {bflo(lw.x), bfhi(lw.x), bflo(lw.y), bfhi(lw.y)}, av = {bflo(aw.x), bfhi(aw.x), bflo(aw.y), bfhi(aw.y)}; \
        const f32x4 rlp = rc + (rpv - rc) * mur, klp = kc_ + (kpv - kc_) * muk, vlp = vc + (vpv - vc) * muv; \
        const f32x4 kkv = klp * kk4; \
        float ss = (kkv[0] * kkv[0] + kkv[1] * kkv[1]) + (kkv[2] * kkv[2] + kkv[3] * kkv[3]); \
        ss = red16(ss); \
        const float inv = 1.f / fmaxf(sqrtf(ss), 1e-12f); \
        const f32x4 kkn = kkv * inv; \
        const f32x4 kpr = klp * (1.f + (av - 1.f) * ka4); \
        f32x4 wv; wv[0] = __builtin_amdgcn_exp2f(ldv[0]); wv[1] = __builtin_amdgcn_exp2f(ldv[1]); wv[2] = __builtin_amdgcn_exp2f(ldv[2]); wv[3] = __builtin_amdgcn_exp2f(ldv[3]); \
        LAS float* vs = vec + (buf) * 6144 + ds * 384 + 4 * kq; \
        *(LAS f32x4*)(vs) = wv; *(LAS f32x4*)(vs + 64) = -kkn; *(LAS f32x4*)(vs + 128) = kkn * av; *(LAS f32x4*)(vs + 192) = kpr; *(LAS f32x4*)(vs + 256) = rlp; *(LAS f32x4*)(vs + 320) = vlp; } while (0)
#define SC_YREDUCE(chunk, buf) do { \
        _Pragma("unroll") for (int j_ = 0; j_ < 8; ++j_) { const int idx_ = ht + 256 * j_; \
            const f32x4 x_ = *(const LAS f32x4*)(ypart + (buf) * 8192 + idx_ * 4); \
            float pa_ = x_[0] + x_[2], pb_ = x_[1] + x_[3]; \
            pa_ += dppf<0xB1>(pa_); pb_ += dppf<0xB1>(pb_); pa_ += dppf<0x4E>(pa_); pb_ += dppf<0x4E>(pb_); pa_ += dppf<0x141>(pa_); pb_ += dppf<0x141>(pb_); \
            if ((ht & 7) == 0) { const int g_ = idx_ >> 3, s_ = g_ >> 4, cw_ = (g_ >> 2) & 3, rl_ = g_ & 3; \
                *(unsigned*)(Y + ((size_t)b * LP + (chunk) * 16 + s_) * 1024 + h * 64 + 32 * half + 8 * cw_ + 2 * rl_) = pk2(pa_, pb_); } } } while (0)
        if (wid >= 4) { SC_LOADRAW(0); SC_DERIVE(0); SC_LOADRAW(1); }
        __syncthreads();
        f32x4 SA = {0.f, 0.f, 0.f, 0.f}, SB = {0.f, 0.f, 0.f, 0.f};
        if (wid < 4) __builtin_amdgcn_s_setprio(2);
        for (int ch = 0; ch < NCH; ++ch) {
            const int buf = ch & 1;
            if (wid < 4) {
                const LAS float* vb = vec + buf * 6144 + 4 * kq;
                const LAS float* vvp = vec + buf * 6144 + 320 + 32 * half + 8 * wid + 2 * rl;
                LAS float* yp = ypart + buf * 8192 + (wid * 64 + lane) * 2;
                f32x4 w4 = *(const LAS f32x4*)(vb), a4 = *(const LAS f32x4*)(vb + 64), b4 = *(const LAS f32x4*)(vb + 128), k4 = *(const LAS f32x4*)(vb + 192), r4 = *(const LAS f32x4*)(vb + 256);
                f32x2 vv = *(const LAS f32x2*)(vvp);
#pragma unroll
                for (int s = 0; s < 16; ++s) {
                    f32x4 nw = w4, na = a4, nb = b4, nk = k4, nr = r4; f32x2 nv = vv;
                    if (s < 15) { nw = *(const LAS f32x4*)(vb + (s + 1) * 384); na = *(const LAS f32x4*)(vb + (s + 1) * 384 + 64); nb = *(const LAS f32x4*)(vb + (s + 1) * 384 + 128);
                        nk = *(const LAS f32x4*)(vb + (s + 1) * 384 + 192); nr = *(const LAS f32x4*)(vb + (s + 1) * 384 + 256); nv = *(const LAS f32x2*)(vvp + (s + 1) * 384); }
                    float saA = __builtin_fmaf(SA[3], a4[3], __builtin_fmaf(SA[2], a4[2], __builtin_fmaf(SA[1], a4[1], SA[0] * a4[0])));
                    float saB = __builtin_fmaf(SB[3], a4[3], __builtin_fmaf(SB[2], a4[2], __builtin_fmaf(SB[1], a4[1], SB[0] * a4[0])));
                    saA += dppf<0xB1>(saA); saB += dppf<0xB1>(saB); saA += dppf<0x4E>(saA); saB += dppf<0x4E>(saB);
                    saA += dppf<0x141>(saA); saB += dppf<0x141>(saB); saA += dppf<0x140>(saA); saB += dppf<0x140>(saB);
                    SA = SA * w4 + vv[0] * k4 + saA * b4; SB = SB * w4 + vv[1] * k4 + saB * b4;
                    const float yA = __builtin_fmaf(SA[3], r4[3], __builtin_fmaf(SA[2], r4[2], __builtin_fmaf(SA[1], r4[1], SA[0] * r4[0])));
                    const float yB = __builtin_fmaf(SB[3], r4[3], __builtin_fmaf(SB[2], r4[2], __builtin_fmaf(SB[1], r4[1], SB[0] * r4[0])));
                    *(LAS f32x2*)(yp + s * 512) = (f32x2){yA, yB};
                    w4 = nw; a4 = na; b4 = nb; k4 = nk; r4 = nr; vv = nv;
                }
            } else {
                if (ch + 1 < NCH) SC_DERIVE(buf ^ 1);
                if (ch + 2 < NCH) SC_LOADRAW(ch + 2);
                if (ch > 0) SC_YREDUCE(ch - 1, buf ^ 1);
            }
            __syncthreads();
        }
        if (wid < 4) __builtin_amdgcn_s_setprio(0);
        else SC_YREDUCE(NCH - 1, (NCH - 1) & 1);
        __syncthreads();
#undef SC_LOADRAW
#undef SC_DERIVE
#undef SC_YREDUCE
    }
}

__device__ __forceinline__ void phase_r4(const Params& p, int jr) {
    const int tid = opaque_tid(), lane = tid & 63, wave = __builtin_amdgcn_readfirstlane(tid >> 6);
    const int gw = BID * 8 + wave, NGW = GRD * 8;
    const bf16_t* P = (const bf16_t*)(p.ws + WS_C); const bf16_t* AA = (const bf16_t*)(p.ws + WS_AA); const bf16_t* Y = (const bf16_t*)(p.ws + WS_B);
    bf16_t* YG = (bf16_t*)(p.ws + WS_LD);
    const float* mu = p.rwkv_mu + (size_t)jr * RWKV_IN;
    for (int it = gw; it < 2048; it += NGW) {
        const int tile = it >> 2, q = it & 3, c = 256 * q + 4 * lane;
        const f32x4 mur = *(const f32x4*)(mu + c), muk = *(const f32x4*)(mu + 1024 + c), muv = *(const f32x4*)(mu + 2048 + c), mug = *(const f32x4*)(mu + 3072 + c);
        const f32x4 ka4 = *(const f32x4*)(p.rwkv_k_a + jr * 1024 + c), rk4 = *(const f32x4*)(p.rwkv_r_k + jr * 1024 + c);
        const f32x4 lnw = *(const f32x4*)(p.rwkv_ln_w + jr * 1024 + c), lnb = *(const f32x4*)(p.rwkv_ln_b + jr * 1024 + c);
        const int m0 = tile * 33;
        f32x4 rp = {0.f, 0.f, 0.f, 0.f}, kp = rp, vp = rp, gp = rp;
        if (m0 % LP != 0) { const bf16_t* pr = P + (size_t)(m0 - 1) * 4096 + c;
            const u32x2 a = *(const u32x2*)pr, b2 = *(const u32x2*)(pr + 1024), c2 = *(const u32x2*)(pr + 2048), d2 = *(const u32x2*)(pr + 3072);
            rp = (f32x4){bflo(a.x), bfhi(a.x), bflo(a.y), bfhi(a.y)}; kp = (f32x4){bflo(b2.x), bfhi(b2.x), bflo(b2.y), bfhi(b2.y)};
            vp = (f32x4){bflo(c2.x), bfhi(c2.x), bflo(c2.y), bfhi(c2.y)}; gp = (f32x4){bflo(d2.x), bfhi(d2.x), bflo(d2.y), bfhi(d2.y)}; }
#pragma unroll 3
        for (int i = 0; i < 33; ++i) {
            const size_t row = (size_t)(m0 + i);
            const bf16_t* pr = P + row * 4096 + c;
            const u32x2 a = *(const u32x2*)pr, b2 = *(const u32x2*)(pr + 1024), c2 = *(const u32x2*)(pr + 2048), d2 = *(const u32x2*)(pr + 3072);
            const u32x2 aw = *(const u32x2*)(AA + row * 1024 + c), yw = *(const u32x2*)(Y + row * 1024 + c);
            const f32x4 rc = {bflo(a.x), bfhi(a.x), bflo(a.y), bfhi(a.y)}, kc = {bflo(b2.x), bfhi(b2.x), bflo(b2.y), bfhi(b2.y)};
            const f32x4 vc = {bflo(c2.x), bfhi(c2.x), bflo(c2.y), bfhi(c2.y)}, gc = {bflo(d2.x), bfhi(d2.x), bflo(d2.y), bfhi(d2.y)};
            const f32x4 av = {bflo(aw.x), bfhi(aw.x), bflo(aw.y), bfhi(aw.y)}, yv = {bflo(yw.x), bfhi(yw.x), bflo(yw.y), bfhi(yw.y)};
            const f32x4 rl = rc + (rp - rc) * mur, kl = kc + (kp - kc) * muk, vl = vc + (vp - vc) * muv, gl = gc + (gp - gc) * mug;
            rp = rc; kp = kc; vp = vc; gp = gc;
            const f32x4 kpr = kl * (1.f + (av - 1.f) * ka4);
            const f32x4 bt = rl * kpr * rk4;
            const float bonus = red16((bt[0] + bt[1]) + (bt[2] + bt[3]));
            const float mean = red16((yv[0] + yv[1]) + (yv[2] + yv[3])) * (1.f / 64.f);
            const f32x4 d = yv - mean;
            const float var = red16((d[0] * d[0] + d[1] * d[1]) + (d[2] * d[2] + d[3] * d[3])) * (1.f / 64.f);
            const float rstd = 1.0f / sqrtf(var + GN_EPS);
            const f32x4 o = (d * rstd * lnw + lnb) + bonus * vl;
            u32x2 w; w.x = pk2(o[0] * gl[0] * sigmoidf_(gl[0]), o[1] * gl[1] * sigmoidf_(gl[1])); w.y = pk2(o[2] * gl[2] * sigmoidf_(gl[2]), o[3] * gl[3] * sigmoidf_(gl[3]));
            *(u32x2*)(YG + row * 1024 + c) = w;
        }
    }
}

__global__ void __launch_bounds__(512, 2) fwd_megakernel(Params p) {
    extern __shared__ __attribute__((aligned(16))) unsigned char lds_raw[];
    LAS unsigned char* lds = (LAS unsigned char*)lds_raw;
    cg::grid_group grid = cg::this_grid();
    bf16_t* U = (bf16_t*)(p.ws + WS_B); bf16_t* WIN = (bf16_t*)(p.ws + WS_WIN); bf16_t* WOUT = (bf16_t*)(p.ws + WS_WOUT);
    bf16_t* P = (bf16_t*)(p.ws + WS_C); bf16_t* PL = (bf16_t*)(p.ws + WS_PL); float* MB = (float*)(p.ws + WS_C);
    phase_e<0>(p, lds, 0, -1);
    grid.sync();
#pragma unroll 1
    for (int layer = 0; layer < 4; ++layer) {
        const int jr = layer >> 1; const bool rw = (layer & 1) != 0;
        if (!rw) phase_cumsum(p, lds);
        {   pg8::Gemm g{U, WIN, MROWS, rw ? 4352 : 4096, 1024}; pg8::StaticOrder S; S.init(MROWS, rw ? 4352 : 4096, (int)GRD, (int)BID);
            pg8::EpiP E{P, PL, rw ? 1.f : 0.125f * LOG2E, rw ? 0 : 1024};
            pg8::gemm_phase<pg8::EpiP, pg8::StaticOrder, true, true>(lds, g, S, E); }
        grid.sync();
        if (!rw) { phase_attn(p, lds); grid.sync(); }
        else { phase_lora(p, lds, jr); grid.sync(); phase_scan(p, lds, jr); grid.sync(); phase_r4(p, jr); grid.sync(); }
        {   pg8::Gemm g{rw ? (const bf16_t*)(p.ws + WS_LD) : (const bf16_t*)(p.ws + WS_B), WOUT, MROWS, 1024, 1024}; pg8::StaticOrder S; S.init(MROWS, 1024, (int)GRD, (int)BID);
            pg8::EpiF32 E{MB, 1024};
            pg8::gemm_phase<pg8::EpiF32, pg8::StaticOrder, true, true>(lds, g, S, E); }
        grid.sync();
        phase_e<1>(p, lds, layer < 3 ? layer + 1 : -1, layer);
        if (layer < 3) grid.sync();
    }
}

extern "C" void kernel_launch(void* const* d_in, const int* in_sizes, int n_in, void* d_out, int out_size, void* d_ws, size_t ws_size, hipStream_t stream) {
    static int grid_blocks = 0;
    if (grid_blocks == 0) {
        if (n_in != 19 || ws_size < WS_END) { fprintf(stderr, "kernel_launch: unexpected inputs (n_in %d, ws %zu)\n", n_in, ws_size); grid_blocks = -1; return; }
        int dev = 0, cus = 0, per_cu = 0;
        hipGetDevice(&dev); hipDeviceGetAttribute(&cus, hipDeviceAttributeMultiprocessorCount, dev);
        if (hipFuncSetAttribute((const void*)fwd_megakernel, hipFuncAttributeMaxDynamicSharedMemorySize, LDS_BYTES) != hipSuccess) { fprintf(stderr, "kernel_launch: hipFuncSetAttribute failed\n"); grid_blocks = -1; return; }
        if (hipOccupancyMaxActiveBlocksPerMultiprocessor(&per_cu, (const void*)fwd_megakernel, 512, LDS_BYTES) != hipSuccess || per_cu < 1) { fprintf(stderr, "kernel_launch: occupancy query failed (%d)\n", per_cu); (void)hipGetLastError(); grid_blocks = -1; return; }
        grid_blocks = cus * (per_cu > 1 ? 1 : per_cu);
    }
    if (grid_blocks < 0) return;
    Params p{};
    const float** f = (const float**)&p;
    for (int i = 0; i < 19; ++i) f[i] = (const float*)d_in[i];
    p.out = (float*)d_out; p.ws = (unsigned char*)d_ws;
    void* args[] = {&p};
    hipError_t e = hipLaunchCooperativeKernel((const void*)fwd_megakernel, dim3(grid_blocks), dim3(512), args, LDS_BYTES, stream);
    if (e != hipSuccess) fprintf(stderr, "cooperative launch failed: %s (grid %d)\n", hipGetErrorString(e), grid_blocks);
}
```

```cpp
#include <hip/hip_runtime.h>
#include <hip/hip_cooperative_groups.h>
#include <cstdio>
#include <cstdint>
namespace cg = cooperative_groups;
__device__ __forceinline__ int opaque_tid() { int t = threadIdx.x; asm volatile("" : "+v"(t)); return t; }
__device__ __forceinline__ int opaque_bid() { int t = blockIdx.x; asm volatile("" : "+s"(t)); return t; }
__device__ __forceinline__ int opaque_grid() { int t = gridDim.x; asm volatile("" : "+s"(t)); return t; }
namespace pg8 {
#define PG8_LAS __attribute__((address_space(3)))
typedef unsigned short bf16_t;
typedef short bf16x8 __attribute__((ext_vector_type(8)));
typedef float f32x4 __attribute__((ext_vector_type(4)));
typedef unsigned u32x4 __attribute__((ext_vector_type(4)));
constexpr int BM = 256, BK = 64, HALF = 128, HTB = HALF * BK * 2  , STAGE_BYTES = 8 * HTB, NXCD = 8, WGM = 8;

__host__ __device__ __forceinline__ int lds_byte(int r, int c) { const int st = (r >> 4) * 2 + (c >> 5), rr = r & 15, cc = c & 31, ob = rr * 64 + cc * 2; return st * 1024 + (ob ^ (((ob >> 9) & 1) << 5)); }
__host__ __device__ __forceinline__ void stage_rc(int b, int& R, int& C) { const int st = b / 1024, sb = b % 1024, swz = sb ^ (((sb >> 9) & 1) << 5); R = (st >> 1) * 16 + swz / 64; C = (st & 1) * 32 + (swz % 64) / 2; }
__host__ __device__ __forceinline__ int perm32(int rho) { const int n = rho >> 4, i = rho & 15; return 8 * (i >> 2) + 4 * n + (i & 3); }

struct Unit { int pm, pn; };
struct Gemm { const bf16_t* A; const bf16_t* Bt; int M, N, K; };

struct StaticOrder {
    int nM, nN, nwg, G, c;
    __host__ __device__ void init(int M, int N, int G_, int c_) { nM = M / BM; nN = N / BM; nwg = nM * nN; G = G_; c = c_; }
    __host__ __device__ bool next(int i, Unit& u) const {
        const long L = (long)i * G + c; if (L >= nwg) return false;
        int wgid = (int)L; { const int q = nwg / NXCD, r = nwg % NXCD, xcd = wgid % NXCD, off = wgid / NXCD; wgid = (xcd < r ? xcd * (q + 1) : r * (q + 1) + (xcd - r) * q) + off; }
        const int nig = WGM * nN, gid = wgid / nig, fm = gid * WGM, gsz = (nM - fm) < WGM ? (nM - fm) : WGM;
        u.pm = fm + ((wgid % nig) % gsz); u.pn = (wgid % nig) / gsz; return true;
    }
    __device__ __forceinline__ void a_ready(const Unit&) const {}
    __device__ __forceinline__ void done(const Unit&) const {}
};

__device__ __forceinline__ unsigned cvt_pk_bf16(float lo, float hi) { unsigned r; asm volatile("v_cvt_pk_bf16_f32 %0, %1, %2" : "=v"(r) : "v"(lo), "v"(hi)); return r; }
typedef float f32x2 __attribute__((ext_vector_type(2)));
typedef __bf16 bf16x2_t __attribute__((ext_vector_type(2)));
__device__ __forceinline__ unsigned pk2(float lo, float hi) { f32x2 v = {lo, hi}; bf16x2_t b = __builtin_convertvector(v, bf16x2_t); return __builtin_bit_cast(unsigned, b); }
struct EpiP {
    static constexpr bool PERM = true, AFTER_DRAIN = false;
    bf16_t* P; bf16_t* PL; float qscale; int qcols;
    __device__ __forceinline__ void operator()(const f32x4 (&acc)[2][2][4][2], const Unit& u, int wr, int wc, int fr, int fq) const {
        const int row0 = u.pm * BM + wr * 64 + fr; const int colt = u.pn * BM;
        bf16_t* base; int ldc, c0;
        if (colt < 4096) { base = P; ldc = 4096; c0 = colt; } else { base = PL; ldc = 256; c0 = colt - 4096; }
        const float sc = (colt < qcols) ? qscale : 1.f;
        const int col0 = c0 + wc * 32 + 8 * fq;
#pragma unroll
        for (int ai = 0; ai < 2; ++ai)
#pragma unroll
            for (int m = 0; m < 4; ++m) { bf16_t* rowp = base + (size_t)(row0 + ai * HALF + m * 16) * ldc + col0;
#pragma unroll
                for (int bj = 0; bj < 2; ++bj) { const f32x4 v0 = acc[ai][bj][m][0] * sc, v1 = acc[ai][bj][m][1] * sc;
                    u32x4 w; w.x = pk2(v0[0], v0[1]); w.y = pk2(v0[2], v0[3]); w.z = pk2(v1[0], v1[1]); w.w = pk2(v1[2], v1[3]);
                    *(u32x4*)(rowp + bj * HALF) = w; } }
    }
};
struct EpiF32 {
    static constexpr bool PERM = false, AFTER_DRAIN = false;
    float* O; int ldc;
    __device__ __forceinline__ void operator()(const f32x4 (&acc)[2][2][4][2], const Unit& u, int wr, int wc, int fr, int fq) const {
        const int row0 = u.pm * BM + wr * 64 + fr; const int col0 = u.pn * BM + wc * 32 + 4 * fq;
#pragma unroll
        for (int ai = 0; ai < 2; ++ai)
#pragma unroll
            for (int m = 0; m < 4; ++m) { float* rowp = O + (size_t)(row0 + ai * HALF + m * 16) * ldc + col0;
#pragma unroll
                for (int bj = 0; bj < 2; ++bj)
#pragma unroll
                    for (int n = 0; n < 2; ++n) *(f32x4*)(rowp + bj * HALF + n * 16) = acc[ai][bj][m][n]; }
    }
};
template <class Epi, class Sched, bool ALIGN_EPI = false, bool SP2 = false>
__device__ __forceinline__ void gemm_phase(PG8_LAS unsigned char* lds, const Gemm g, const Sched& S, const Epi& E) {
    const int tid = opaque_tid(), wid = __builtin_amdgcn_readfirstlane(tid >> 6), lane = tid & 63, wr = wid >> 2, wc = wid & 3, fr = lane & 15, fq = lane >> 4;
    const int K = g.K, nt = K / BK;
    unsigned voffA[2], voffB[2];
#pragma unroll
    for (int i = 0; i < 2; ++i) { int R, C; stage_rc(tid * 16 + i * 8192, R, C); const int Rb = Epi::PERM ? ((R & ~31) + perm32(R & 31)) : R;
        voffA[i] = (unsigned)(R * K + C) * 2u; voffB[i] = (unsigned)(Rb * K + C) * 2u; }
    const size_t kstep = (size_t)(BK * 2);
    const size_t hstep = (size_t)HALF * K * 2;
    const size_t tstep = 2 * hstep;
    const unsigned ldsw = (unsigned)wid * 1024u;
    const int aoff = lds_byte(wr * 64 + fr, fq * 8), boff = lds_byte(wc * 32 + fr, fq * 8);
#define PG8_SA(b, h) (((b) * 2 + (h)) * HTB)
#define PG8_SB(b, h) ((4 + (b) * 2 + (h)) * HTB)
#define PG8_STAGE(bufoff, gbase, voff) do { _Pragma("unroll") for (int _i = 0; _i < 2; ++_i) \
        __builtin_amdgcn_global_load_lds((const unsigned*)((const char*)(gbase) + (voff)[_i]), (PG8_LAS unsigned*)(lds + (bufoff) + ldsw + _i * 8192), 16, 0, 0); } while (0)
#define PG8_LDA(dst, b, h) do { _Pragma("unroll") for (int m = 0; m < 4; ++m) _Pragma("unroll") for (int k = 0; k < 2; ++k) dst[m][k] = *(const PG8_LAS bf16x8*)(lds + PG8_SA(b, h) + aoff + m * 2048 + k * 1024); } while (0)
#define PG8_LDB(dst, b, h) do { _Pragma("unroll") for (int n = 0; n < 2; ++n) _Pragma("unroll") for (int k = 0; k < 2; ++k) dst[n][k] = *(const PG8_LAS bf16x8*)(lds + PG8_SB(b, h) + boff + n * 2048 + k * 1024); } while (0)
#define PG8_MMA(ai, bj, At, Bt) do { __builtin_amdgcn_s_setprio(1); _Pragma("unroll") for (int m = 0; m < 4; ++m) _Pragma("unroll") for (int n = 0; n < 2; ++n) _Pragma("unroll") for (int k = 0; k < 2; ++k) \
        acc[ai][bj][m][n] = __builtin_amdgcn_mfma_f32_16x16x32_bf16(Bt[n][k], At[m][k], acc[ai][bj][m][n], 0, 0, 0); __builtin_amdgcn_s_setprio(0); } while (0)
#define PG8_WAIT_V(n) asm volatile("s_waitcnt vmcnt(" #n ")" ::: "memory")
#define PG8_WAIT_L(n) asm volatile("s_waitcnt lgkmcnt(" #n ")" ::: "memory")
#define PG8_BAR __builtin_amdgcn_s_barrier()
#define PG8_SCHED __builtin_amdgcn_sched_barrier(0)
    Unit cur, nxt; int ui = 0;
    if (!S.next(0, cur)) return;
    f32x4 acc[2][2][4][2];
#pragma unroll
    for (int a = 0; a < 2; ++a)
#pragma unroll
        for (int b = 0; b < 2; ++b)
#pragma unroll
            for (int m = 0; m < 4; ++m)
#pragma unroll
                for (int n = 0; n < 2; ++n) acc[a][b][m][n] = (f32x4){0.f, 0.f, 0.f, 0.f};
    bf16x8 At[4][2], B0[2][2], B1[2][2];
    const char* cA = (const char*)g.A + (size_t)cur.pm * tstep; const char* cB = (const char*)g.Bt + (size_t)cur.pn * tstep;
    S.a_ready(cur);
    if constexpr (SP2) {
        PG8_STAGE(PG8_SB(0, 0), cB, voffB); PG8_STAGE(PG8_SB(0, 1), cB + hstep, voffB); PG8_STAGE(PG8_SA(0, 0), cA, voffA); PG8_STAGE(PG8_SA(0, 1), cA + hstep, voffA);
        if (wr == 1) PG8_BAR;
        PG8_WAIT_V(2); PG8_BAR;
        PG8_STAGE(PG8_SB(1, 0), cB + kstep, voffB); PG8_STAGE(PG8_SA(1, 0), cA + kstep, voffA); PG8_STAGE(PG8_SB(1, 1), cB + hstep + kstep, voffB);
        PG8_WAIT_V(6); PG8_BAR;
    } else {
        PG8_STAGE(PG8_SB(0, 0), cB, voffB); PG8_STAGE(PG8_SA(0, 0), cA, voffA); PG8_STAGE(PG8_SB(0, 1), cB + hstep, voffB); PG8_STAGE(PG8_SA(0, 1), cA + hstep, voffA);
        if (wr == 1) PG8_BAR;
        PG8_WAIT_V(4); PG8_BAR;
        PG8_STAGE(PG8_SB(1, 0), cB + kstep, voffB); PG8_STAGE(PG8_SA(1, 0), cA + kstep, voffA); PG8_STAGE(PG8_SB(1, 1), cB + hstep + kstep, voffB);
        PG8_WAIT_V(6); PG8_BAR;
    }
    for (;;) {
        const bool has_next = S.next(ui + 1, nxt);
        const char* nA = has_next ? (const char*)g.A + (size_t)nxt.pm * tstep : cA; const char* nB = has_next ? (const char*)g.Bt + (size_t)nxt.pn * tstep : cB;
        for (int t = 0; t < nt; t += 2) {
            const bool last = (t == nt - 2);
            const char* a1 = cA + (size_t)(t + 1) * kstep;
            const char* a2 = last ? nA : cA + (size_t)(t + 2) * kstep; const char* b2 = last ? nB : cB + (size_t)(t + 2) * kstep;
            const char* a3 = a2 + kstep; const char* b3 = b2 + kstep;
            if (last && has_next) S.a_ready(nxt);
            if constexpr (SP2) {
            PG8_LDB(B0, 0, 0); PG8_LDB(B1, 0, 1); PG8_SCHED; PG8_LDA(At, 0, 0); PG8_STAGE(PG8_SA(1, 1), a1 + hstep, voffA);
            PG8_WAIT_V(8); PG8_WAIT_L(0); PG8_BAR; PG8_MMA(0, 0, At, B0); PG8_MMA(0, 1, At, B1); PG8_BAR; PG8_SCHED;
            PG8_LDA(At, 0, 1); PG8_STAGE(PG8_SB(0, 0), b2, voffB); PG8_STAGE(PG8_SB(0, 1), b2 + hstep, voffB); PG8_STAGE(PG8_SA(0, 0), a2, voffA);
            PG8_WAIT_V(8); PG8_WAIT_L(0); PG8_BAR; PG8_MMA(1, 0, At, B0); PG8_MMA(1, 1, At, B1); PG8_BAR; PG8_SCHED;
            PG8_LDB(B0, 1, 0); PG8_LDB(B1, 1, 1); PG8_SCHED; PG8_LDA(At, 1, 0); PG8_STAGE(PG8_SA(0, 1), a2 + hstep, voffA);
            PG8_WAIT_V(8); PG8_WAIT_L(0); PG8_BAR; PG8_MMA(0, 0, At, B0); PG8_MMA(0, 1, At, B1); PG8_BAR; PG8_SCHED;
            PG8_LDA(At, 1, 1); PG8_STAGE(PG8_SB(1, 0), b3, voffB); PG8_STAGE(PG8_SB(1, 1), b3 + hstep, voffB); PG8_STAGE(PG8_SA(1, 0), a3, voffA);
            PG8_WAIT_V(8); PG8_WAIT_L(0); PG8_BAR; PG8_MMA(1, 0, At, B0); PG8_MMA(1, 1, At, B1); PG8_BAR; PG8_SCHED;
            } else {
            PG8_LDB(B0, 0, 0); PG8_SCHED; PG8_LDA(At, 0, 0); PG8_STAGE(PG8_SA(1, 1), a1 + hstep, voffA);
            PG8_WAIT_L(8); PG8_BAR; PG8_WAIT_L(0); PG8_MMA(0, 0, At, B0); PG8_BAR; PG8_SCHED;
            PG8_LDB(B1, 0, 1); PG8_STAGE(PG8_SB(0, 0), b2, voffB);
            PG8_BAR; PG8_WAIT_L(0); PG8_MMA(0, 1, At, B1); PG8_BAR;
            PG8_LDA(At, 0, 1); PG8_STAGE(PG8_SA(0, 0), a2, voffA);
            PG8_BAR; PG8_WAIT_L(0); PG8_MMA(1, 0, At, B0); PG8_BAR; PG8_SCHED;
            PG8_STAGE(PG8_SB(0, 1), b2 + hstep, voffB);
            PG8_WAIT_V(6); PG8_BAR; PG8_MMA(1, 1, At, B1); PG8_BAR;
            PG8_LDB(B0, 1, 0); PG8_SCHED; PG8_LDA(At, 1, 0); PG8_STAGE(PG8_SA(0, 1), a2 + hstep, voffA);
            PG8_WAIT_L(8); PG8_BAR; PG8_WAIT_L(0); PG8_MMA(0, 0, At, B0); PG8_BAR; PG8_SCHED;
            PG8_LDB(B1, 1, 1); PG8_STAGE(PG8_SB(1, 0), b3, voffB);
            PG8_BAR; PG8_WAIT_L(0); PG8_MMA(0, 1, At, B1); PG8_BAR;
            PG8_LDA(At, 1, 1); PG8_STAGE(PG8_SA(1, 0), a3, voffA);
            PG8_BAR; PG8_WAIT_L(0); PG8_MMA(1, 0, At, B0); PG8_BAR; PG8_SCHED;
            PG8_STAGE(PG8_SB(1, 1), b3 + hstep, voffB);
            PG8_WAIT_V(6); PG8_BAR; PG8_MMA(1, 1, At, B1); PG8_BAR;
            }
        }
        if constexpr (ALIGN_EPI) { if (wr == 0) PG8_BAR; }
        if constexpr (!Epi::AFTER_DRAIN) { E(acc, cur, wr, wc, fr, fq); S.done(cur); }
        if (!has_next) break;
#pragma unroll
        for (int a = 0; a < 2; ++a)
#pragma unroll
            for (int b = 0; b < 2; ++b)
#pragma unroll
                for (int m = 0; m < 4; ++m)
#pragma unroll
                    for (int n = 0; n < 2; ++n) acc[a][b][m][n] = (f32x4){0.f, 0.f, 0.f, 0.f};
        cur = nxt; cA = nA; cB = nB; ++ui;
        if constexpr (ALIGN_EPI) { if (wr == 1) PG8_BAR; }
    }
    PG8_WAIT_V(0);
    if constexpr (!ALIGN_EPI) { if (wr == 0) PG8_BAR; }
    PG8_BAR;
    if constexpr (Epi::AFTER_DRAIN) { E.fused(acc, cur, wr, wc, fr, fq, lds, wid, lane); S.done(cur); }
#undef PG8_SA
#undef PG8_SB
#undef PG8_STAGE
#undef PG8_LDA
#undef PG8_LDB
#undef PG8_MMA
#undef PG8_WAIT_V
#undef PG8_WAIT_L
#undef PG8_BAR
#undef PG8_SCHED
}
}
#define LAS __attribute__((address_space(3)))
#define BID opaque_bid()
#define GRD opaque_grid()
typedef unsigned short bf16_t;
typedef short bf16x8 __attribute__((ext_vector_type(8)));
typedef short s16x4 __attribute__((ext_vector_type(4)));
typedef float f32x4 __attribute__((ext_vector_type(4)));
typedef float f32x2 __attribute__((ext_vector_type(2)));
typedef float f32x16 __attribute__((ext_vector_type(16)));
typedef unsigned u32x4 __attribute__((ext_vector_type(4)));
typedef unsigned u32x2 __attribute__((ext_vector_type(2)));

constexpr int NB = 8, SEQ = 2048, NMETA = 16, LSEQ = SEQ + NMETA  , LP = 2112  , DM = 1024;
constexpr int MROWS = NB * LP;
constexpr int FOX_IN = 4112, RWKV_IN = 4224;
constexpr float NORM_EPS = 1e-6f, GN_EPS = 64e-5f, LOG2E = 1.4426950408889634f;
constexpr float DECAY_SCALE = 0.6065306597126334f;
constexpr int LDS_BYTES = 147456;
constexpr size_t MiB = 1u << 20;
constexpr size_t WS_WIN = 1 * MiB;
constexpr size_t WS_WOUT = 10 * MiB;
constexpr size_t WS_HMETA = 12 * MiB;
constexpr size_t WS_CUM = 13 * MiB;
constexpr size_t WS_PL = 15 * MiB;
constexpr size_t WS_B = 24 * MiB;
constexpr size_t WS_C = 57 * MiB;
constexpr size_t WS_LD = 189 * MiB;
constexpr size_t WS_AA = 222 * MiB;
constexpr size_t WS_END = 255 * MiB;
static_assert(WS_B + (size_t)MROWS * 1024 * 2 <= WS_C && WS_C + (size_t)MROWS * 4096 * 2 <= WS_LD && WS_LD + (size_t)MROWS * 2048 <= WS_AA && WS_AA + (size_t)MROWS * 2048 <= WS_END, "ws map");
static_assert(WS_PL + (size_t)MROWS * 512 <= WS_B && WS_CUM + (size_t)MROWS * 64 <= WS_PL, "ws map 2");

struct Params {
    const float *x, *meta, *norm_pre, *norm_post, *fox_w_in, *fox_b_f, *fox_w_out, *rwkv_w_in, *rwkv_mu, *rwkv_w0, *rwkv_w_up, *rwkv_a0, *rwkv_a_up,
        *rwkv_k_k, *rwkv_k_a, *rwkv_r_k, *rwkv_ln_w, *rwkv_ln_b, *rwkv_w_out;
    float* out; unsigned char* ws;
};

__device__ __forceinline__ float wave_sum(float v) {
#pragma unroll
    for (int o = 1; o < 64; o <<= 1) v += __shfl_xor(v, o);
    return v;
}
__device__ __forceinline__ unsigned pk2(float lo, float hi) { return pg8::pk2(lo, hi); }
__device__ __forceinline__ float bflo(unsigned w) { return __uint_as_float(w << 16); }
__device__ __forceinline__ float bfhi(unsigned w) { return __uint_as_float(w & 0xffff0000u); }
template <int CTRL> __device__ __forceinline__ float dppf(float v) { return __int_as_float(__builtin_amdgcn_update_dpp(0, __float_as_int(v), CTRL, 0xF, 0xF, true)); }
__device__ __forceinline__ float red16(float v) {
    v += dppf<0xB1>(v); v += dppf<0x4E>(v); v += dppf<0x141>(v); v += dppf<0x140>(v); return v;
}
__device__ __forceinline__ float sigmoidf_(float x) { return 1.f / (1.f + __expf(-x)); }
#define LDS_WAIT() asm volatile("s_waitcnt lgkmcnt(0)" ::: "memory")

__device__ __forceinline__ void transpose_item(const float* W, int ldw, bf16_t* WT, LAS float* scr, int kb, int nb, int lane) {
    const int k0 = 64 * kb, n0 = 32 * nb;
#pragma unroll 8
    for (int i = 0; i < 32; ++i) { const int kk = 2 * i + (lane >> 5); scr[kk * 33 + (lane & 31)] = W[(size_t)(k0 + kk) * ldw + n0 + (lane & 31)]; }
    LDS_WAIT();
    const int c = lane & 7;
#pragma unroll
    for (int j = 0; j < 4; ++j) { const int n = (lane >> 3) + 8 * j; const LAS float* s = scr + (8 * c) * 33 + n;
        u32x4 o; o.x = pk2(s[0 * 33], s[1 * 33]); o.y = pk2(s[2 * 33], s[3 * 33]); o.z = pk2(s[4 * 33], s[5 * 33]); o.w = pk2(s[6 * 33], s[7 * 33]);
        *(u32x4*)(WT + (size_t)(n0 + n) * 1024 + k0 + 8 * c) = o; }
    LDS_WAIT();
}

template <int MODE>
__device__ __forceinline__ void phase_e(const Params& p, LAS unsigned char* lds, int next, int prev) {
    const int tid = opaque_tid(), lane = tid & 63, wave = __builtin_amdgcn_readfirstlane(tid >> 6);
    const int G = GRD, gw = BID * 8 + wave, NGW = G * 8;
    bf16_t* U = (bf16_t*)(p.ws + WS_B);
    float* CUM = (float*)(p.ws + WS_CUM);
    float* HMETA = (float*)(p.ws + WS_HMETA);
    const float* MB = (const float*)(p.ws + WS_C);
    const bool next_fox = (next >= 0) && ((next & 1) == 0);
    LAS float* WfT = (LAS float*)lds;
    LAS float* scr = (LAS float*)(lds + 65536 + wave * 8448);
    if (next >= 0) {
        const int jn = next >> 1;
        bf16_t* WIN = (bf16_t*)(p.ws + WS_WIN); bf16_t* WOUT = (bf16_t*)(p.ws + WS_WOUT);
        if (next_fox) {
            const float* Wf = p.fox_w_in + (size_t)jn * 1024 * FOX_IN + 4096;
            for (int i = tid; i < 4096; i += 512) { const int k = i >> 2, q = i & 3; const f32x4 v = *(const f32x4*)(Wf + (size_t)k * FOX_IN + 4 * q);
                WfT[(4 * q + 0) * 1024 + k] = v[0]; WfT[(4 * q + 1) * 1024 + k] = v[1]; WfT[(4 * q + 2) * 1024 + k] = v[2]; WfT[(4 * q + 3) * 1024 + k] = v[3]; }
            const float* W = p.fox_w_in + (size_t)jn * 1024 * FOX_IN; const float* Wo = p.fox_w_out + (size_t)jn * 1024 * 1024;
            for (int it = gw; it < 16 * 128 + 16 * 32; it += NGW) {
                if (it < 16 * 128) transpose_item(W, FOX_IN, WIN, scr, it / 128, it % 128, lane);
                else { const int r = it - 16 * 128; transpose_item(Wo, 1024, WOUT, scr, r / 32, r % 32, lane); }
            }
        } else {
            const float* W = p.rwkv_w_in + (size_t)jn * 1024 * RWKV_IN; const float* Wo = p.rwkv_w_out + (size_t)jn * 1024 * 1024;
            for (int it = gw; it < 16 * 132 + 16 * 32; it += NGW) {
                if (it < 16 * 132) transpose_item(W, RWKV_IN, WIN, scr, it / 132, it % 132, lane);
                else { const int r = it - 16 * 132; transpose_item(Wo, 1024, WOUT, scr, r / 32, r % 32, lane); }
            }
            for (int i = BID * 512 + tid; i < 16384; i += G * 512) *(u32x4*)(WIN + (size_t)4224 * 1024 + (size_t)i * 8) = (u32x4){0u, 0u, 0u, 0u};
        }
    }
    __syncthreads();
    f32x4 gpo[4], gpr[4];
#pragma unroll
    for (int j = 0; j < 4; ++j) {
        gpo[j] = (MODE == 1) ? *((const f32x4*)(p.norm_post + (size_t)prev * 1024) + lane + 64 * j) : (f32x4){0.f, 0.f, 0.f, 0.f};
        gpr[j] = (next >= 0) ? *((const f32x4*)(p.norm_pre + (size_t)next * 1024) + lane + 64 * j) : (f32x4){0.f, 0.f, 0.f, 0.f};
    }
    const float bfv = (next_fox && lane < 16) ? p.fox_b_f[(next >> 1) * 16 + lane] : 0.f;
    for (int m = gw; m < MROWS; m += NGW) {
        const int b = m / LP, t = m - b * LP;
        if (t >= LSEQ) {
            if (next >= 0) { u32x2* o8 = (u32x2*)(U + (size_t)m * 1024) + lane;
#pragma unroll
                for (int j = 0; j < 4; ++j) o8[64 * j] = (u32x2){0u, 0u};
                if (next_fox && lane < 16) CUM[(size_t)m * 16 + lane] = 0.f; }
            continue;
        }
        float* hrow = (t < NMETA) ? HMETA + (size_t)(b * NMETA + t) * 1024 : p.out + ((size_t)b * SEQ + (t - NMETA)) * 1024;
        f32x4 v[4];
        if (MODE == 0) {
            const float* src = (t < NMETA) ? p.meta + (size_t)t * 1024 : p.x + ((size_t)b * SEQ + (t - NMETA)) * 1024;
#pragma unroll
            for (int j = 0; j < 4; ++j) v[j] = *((const f32x4*)src + lane + 64 * j);
        } else {
            f32x4 mv[4]; float ss = 0.f;
#pragma unroll
            for (int j = 0; j < 4; ++j) { v[j] = *((const f32x4*)hrow + lane + 64 * j); mv[j] = *((const f32x4*)(MB + (size_t)m * 1024) + lane + 64 * j);
                ss += (mv[j][0] * mv[j][0] + mv[j][1] * mv[j][1]) + (mv[j][2] * mv[j][2] + mv[j][3] * mv[j][3]); }
            const float rs = 1.0f / sqrtf(wave_sum(ss) * (1.f / 1024.f) + NORM_EPS);
#pragma unroll
            for (int j = 0; j < 4; ++j) v[j] = v[j] + mv[j] * rs * gpo[j];
        }
#pragma unroll
        for (int j = 0; j < 4; ++j) *((f32x4*)hrow + lane + 64 * j) = v[j];
        if (next >= 0) {
            float ss = 0.f;
#pragma unroll
            for (int j = 0; j < 4; ++j) ss += (v[j][0] * v[j][0] + v[j][1] * v[j][1]) + (v[j][2] * v[j][2] + v[j][3] * v[j][3]);
            const float rs = 1.0f / sqrtf(wave_sum(ss) * (1.f / 1024.f) + NORM_EPS);
            u32x2* o8 = (u32x2*)(U + (size_t)m * 1024) + lane;
#pragma unroll
            for (int j = 0; j < 4; ++j) { v[j] = v[j] * rs * gpr[j]; o8[64 * j] = (u32x2){pk2(v[j][0], v[j][1]), pk2(v[j][2], v[j][3])}; }
            if (next_fox) {
                float mine = 0.f;
#pragma unroll
                for (int hd = 0; hd < 16; ++hd) { float s = 0.f;
#pragma unroll
                    for (int j = 0; j < 4; ++j) { const f32x4 w = *((const LAS f32x4*)(WfT + hd * 1024) + lane + 64 * j); s += (v[j][0] * w[0] + v[j][1] * w[1]) + (v[j][2] * w[2] + v[j][3] * w[3]); }
                    s = wave_sum(s); if (lane == hd) mine = s; }
                if (lane < 16) { const float xx = mine + bfv; const float lf = fminf(xx, 0.f) - log1pf(__expf(-fabsf(xx))); CUM[(size_t)m * 16 + lane] = lf * LOG2E; }
            }
        }
    }
}

__device__ __forceinline__ void phase_cumsum(const Params& p, LAS unsigned char* lds) {
    const int tid = opaque_tid(); LAS float* s = (LAS float*)lds;
    float* CUM = (float*)(p.ws + WS_CUM);
    for (int j = BID; j < 128; j += GRD) {
        const int b = j >> 4, hd = j & 15; float* base = CUM + (size_t)b * LP * 16 + hd;
        float v[5]; float tot = 0.f;
#pragma unroll
        for (int e = 0; e < 5; ++e) { const int t = tid * 5 + e; v[e] = (t < LP) ? base[(size_t)t * 16] : 0.f; tot += v[e]; }
        s[tid] = tot; __syncthreads();
        for (int off = 1; off < 512; off <<= 1) { const float a = (tid >= off) ? s[tid - off] : 0.f; __syncthreads(); s[tid] += a; __syncthreads(); }
        float run = s[tid] - tot;
#pragma unroll
        for (int e = 0; e < 5; ++e) { const int t = tid * 5 + e; run += v[e]; if (t < LP) base[(size_t)t * 16] = run; }
        __syncthreads();
    }
}

__device__ __forceinline__ void phase_attn(const Params& p, LAS unsigned char* lds) {
    const int tid = opaque_tid(), lane = tid & 63, wid = __builtin_amdgcn_readfirstlane(tid >> 6), r32 = lane & 31, hi = lane >> 5;
    LAS bf16_t* Ks = (LAS bf16_t*)lds;
    LAS bf16_t* Vt = Ks + 2 * 64 * 72;
    LAS float* cks = (LAS float*)(lds + 2 * 2 * 64 * 72 * 2);
    const bf16_t* P = (const bf16_t*)(p.ws + WS_C);
    const float* CUM = (const float*)(p.ws + WS_CUM);
    bf16_t* OG = (bf16_t*)(p.ws + WS_B);
    const int kr = tid >> 3, kc = tid & 7;
    for (int u = BID; u < 1152; u += GRD) {
        const int qb = 8 - u / 128, bh = u % 128, b = bh >> 4, h = bh & 15;
        const int q0 = qb * 256;
        int NT = (q0 + 256) / 64; if (NT > LP / 64) NT = LP / 64;
        const int qw0 = q0 + 32 * wid;
        const bool active = qw0 < LP;
        const int jmax = (qw0 + 31) >> 6;
        const size_t rowb = (size_t)b * LP;
        bf16x8 qr[4];
#pragma unroll
        for (int d0 = 0; d0 < 4; ++d0) qr[d0] = active ? *(const bf16x8*)(P + (rowb + qw0 + r32) * 4096 + h * 64 + d0 * 16 + hi * 8) : (bf16x8){0, 0, 0, 0, 0, 0, 0, 0};
        const bf16_t* kg = P + (rowb + kr) * 4096 + 1024 + h * 64 + kc * 8;
        const bf16_t* vg = kg + 1024;
        const float* cgp = CUM + (rowb + (tid & 63)) * 16 + h;
        u32x4 kreg = *(const u32x4*)kg, vreg = *(const u32x4*)vg; float creg = (tid < 64) ? cgp[0] : 0.f;
#define STORE_TILE(buf) do { *(LAS u32x4*)(Ks + (buf) * 4608 + kr * 72 + kc * 8) = kreg; \
        LAS bf16_t* vt_ = Vt + (buf) * 4608 + (kc * 8) * 72 + kr; \
        vt_[0 * 72] = (bf16_t)(vreg.x & 0xffffu); vt_[1 * 72] = (bf16_t)(vreg.x >> 16); vt_[2 * 72] = (bf16_t)(vreg.y & 0xffffu); vt_[3 * 72] = (bf16_t)(vreg.y >> 16); \
        vt_[4 * 72] = (bf16_t)(vreg.z & 0xffffu); vt_[5 * 72] = (bf16_t)(vreg.z >> 16); vt_[6 * 72] = (bf16_t)(vreg.w & 0xffffu); vt_[7 * 72] = (bf16_t)(vreg.w >> 16); \
        if (tid < 64) cks[(buf) * 64 + tid] = creg; } while (0)
        STORE_TILE(0);
        __syncthreads();
        float m_run = -INFINITY, l_run = 0.f;
        f32x16 o0, o1;
#pragma unroll
        for (int r = 0; r < 16; ++r) { o0[r] = 0.f; o1[r] = 0.f; }
        for (int j = 0; j < NT; ++j) {
            const int buf = j & 1;
            if (j + 1 < NT) { kreg = *(const u32x4*)(kg + (size_t)(j + 1) * 64 * 4096); vreg = *(const u32x4*)(vg + (size_t)(j + 1) * 64 * 4096); if (tid < 64) creg = cgp[(size_t)(j + 1) * 64 * 16]; }
            if (active && j <= jmax) {
                const LAS bf16_t* Kb = Ks + buf * 4608; const LAS bf16_t* Vb = Vt + buf * 4608; const LAS float* cb = cks + buf * 64;
                f32x16 p0, p1;
#pragma unroll
                for (int i = 0; i < 4; ++i) { const f32x4 c0 = *(const LAS f32x4*)(cb + 8 * i + 4 * hi), c1 = *(const LAS f32x4*)(cb + 32 + 8 * i + 4 * hi);
#pragma unroll
                    for (int e = 0; e < 4; ++e) { p0[4 * i + e] = -c0[e]; p1[4 * i + e] = -c1[e]; } }
#pragma unroll
                for (int d0 = 0; d0 < 4; ++d0) {
                    const bf16x8 a0 = *(const LAS bf16x8*)(Kb + r32 * 72 + d0 * 16 + hi * 8), a1 = *(const LAS bf16x8*)(Kb + (32 + r32) * 72 + d0 * 16 + hi * 8);
                    p0 = __builtin_amdgcn_mfma_f32_32x32x16_bf16(a0, qr[d0], p0, 0, 0, 0); p1 = __builtin_amdgcn_mfma_f32_32x32x16_bf16(a1, qr[d0], p1, 0, 0, 0);
                }
                if (64 * j + 63 > qw0) {
                    const int qpos = qw0 + r32;
#pragma unroll
                    for (int r = 0; r < 16; ++r) { const int kv = 64 * j + (r & 3) + 8 * (r >> 2) + 4 * hi; if (kv > qpos) p0[r] = -INFINITY; if (kv + 32 > qpos) p1[r] = -INFINITY; }
                }
                float mx = fmaxf(p0[0], p1[0]);
#pragma unroll
                for (int r = 1; r < 16; ++r) mx = fmaxf(mx, fmaxf(p0[r], p1[r]));
                mx = fmaxf(mx, __shfl_xor(mx, 32));
                const float m_new = fmaxf(m_run, mx);
                const float alpha = __builtin_amdgcn_exp2f(m_run - m_new);
                m_run = m_new;
                float sum = 0.f;
#pragma unroll
                for (int r = 0; r < 16; ++r) { p0[r] = __builtin_amdgcn_exp2f(p0[r] - m_new); p1[r] = __builtin_amdgcn_exp2f(p1[r] - m_new); sum += p0[r] + p1[r]; }
                l_run = l_run * alpha + sum;
#pragma unroll
                for (int r = 0; r < 16; ++r) { o0[r] *= alpha; o1[r] *= alpha; }
#pragma unroll
                for (int c = 0; c < 4; ++c) {
                    u32x4 pw;
                    if (c < 2) { pw.x = pk2(p0[8 * c + 0], p0[8 * c + 1]); pw.y = pk2(p0[8 * c + 2], p0[8 * c + 3]); pw.z = pk2(p0[8 * c + 4], p0[8 * c + 5]); pw.w = pk2(p0[8 * c + 6], p0[8 * c + 7]); }
                    else { const int c2 = c - 2; pw.x = pk2(p1[8 * c2 + 0], p1[8 * c2 + 1]); pw.y = pk2(p1[8 * c2 + 2], p1[8 * c2 + 3]); pw.z = pk2(p1[8 * c2 + 4], p1[8 * c2 + 5]); pw.w = pk2(p1[8 * c2 + 6], p1[8 * c2 + 7]); }
                    const bf16x8 pf = __builtin_bit_cast(bf16x8, pw);
                    {   const s16x4 lo = *(const LAS s16x4*)(Vb + r32 * 72 + 16 * c + 4 * hi), h4 = *(const LAS s16x4*)(Vb + r32 * 72 + 16 * c + 4 * hi + 8);
                        const bf16x8 vf = (bf16x8){lo[0], lo[1], lo[2], lo[3], h4[0], h4[1], h4[2], h4[3]};
                        o0 = __builtin_amdgcn_mfma_f32_32x32x16_bf16(vf, pf, o0, 0, 0, 0); }
                    {   const s16x4 lo = *(const LAS s16x4*)(Vb + (32 + r32) * 72 + 16 * c + 4 * hi), h4 = *(const LAS s16x4*)(Vb + (32 + r32) * 72 + 16 * c + 4 * hi + 8);
                        const bf16x8 vf = (bf16x8){lo[0], lo[1], lo[2], lo[3], h4[0], h4[1], h4[2], h4[3]};
                        o1 = __builtin_amdgcn_mfma_f32_32x32x16_bf16(vf, pf, o1, 0, 0, 0); }
                }
            }
            if (j + 1 < NT) STORE_TILE(buf ^ 1);
            __syncthreads();
        }
#undef STORE_TILE
        if (active) {
            const float l = l_run + __shfl_xor(l_run, 32); const float inv = 1.f / l;
            const size_t row = rowb + qw0 + r32;
#pragma unroll
            for (int dh = 0; dh < 2; ++dh)
#pragma unroll
                for (int i = 0; i < 4; ++i) {
                    const int dcol = h * 64 + 32 * dh + 8 * i + 4 * hi;
                    const u32x2 gw_ = *(const u32x2*)(P + row * 4096 + 3072 + dcol);
                    const float g0 = bflo(gw_.x), g1 = bfhi(gw_.x), g2 = bflo(gw_.y), g3 = bfhi(gw_.y);
                    const float a0 = (dh ? o1[4 * i + 0] : o0[4 * i + 0]) * inv, a1 = (dh ? o1[4 * i + 1] : o0[4 * i + 1]) * inv, a2 = (dh ? o1[4 * i + 2] : o0[4 * i + 2]) * inv, a3 = (dh ? o1[4 * i + 3] : o0[4 * i + 3]) * inv;
                    u32x2 w; w.x = pk2(a0 * g0 * sigmoidf_(g0), a1 * g1 * sigmoidf_(g1)); w.y = pk2(a2 * g2 * sigmoidf_(g2), a3 * g3 * sigmoidf_(g3));
                    *(u32x2*)(OG + row * 1024 + dcol) = w;
                }
        }
    }
}

__device__ __forceinline__ void phase_lora(const Params& p, LAS unsigned char* lds, int jr) {
    const int tid = opaque_tid();
    LAS float* tw = (LAS float*)lds;
    LAS float* ad = tw + 1024;
    const bf16_t* PL = (const bf16_t*)(p.ws + WS_PL);
    bf16_t* LD = (bf16_t*)(p.ws + WS_LD); bf16_t* AA = (bf16_t*)(p.ws + WS_AA);
    const float* mu = p.rwkv_mu + (size_t)jr * RWKV_IN + 4096;
    const float* w_up = p.rwkv_w_up + (size_t)jr * 64 * 1024; const float* a_up = p.rwkv_a_up + (size_t)jr * 64 * 1024;
    const int c0 = tid, c1 = tid + 512;
    const float w00 = p.rwkv_w0[jr * 1024 + c0], w01 = p.rwkv_w0[jr * 1024 + c1], a00 = p.rwkv_a0[jr * 1024 + c0], a01 = p.rwkv_a0[jr * 1024 + c1];
    const int st = tid >> 5, scq = tid & 31;
    const f32x4 mu4 = *(const f32x4*)(mu + 4 * scq);
    for (int tile = BID; tile < MROWS / 16; tile += GRD) {
        const int m0 = tile * 16;
        {   const int row = m0 + st, tpos = row % LP;
            const u32x2 cw = *(const u32x2*)(PL + (size_t)row * 256 + 4 * scq);
            u32x2 pw = (u32x2){0u, 0u}; if (tpos > 0) pw = *(const u32x2*)(PL + (size_t)(row - 1) * 256 + 4 * scq);
            float cv[4] = {bflo(cw.x), bfhi(cw.x), bflo(cw.y), bfhi(cw.y)}, pv[4] = {bflo(pw.x), bfhi(pw.x), bflo(pw.y), bfhi(pw.y)};
#pragma unroll
            for (int e = 0; e < 4; ++e) { const int c = 4 * scq + e; const float val = cv[e] + (pv[e] - cv[e]) * mu4[e];
                if (c < 64) tw[c * 16 + st] = tanhf(val); else ad[(c - 64) * 16 + st] = val; }
        }
        __syncthreads();
        float wa0[16], wa1[16], aa0[16], aa1[16];
#pragma unroll
        for (int t = 0; t < 16; ++t) { wa0[t] = 0.f; wa1[t] = 0.f; aa0[t] = 0.f; aa1[t] = 0.f; }
#pragma unroll 2
        for (int j = 0; j < 64; ++j) {
            const float wu0 = w_up[j * 1024 + c0], wu1 = w_up[j * 1024 + c1], au0 = a_up[j * 1024 + c0], au1 = a_up[j * 1024 + c1];
#pragma unroll
            for (int q = 0; q < 4; ++q) { const f32x4 t4 = *(const LAS f32x4*)(tw + j * 16 + 4 * q), a4 = *(const LAS f32x4*)(ad + j * 16 + 4 * q);
#pragma unroll
                for (int e = 0; e < 4; ++e) { wa0[4 * q + e] += t4[e] * wu0; wa1[4 * q + e] += t4[e] * wu1; aa0[4 * q + e] += a4[e] * au0; aa1[4 * q + e] += a4[e] * au1; } }
        }
#pragma unroll
        for (int t = 0; t < 16; ++t) { const size_t row = (size_t)(m0 + t);
            LD[row * 1024 + c0] = (bf16_t)(pk2(-DECAY_SCALE * LOG2E * sigmoidf_(w00 + wa0[t]), 0.f) & 0xffffu);
            LD[row * 1024 + c1] = (bf16_t)(pk2(-DECAY_SCALE * LOG2E * sigmoidf_(w01 + wa1[t]), 0.f) & 0xffffu);
            AA[row * 1024 + c0] = (bf16_t)(pk2(sigmoidf_(a00 + aa0[t]), 0.f) & 0xffffu);
            AA[row * 1024 + c1] = (bf16_t)(pk2(sigmoidf_(a01 + aa1[t]), 0.f) & 0xffffu); }
        __syncthreads();
    }
}

__device__ __forceinline__ void phase_scan(const Params& p, LAS unsigned char* lds, int jr) {
    const int tid = opaque_tid(), lane = tid & 63, wid = __builtin_amdgcn_readfirstlane(tid >> 6);
    LAS float* vec = (LAS float*)lds;
    LAS float* ypart = vec + 2 * 6144;
    const bf16_t* P = (const bf16_t*)(p.ws + WS_C);
    const bf16_t* LD = (const bf16_t*)(p.ws + WS_LD); const bf16_t* AA = (const bf16_t*)(p.ws + WS_AA);
    bf16_t* Y = (bf16_t*)(p.ws + WS_B);
    constexpr int NCH = 130;
    const int ht = tid & 255, ds = ht >> 4, kq = lane & 15, rl = lane >> 4;
    for (int u = BID; u < 256; u += GRD) {
        const int bh = u >> 1, half = u & 1, b = bh >> 4, h = bh & 15;
        const int kcol = h * 64 + 4 * kq;
        const float* mu = p.rwkv_mu + (size_t)jr * RWKV_IN;
        f32x4 mur, muk, muv, kk4, ka4;
        u32x2 rw, kw, vw, rp, kp_, vp, lw, aw;
        if (wid >= 4) { mur = *(const f32x4*)(mu + kcol); muk = *(const f32x4*)(mu + 1024 + kcol); muv = *(const f32x4*)(mu + 2048 + kcol);
            kk4 = *(const f32x4*)(p.rwkv_k_k + jr * 1024 + kcol); ka4 = *(const f32x4*)(p.rwkv_k_a + jr * 1024 + kcol); }
#define SC_LOADRAW(ch) do { const int t_ = (ch) * 16 + ds; const size_t row_ = (size_t)b * LP + t_; const bf16_t* pr_ = P + row_ * 4096 + kcol; \
        rw = *(const u32x2*)pr_; kw = *(const u32x2*)(pr_ + 1024); vw = *(const u32x2*)(pr_ + 2048); \
        rp = (u32x2){0u, 0u}; kp_ = rp; vp = rp; \
        if (t_ > 0) { rp = *(const u32x2*)(pr_ - 4096); kp_ = *(const u32x2*)(pr_ - 4096 + 1024); vp = *(const u32x2*)(pr_ - 4096 + 2048); } \
        lw = *(const u32x2*)(LD + row_ * 1024 + kcol); aw = *(const u32x2*)(AA + row_ * 1024 + kcol); } while (0)
#define SC_DERIVE(buf) do { \
        const f32x4 rc = {bflo(rw.x), bfhi(rw.x), bflo(rw.y), bfhi(rw.y)}, kc_ = {bflo(kw.x), bfhi(kw.x), bflo(kw.y), bfhi(kw.y)}, vc = {bflo(vw.x), bfhi(vw.x), bflo(vw.y), bfhi(vw.y)}; \
        const f32x4 rpv = {bflo(rp.x), bfhi(rp.x), bflo(rp.y), bfhi(rp.y)}, kpv = {bflo(kp_.x), bfhi(kp_.x), bflo(kp_.y), bfhi(kp_.y)}, vpv = {bflo(vp.x), bfhi(vp.x), bflo(vp.y), bfhi(vp.y)}; \
        const f32x4 ldv = {bflo(lw.x), bfhi(lw.x), bflo(lw.y), bfhi(lw.y)}, av = {bflo(aw.x), bfhi(aw.x), bflo(aw.y), bfhi(aw.y)}; \
        const f32x4 rlp = rc + (rpv - rc) * mur, klp = kc_ + (kpv - kc_) * muk, vlp = vc + (vpv - vc) * muv; \
        const f32x4 kkv = klp * kk4; \
        float ss = (kkv[0] * kkv[0] + kkv[1] * kkv[1]) + (kkv[2] * kkv[2] + kkv[3] * kkv[3]); \
        ss = red16(ss); \
        const float inv = 1.f / fmaxf(sqrtf(ss), 1e-12f); \
        const f32x4 kkn = kkv * inv; \
        const f32x4 kpr = klp * (1.f + (av - 1.f) * ka4); \
        f32x4 wv; wv[0] = __builtin_amdgcn_exp2f(ldv[0]); wv[1] = __builtin_amdgcn_exp2f(ldv[1]); wv[2] = __builtin_amdgcn_exp2f(ldv[2]); wv[3] = __builtin_amdgcn_exp2f(ldv[3]); \
        LAS float* vs = vec + (buf) * 6144 + ds * 384 + 4 * kq; \
        *(LAS f32x4*)(vs) = wv; *(LAS f32x4*)(vs + 64) = -kkn; *(LAS f32x4*)(vs + 128) = kkn * av; *(LAS f32x4*)(vs + 192) = kpr; *(LAS f32x4*)(vs + 256) = rlp; *(LAS f32x4*)(vs + 320) = vlp; } while (0)
#define SC_YREDUCE(chunk, buf) do { \
        _Pragma("unroll") for (int j_ = 0; j_ < 8; ++j_) { const int idx_ = ht + 256 * j_; \
            const f32x4 x_ = *(const LAS f32x4*)(ypart + (buf) * 8192 + idx_ * 4); \
            float pa_ = x_[0] + x_[2], pb_ = x_[1] + x_[3]; \
            pa_ += dppf<0xB1>(pa_); pb_ += dppf<0xB1>(pb_); pa_ += dppf<0x4E>(pa_); pb_ += dppf<0x4E>(pb_); pa_ += dppf<0x141>(pa_); pb_ += dppf<0x141>(pb_); \
            if ((ht & 7) == 0) { const int g_ = idx_ >> 3, s_ = g_ >> 4, cw_ = (g_ >> 2) & 3, rl_ = g_ & 3; \
                *(unsigned*)(Y + ((size_t)b * LP + (chunk) * 16 + s_) * 1024 + h * 64 + 32 * half + 8 * cw_ + 2 * rl_) = pk2(pa_, pb_); } } } while (0)
        if (wid >= 4) { SC_LOADRAW(0); SC_DERIVE(0); SC_LOADRAW(1); }
        __syncthreads();
        f32x4 SA = {0.f, 0.f, 0.f, 0.f}, SB = {0.f, 0.f, 0.f, 0.f};
        if (wid < 4) __builtin_amdgcn_s_setprio(2);
        for (int ch = 0; ch < NCH; ++ch) {
            const int buf = ch & 1;
            if (wid < 4) {
                const LAS float* vb = vec + buf * 6144 + 4 * kq;
                const LAS float* vvp = vec + buf * 6144 + 320 + 32 * half + 8 * wid + 2 * rl;
                LAS float* yp = ypart + buf * 8192 + (wid * 64 + lane) * 2;
                f32x4 w4 = *(const LAS f32x4*)(vb), a4 = *(const LAS f32x4*)(vb + 64), b4 = *(const LAS f32x4*)(vb + 128), k4 = *(const LAS f32x4*)(vb + 192), r4 = *(const LAS f32x4*)(vb + 256);
                f32x2 vv = *(const LAS f32x2*)(vvp);
#pragma unroll
                for (int s = 0; s < 16; ++s) {
                    f32x4 nw = w4, na = a4, nb = b4, nk = k4, nr = r4; f32x2 nv = vv;
                    if (s < 15) { nw = *(const LAS f32x4*)(vb + (s + 1) * 384); na = *(const LAS f32x4*)(vb + (s + 1) * 384 + 64); nb = *(const LAS f32x4*)(vb + (s + 1) * 384 + 128);
                        nk = *(const LAS f32x4*)(vb + (s + 1) * 384 + 192); nr = *(const LAS f32x4*)(vb + (s + 1) * 384 + 256); nv = *(const LAS f32x2*)(vvp + (s + 1) * 384); }
                    float saA = __builtin_fmaf(SA[3], a4[3], __builtin_fmaf(SA[2], a4[2], __builtin_fmaf(SA[1], a4[1], SA[0] * a4[0])));
                    float saB = __builtin_fmaf(SB[3], a4[3], __builtin_fmaf(SB[2], a4[2], __builtin_fmaf(SB[1], a4[1], SB[0] * a4[0])));
                    saA += dppf<0xB1>(saA); saB += dppf<0xB1>(saB); saA += dppf<0x4E>(saA); saB += dppf<0x4E>(saB);
                    saA += dppf<0x141>(saA); saB += dppf<0x141>(saB); saA += dppf<0x140>(saA); saB += dppf<0x140>(saB);
                    SA = SA * w4 + vv[0] * k4 + saA * b4; SB = SB * w4 + vv[1] * k4 + saB * b4;
                    const float yA = __builtin_fmaf(SA[3], r4[3], __builtin_fmaf(SA[2], r4[2], __builtin_fmaf(SA[1], r4[1], SA[0] * r4[0])));
                    const float yB = __builtin_fmaf(SB[3], r4[3], __builtin_fmaf(SB[2], r4[2], __builtin_fmaf(SB[1], r4[1], SB[0] * r4[0])));
                    *(LAS f32x2*)(yp + s * 512) = (f32x2){yA, yB};
                    w4 = nw; a4 = na; b4 = nb; k4 = nk; r4 = nr; vv = nv;
                }
            } else {
                if (ch + 1 < NCH) SC_DERIVE(buf ^ 1);
                if (ch + 2 < NCH) SC_LOADRAW(ch + 2);
                if (ch > 0) SC_YREDUCE(ch - 1, buf ^ 1);
            }
            __syncthreads();
        }
        if (wid < 4) __builtin_amdgcn_s_setprio(0);
        else SC_YREDUCE(NCH - 1, (NCH - 1) & 1);
        __syncthreads();
#undef SC_LOADRAW
#undef SC_DERIVE
#undef SC_YREDUCE
    }
}

__device__ __forceinline__ void phase_r4(const Params& p, int jr) {
    const int tid = opaque_tid(), lane = tid & 63, wave = __builtin_amdgcn_readfirstlane(tid >> 6);
    const int gw = BID * 8 + wave, NGW = GRD * 8;
    const bf16_t* P = (const bf16_t*)(p.ws + WS_C); const bf16_t* AA = (const bf16_t*)(p.ws + WS_AA); const bf16_t* Y = (const bf16_t*)(p.ws + WS_B);
    bf16_t* YG = (bf16_t*)(p.ws + WS_LD);
    const float* mu = p.rwkv_mu + (size_t)jr * RWKV_IN;
    for (int it = gw; it < 2048; it += NGW) {
        const int tile = it >> 2, q = it & 3, c = 256 * q + 4 * lane;
        const f32x4 mur = *(const f32x4*)(mu + c), muk = *(const f32x4*)(mu + 1024 + c), muv = *(const f32x4*)(mu + 2048 + c), mug = *(const f32x4*)(mu + 3072 + c);
        const f32x4 ka4 = *(const f32x4*)(p.rwkv_k_a + jr * 1024 + c), rk4 = *(const f32x4*)(p.rwkv_r_k + jr * 1024 + c);
        const f32x4 lnw = *(const f32x4*)(p.rwkv_ln_w + jr * 1024 + c), lnb = *(const f32x4*)(p.rwkv_ln_b + jr * 1024 + c);
        const int m0 = tile * 33;
        f32x4 rp = {0.f, 0.f, 0.f, 0.f}, kp = rp, vp = rp, gp = rp;
        if (m0 % LP != 0) { const bf16_t* pr = P + (size_t)(m0 - 1) * 4096 + c;
            const u32x2 a = *(const u32x2*)pr, b2 = *(const u32x2*)(pr + 1024), c2 = *(const u32x2*)(pr + 2048), d2 = *(const u32x2*)(pr + 3072);
            rp = (f32x4){bflo(a.x), bfhi(a.x), bflo(a.y), bfhi(a.y)}; kp = (f32x4){bflo(b2.x), bfhi(b2.x), bflo(b2.y), bfhi(b2.y)};
            vp = (f32x4){bflo(c2.x), bfhi(c2.x), bflo(c2.y), bfhi(c2.y)}; gp = (f32x4){bflo(d2.x), bfhi(d2.x), bflo(d2.y), bfhi(d2.y)}; }
#pragma unroll 3
        for (int i = 0; i < 33; ++i) {
            const size_t row = (size_t)(m0 + i);
            const bf16_t* pr = P + row * 4096 + c;
            const u32x2 a = *(const u32x2*)pr, b2 = *(const u32x2*)(pr + 1024), c2 = *(const u32x2*)(pr + 2048), d2 = *(const u32x2*)(pr + 3072);
            const u32x2 aw = *(const u32x2*)(AA + row * 1024 + c), yw = *(const u32x2*)(Y + row * 1024 + c);
            const f32x4 rc = {bflo(a.x), bfhi(a.x), bflo(a.y), bfhi(a.y)}, kc = {bflo(b2.x), bfhi(b2.x), bflo(b2.y), bfhi(b2.y)};
            const f32x4 vc = {bflo(c2.x), bfhi(c2.x), bflo(c2.y), bfhi(c2.y)}, gc = {bflo(d2.x), bfhi(d2.x), bflo(d2.y), bfhi(d2.y)};
            const f32x4 av = {bflo(aw.x), bfhi(aw.x), bflo(aw.y), bfhi(aw.y)}, yv = {bflo(yw.x), bfhi(yw.x), bflo(yw.y), bfhi(yw.y)};
            const f32x4 rl = rc + (rp - rc) * mur, kl = kc + (kp - kc) * muk, vl = vc + (vp - vc) * muv, gl = gc + (gp - gc) * mug;
            rp = rc; kp = kc; vp = vc; gp = gc;
            const f32x4 kpr = kl * (1.f + (av - 1.f) * ka4);
            const f32x4 bt = rl * kpr * rk4;
            const float bonus = red16((bt[0] + bt[1]) + (bt[2] + bt[3]));
            const float mean = red16((yv[0] + yv[1]) + (yv[2] + yv[3])) * (1.f / 64.f);
            const f32x4 d = yv - mean;
            const float var = red16((d[0] * d[0] + d[1] * d[1]) + (d[2] * d[2] + d[3] * d[3])) * (1.f / 64.f);
            const float rstd = 1.0f / sqrtf(var + GN_EPS);
            const f32x4 o = (d * rstd * lnw + lnb) + bonus * vl;
            u32x2 w; w.x = pk2(o[0] * gl[0] * sigmoidf_(gl[0]), o[1] * gl[1] * sigmoidf_(gl[1])); w.y = pk2(o[2] * gl[2] * sigmoidf_(gl[2]), o[3] * gl[3] * sigmoidf_(gl[3]));
            *(u32x2*)(YG + row * 1024 + c) = w;
        }
    }
}

#define XB_TMO      128
#define XB_XCNT(j)  (256  + 64 * (j))
#define XB_XSUB(j)  (1280 + 64 * (j))
#define XB_XGEN(j)  (2304 + 64 * (j))
#define XB_TOP      3328
#define XB_TOPGEN   3392
#define XCD_BAR_WORDS 3456
#define XB_SPIN_CAP (1u << 18)

__device__ __forceinline__ unsigned xb_ld(unsigned* p)              { return __hip_atomic_load(p, __ATOMIC_RELAXED, __HIP_MEMORY_SCOPE_AGENT); }
__device__ __forceinline__ unsigned xb_add(unsigned* p, unsigned v) { return __hip_atomic_fetch_add(p, v, __ATOMIC_RELAXED, __HIP_MEMORY_SCOPE_AGENT); }
__device__ __forceinline__ unsigned xb_xcc_id() { return (unsigned)__builtin_amdgcn_s_getreg((3 << 11) | 20) & 0xFu; }
#define XB_SPIN(cond, bar) do { unsigned _sp = 0; while (cond) { __builtin_amdgcn_s_sleep(1); \
    if ((++_sp & 255u) == 0u) { if (xb_ld(&(bar)[XB_TMO])) break; if (_sp > XB_SPIN_CAP) { atomicAdd(&(bar)[XB_TMO], 1u); break; } } } } while (0)

struct XcdBarrier {
    unsigned* bar; unsigned x;
    volatile LAS unsigned* st;
};

__device__ __forceinline__ XcdBarrier xcd_barrier_post(unsigned* bar, volatile LAS unsigned* st) {
    XcdBarrier b; b.bar = bar; b.x = xb_xcc_id(); b.st = st;
    if (threadIdx.x == 0) (void)xb_add(&bar[XB_XCNT(b.x)], 1u);
    return b;
}
__device__ __forceinline__ void xcd_barrier_complete(unsigned* bar, unsigned x, unsigned& nloc, unsigned& nx) {
    const unsigned G = gridDim.x * gridDim.y * gridDim.z;
    unsigned sum, cnt, mine, sp = 0u;
    for (;;) {
        sum = 0u; cnt = 0u; mine = 0u;
#pragma unroll
        for (unsigned j = 0; j < 16; ++j) { const unsigned c = xb_ld(&bar[XB_XCNT(j)]); sum += c; cnt += (c > 0u) ? 1u : 0u; mine = (j == x) ? c : mine; }
        if (sum == G) break;
        __builtin_amdgcn_s_sleep(1);
        if ((++sp & 255u) == 0u) { if (xb_ld(&bar[XB_TMO])) break; if (sp > XB_SPIN_CAP) { atomicAdd(&bar[XB_TMO], 1u); break; } }
    }
    nloc = mine > 0u ? mine : 1u; nx = cnt > 0u ? cnt : 1u;
}

__device__ __forceinline__ void xcd_barrier(const XcdBarrier& b) {
    asm volatile("s_waitcnt vmcnt(0)" ::: "memory");
    __syncthreads();
    if (threadIdx.x == 0) {
        unsigned* bar = b.bar;
        __builtin_amdgcn_s_waitcnt(0);
        unsigned nloc = b.st[0], nx = b.st[1];
        if (nloc == 0u) { xcd_barrier_complete(bar, b.x, nloc, nx); b.st[0] = nloc; b.st[1] = nx; }
        const unsigned old = xb_add(&bar[XB_XSUB(b.x)], 1u);
        const unsigned gen = old / nloc;
        if (old + 1u == (gen + 1u) * nloc) {
            __builtin_amdgcn_fence(__ATOMIC_RELEASE, "agent");
            asm volatile("s_waitcnt vmcnt(0)" ::: "memory");
            const unsigned og = xb_add(&bar[XB_TOP], 1u);
            const unsigned tg = og / nx;
            if (og + 1u == (tg + 1u) * nx) xb_add(&bar[XB_TOPGEN], 1u);
            else XB_SPIN(xb_ld(&bar[XB_TOPGEN]) == tg, bar);
            __builtin_amdgcn_fence(__ATOMIC_ACQUIRE, "agent");
            xb_add(&bar[XB_XGEN(b.x)], 1u);
            asm volatile("s_waitcnt vmcnt(0)" ::: "memory");
        } else {
            XB_SPIN(xb_ld(&bar[XB_XGEN(b.x)]) == gen, bar);
            __builtin_amdgcn_fence(__ATOMIC_ACQUIRE, "agent");
            asm volatile("s_waitcnt vmcnt(0)" ::: "memory");
        }
    }
    __syncthreads();
}

__global__ void __launch_bounds__(512, 2) fwd_megakernel(Params p) {
    extern __shared__ __attribute__((aligned(16))) unsigned char lds_raw[];
    LAS unsigned char* lds = (LAS unsigned char*)lds_raw;
    cg::grid_group grid = cg::this_grid();
    bf16_t* U = (bf16_t*)(p.ws + WS_B); bf16_t* WIN = (bf16_t*)(p.ws + WS_WIN); bf16_t* WOUT = (bf16_t*)(p.ws + WS_WOUT);
    bf16_t* P = (bf16_t*)(p.ws + WS_C); bf16_t* PL = (bf16_t*)(p.ws + WS_PL); float* MB = (float*)(p.ws + WS_C);
    volatile LAS unsigned* st = (volatile LAS unsigned*)(lds + LDS_BYTES - 64);
    if (threadIdx.x < 2) st[threadIdx.x] = 0u;
    __syncthreads();
    XcdBarrier bar = xcd_barrier_post((unsigned*)p.ws + 4096, st);
    phase_e<0>(p, lds, 0, -1);
    grid.sync();
#pragma unroll 1
    for (int layer = 0; layer < 4; ++layer) {
        const int jr = layer >> 1; const bool rw = (layer & 1) != 0;
        if (!rw) phase_cumsum(p, lds);
        {   pg8::Gemm g{U, WIN, MROWS, rw ? 4352 : 4096, 1024}; pg8::StaticOrder S; S.init(MROWS, rw ? 4352 : 4096, (int)GRD, (int)BID);
            pg8::EpiP E{P, PL, rw ? 1.f : 0.125f * LOG2E, rw ? 0 : 1024};
            pg8::gemm_phase<pg8::EpiP, pg8::StaticOrder, true, true>(lds, g, S, E); }
        xcd_barrier(bar);
        if (!rw) { phase_attn(p, lds); xcd_barrier(bar); }
        else { phase_lora(p, lds, jr); xcd_barrier(bar); phase_scan(p, lds, jr); xcd_barrier(bar); phase_r4(p, jr); xcd_barrier(bar); }
        {   pg8::Gemm g{rw ? (const bf16_t*)(p.ws + WS_LD) : (const bf16_t*)(p.ws + WS_B), WOUT, MROWS, 1024, 1024}; pg8::StaticOrder S; S.init(MROWS, 1024, (int)GRD, (int)BID);
            pg8::EpiF32 E{MB, 1024};
            pg8::gemm_phase<pg8::EpiF32, pg8::StaticOrder, true, true>(lds, g, S, E); }
        xcd_barrier(bar);
        phase_e<1>(p, lds, layer < 3 ? layer + 1 : -1, layer);
        if (layer < 3) xcd_barrier(bar);
    }
}

extern "C" void kernel_launch(void* const* d_in, const int* in_sizes, int n_in, void* d_out, int out_size, void* d_ws, size_t ws_size, hipStream_t stream) {
    static int grid_blocks = 0;
    if (grid_blocks == 0) {
        if (n_in != 19 || ws_size < WS_END) { fprintf(stderr, "kernel_launch: unexpected inputs (n_in %d, ws %zu)\n", n_in, ws_size); grid_blocks = -1; return; }
        int dev = 0, cus = 0, per_cu = 0;
        hipGetDevice(&dev); hipDeviceGetAttribute(&cus, hipDeviceAttributeMultiprocessorCount, dev);
        if (hipFuncSetAttribute((const void*)fwd_megakernel, hipFuncAttributeMaxDynamicSharedMemorySize, LDS_BYTES) != hipSuccess) { fprintf(stderr, "kernel_launch: hipFuncSetAttribute failed\n"); grid_blocks = -1; return; }
        if (hipOccupancyMaxActiveBlocksPerMultiprocessor(&per_cu, (const void*)fwd_megakernel, 512, LDS_BYTES) != hipSuccess || per_cu < 1) { fprintf(stderr, "kernel_launch: occupancy query failed (%d)\n", per_cu); (void)hipGetLastError(); grid_blocks = -1; return; }
        grid_blocks = cus * (per_cu > 1 ? 1 : per_cu);
    }
    if (grid_blocks < 0) return;
    if (hipMemsetAsync(d_ws, 0, 65536, stream) != hipSuccess) { fprintf(stderr, "kernel_launch: memset failed\n"); return; }
    Params p{};
    const float** f = (const float**)&p;
    for (int i = 0; i < 19; ++i) f[i] = (const float*)d_in[i];
    p.out = (float*)d_out; p.ws = (unsigned char*)d_ws;
    void* args[] = {&p};
    hipError_t e = hipLaunchCooperativeKernel((const void*)fwd_megakernel, dim3(grid_blocks), dim3(512), args, LDS_BYTES, stream);
    if (e != hipSuccess) fprintf(stderr, "cooperative launch failed: %s (grid %d)\n", hipGetErrorString(e), grid_blocks);
}
```

```cpp
#include <hip/hip_runtime.h>
#include <hip/hip_cooperative_groups.h>
#include <cstdio>
#include <cstdint>
namespace cg = cooperative_groups;
__device__ __forceinline__ int opaque_tid() { int t = threadIdx.x; asm volatile("" : "+v"(t)); return t; }
__device__ __forceinline__ int opaque_bid() { int t = blockIdx.x; asm volatile("" : "+s"(t)); return t; }
__device__ __forceinline__ int opaque_grid() { int t = gridDim.x; asm volatile("" : "+s"(t)); return t; }
namespace pg8 {
#define PG8_LAS __attribute__((address_space(3)))
typedef unsigned short bf16_t;
typedef short bf16x8 __attribute__((ext_vector_type(8)));
typedef float f32x4 __attribute__((ext_vector_type(4)));
typedef unsigned u32x4 __attribute__((ext_vector_type(4)));
constexpr int BM = 256, BK = 64, HALF = 128, HTB = HALF * BK * 2  , STAGE_BYTES = 8 * HTB, NXCD = 8, WGM = 8;

__host__ __device__ __forceinline__ int lds_byte(int r, int c) { const int st = (r >> 4) * 2 + (c >> 5), rr = r & 15, cc = c & 31, ob = rr * 64 + cc * 2; return st * 1024 + (ob ^ (((ob >> 9) & 1) << 5)); }
__host__ __device__ __forceinline__ void stage_rc(int b, int& R, int& C) { const int st = b / 1024, sb = b % 1024, swz = sb ^ (((sb >> 9) & 1) << 5); R = (st >> 1) * 16 + swz / 64; C = (st & 1) * 32 + (swz % 64) / 2; }
__host__ __device__ __forceinline__ int perm32(int rho) { const int n = rho >> 4, i = rho & 15; return 8 * (i >> 2) + 4 * n + (i & 3); }

struct Unit { int pm, pn; };
struct Gemm { const bf16_t* A; const bf16_t* Bt; int M, N, K; };

struct StaticOrder {
    int nM, nN, nwg, G, c;
    __host__ __device__ void init(int M, int N, int G_, int c_) { nM = M / BM; nN = N / BM; nwg = nM * nN; G = G_; c = c_; }
    __host__ __device__ bool next(int i, Unit& u) const {
        const long L = (long)i * G + c; if (L >= nwg) return false;
        int wgid = (int)L; { const int q = nwg / NXCD, r = nwg % NXCD, xcd = wgid % NXCD, off = wgid / NXCD; wgid = (xcd < r ? xcd * (q + 1) : r * (q + 1) + (xcd - r) * q) + off; }
        const int nig = WGM * nN, gid = wgid / nig, fm = gid * WGM, gsz = (nM - fm) < WGM ? (nM - fm) : WGM;
        u.pm = fm + ((wgid % nig) % gsz); u.pn = (wgid % nig) / gsz; return true;
    }
    __device__ __forceinline__ void a_ready(const Unit&) const {}
    __device__ __forceinline__ void done(const Unit&) const {}
};

__device__ __forceinline__ unsigned cvt_pk_bf16(float lo, float hi) { unsigned r; asm volatile("v_cvt_pk_bf16_f32 %0, %1, %2" : "=v"(r) : "v"(lo), "v"(hi)); return r; }
typedef float f32x2 __attribute__((ext_vector_type(2)));
typedef __bf16 bf16x2_t __attribute__((ext_vector_type(2)));
__device__ __forceinline__ unsigned pk2(float lo, float hi) { f32x2 v = {lo, hi}; bf16x2_t b = __builtin_convertvector(v, bf16x2_t); return __builtin_bit_cast(unsigned, b); }
struct EpiP {
    static constexpr bool PERM = true, AFTER_DRAIN = false;
    bf16_t* P; bf16_t* PL; float qscale; int qcols;
    __device__ __forceinline__ void operator()(const f32x4 (&acc)[2][2][4][2], const Unit& u, int wr, int wc, int fr, int fq) const {
        const int row0 = u.pm * BM + wr * 64 + fr; const int colt = u.pn * BM;
        bf16_t* base; int ldc, c0;
        if (colt < 4096) { base = P; ldc = 4096; c0 = colt; } else { base = PL; ldc = 256; c0 = colt - 4096; }
        const float sc = (colt < qcols) ? qscale : 1.f;
        const int col0 = c0 + wc * 32 + 8 * fq;
#pragma unroll
        for (int ai = 0; ai < 2; ++ai)
#pragma unroll
            for (int m = 0; m < 4; ++m) { bf16_t* rowp = base + (size_t)(row0 + ai * HALF + m * 16) * ldc + col0;
#pragma unroll
                for (int bj = 0; bj < 2; ++bj) { const f32x4 v0 = acc[ai][bj][m][0] * sc, v1 = acc[ai][bj][m][1] * sc;
                    u32x4 w; w.x = pk2(v0[0], v0[1]); w.y = pk2(v0[2], v0[3]); w.z = pk2(v1[0], v1[1]); w.w = pk2(v1[2], v1[3]);
                    *(u32x4*)(rowp + bj * HALF) = w; } }
    }
};
struct EpiF32 {
    static constexpr bool PERM = false, AFTER_DRAIN = false;
    float* O; int ldc;
    __device__ __forceinline__ void operator()(const f32x4 (&acc)[2][2][4][2], const Unit& u, int wr, int wc, int fr, int fq) const {
        const int row0 = u.pm * BM + wr * 64 + fr; const int col0 = u.pn * BM + wc * 32 + 4 * fq;
#pragma unroll
        for (int ai = 0; ai < 2; ++ai)
#pragma unroll
            for (int m = 0; m < 4; ++m) { float* rowp = O + (size_t)(row0 + ai * HALF + m * 16) * ldc + col0;
#pragma unroll
                for (int bj = 0; bj < 2; ++bj)
#pragma unroll
                    for (int n = 0; n < 2; ++n) *(f32x4*)(rowp + bj * HALF + n * 16) = acc[ai][bj][m][n]; }
    }
};

struct EpiLora {
    static constexpr bool PERM = true, AFTER_DRAIN = false;
    bf16_t* LD; bf16_t* AA;
    __device__ __forceinline__ void operator()(const f32x4 (&acc)[2][2][4][2], const Unit& u, int wr, int wc, int fr, int fq) const {
        const int row0 = u.pm * BM + wr * 64 + fr; const int colt = u.pn * BM; const int t = colt >> 10;
        const int cbase = (colt & 1023) + wc * 32 + 8 * fq;
        bf16_t* base = t ? AA : LD; const float sc = t ? 1.f : -0.6065306597126334f * 1.4426950408889634f;
#pragma unroll
        for (int ai = 0; ai < 2; ++ai)
#pragma unroll
            for (int m = 0; m < 4; ++m) { bf16_t* rowp = base + (size_t)(row0 + ai * HALF + m * 16) * 1024 + cbase;
#pragma unroll
                for (int bj = 0; bj < 2; ++bj) { f32x4 v0 = acc[ai][bj][m][0], v1 = acc[ai][bj][m][1];
#pragma unroll
                    for (int e = 0; e < 4; ++e) { v0[e] = sc * __builtin_amdgcn_rcpf(1.f + __builtin_amdgcn_exp2f(-1.4426950408889634f * v0[e])); v1[e] = sc * __builtin_amdgcn_rcpf(1.f + __builtin_amdgcn_exp2f(-1.4426950408889634f * v1[e])); }
                    u32x4 w; w.x = pk2(v0[0], v0[1]); w.y = pk2(v0[2], v0[3]); w.z = pk2(v1[0], v1[1]); w.w = pk2(v1[2], v1[3]);
                    *(u32x4*)(rowp + bj * HALF) = w; __builtin_amdgcn_sched_barrier(0); } }
    }
};
template <class Epi, class Sched, bool ALIGN_EPI = false, bool SP2 = false>
__device__ __forceinline__ void gemm_phase(PG8_LAS unsigned char* lds, const Gemm g, const Sched& S, const Epi& E) {
    const int tid = opaque_tid(), wid = __builtin_amdgcn_readfirstlane(tid >> 6), lane = tid & 63, wr = wid >> 2, wc = wid & 3, fr = lane & 15, fq = lane >> 4;
    const int K = g.K, nt = K / BK;
    unsigned voffA[2], voffB[2];
#pragma unroll
    for (int i = 0; i < 2; ++i) { int R, C; stage_rc(tid * 16 + i * 8192, R, C); const int Rb = Epi::PERM ? ((R & ~31) + perm32(R & 31)) : R;
        voffA[i] = (unsigned)(R * K + C) * 2u; voffB[i] = (unsigned)(Rb * K + C) * 2u; }
    const size_t kstep = (size_t)(BK * 2);
    const size_t hstep = (size_t)HALF * K * 2;
    const size_t tstep = 2 * hstep;
    const unsigned ldsw = (unsigned)wid * 1024u;
    const int aoff = lds_byte(wr * 64 + fr, fq * 8), boff = lds_byte(wc * 32 + fr, fq * 8);
#define PG8_SA(b, h) (((b) * 2 + (h)) * HTB)
#define PG8_SB(b, h) ((4 + (b) * 2 + (h)) * HTB)
#define PG8_STAGE(bufoff, gbase, voff) do { _Pragma("unroll") for (int _i = 0; _i < 2; ++_i) \
        __builtin_amdgcn_global_load_lds((const unsigned*)((const char*)(gbase) + (voff)[_i]), (PG8_LAS unsigned*)(lds + (bufoff) + ldsw + _i * 8192), 16, 0, 0); } while (0)
#define PG8_LDA(dst, b, h) do { _Pragma("unroll") for (int m = 0; m < 4; ++m) _Pragma("unroll") for (int k = 0; k < 2; ++k) dst[m][k] = *(const PG8_LAS bf16x8*)(lds + PG8_SA(b, h) + aoff + m * 2048 + k * 1024); } while (0)
#define PG8_LDB(dst, b, h) do { _Pragma("unroll") for (int n = 0; n < 2; ++n) _Pragma("unroll") for (int k = 0; k < 2; ++k) dst[n][k] = *(const PG8_LAS bf16x8*)(lds + PG8_SB(b, h) + boff + n * 2048 + k * 1024); } while (0)
#define PG8_MMA(ai, bj, At, Bt) do { __builtin_amdgcn_s_setprio(1); _Pragma("unroll") for (int m = 0; m < 4; ++m) _Pragma("unroll") for (int n = 0; n < 2; ++n) _Pragma("unroll") for (int k = 0; k < 2; ++k) \
        acc[ai][bj][m][n] = __builtin_amdgcn_mfma_f32_16x16x32_bf16(Bt[n][k], At[m][k], acc[ai][bj][m][n], 0, 0, 0); __builtin_amdgcn_s_setprio(0); } while (0)
#define PG8_WAIT_V(n) asm volatile("s_waitcnt vmcnt(" #n ")" ::: "memory")
#define PG8_WAIT_L(n) asm volatile("s_waitcnt lgkmcnt(" #n ")" ::: "memory")
#define PG8_BAR __builtin_amdgcn_s_barrier()
#define PG8_SCHED __builtin_amdgcn_sched_barrier(0)
    Unit cur, nxt; int ui = 0;
    if (!S.next(0, cur)) return;
    f32x4 acc[2][2][4][2];
#pragma unroll
    for (int a = 0; a < 2; ++a)
#pragma unroll
        for (int b = 0; b < 2; ++b)
#pragma unroll
            for (int m = 0; m < 4; ++m)
#pragma unroll
                for (int n = 0; n < 2; ++n) acc[a][b][m][n] = (f32x4){0.f, 0.f, 0.f, 0.f};
    bf16x8 At[4][2], B0[2][2], B1[2][2];
    const char* cA = (const char*)g.A + (size_t)cur.pm * tstep; const char* cB = (const char*)g.Bt + (size_t)cur.pn * tstep;
    S.a_ready(cur);
    if constexpr (SP2) {
        PG8_STAGE(PG8_SB(0, 0), cB, voffB); PG8_STAGE(PG8_SB(0, 1), cB + hstep, voffB); PG8_STAGE(PG8_SA(0, 0), cA, voffA); PG8_STAGE(PG8_SA(0, 1), cA + hstep, voffA);
        if (wr == 1) PG8_BAR;
        PG8_WAIT_V(2); PG8_BAR;
        PG8_STAGE(PG8_SB(1, 0), cB + kstep, voffB); PG8_STAGE(PG8_SA(1, 0), cA + kstep, voffA); PG8_STAGE(PG8_SB(1, 1), cB + hstep + kstep, voffB);
        PG8_WAIT_V(6); PG8_BAR;
    } else {
        PG8_STAGE(PG8_SB(0, 0), cB, voffB); PG8_STAGE(PG8_SA(0, 0), cA, voffA); PG8_STAGE(PG8_SB(0, 1), cB + hstep, voffB); PG8_STAGE(PG8_SA(0, 1), cA + hstep, voffA);
        if (wr == 1) PG8_BAR;
        PG8_WAIT_V(4); PG8_BAR;
        PG8_STAGE(PG8_SB(1, 0), cB + kstep, voffB); PG8_STAGE(PG8_SA(1, 0), cA + kstep, voffA); PG8_STAGE(PG8_SB(1, 1), cB + hstep + kstep, voffB);
        PG8_WAIT_V(6); PG8_BAR;
    }
    for (;;) {
        const bool has_next = S.next(ui + 1, nxt);
        const char* nA = has_next ? (const char*)g.A + (size_t)nxt.pm * tstep : cA; const char* nB = has_next ? (const char*)g.Bt + (size_t)nxt.pn * tstep : cB;
        for (int t = 0; t < nt; t += 2) {
            const bool last = (t == nt - 2);
            const char* a1 = cA + (size_t)(t + 1) * kstep;
            const char* a2 = last ? nA : cA + (size_t)(t + 2) * kstep; const char* b2 = last ? nB : cB + (size_t)(t + 2) * kstep;
            const char* a3 = a2 + kstep; const char* b3 = b2 + kstep;
            if (last && has_next) S.a_ready(nxt);
            if constexpr (SP2) {
            PG8_LDB(B0, 0, 0); PG8_LDB(B1, 0, 1); PG8_SCHED; PG8_LDA(At, 0, 0); PG8_STAGE(PG8_SA(1, 1), a1 + hstep, voffA);
            PG8_WAIT_V(8); PG8_WAIT_L(0); PG8_BAR; PG8_MMA(0, 0, At, B0); PG8_MMA(0, 1, At, B1); PG8_BAR; PG8_SCHED;
            PG8_LDA(At, 0, 1); PG8_STAGE(PG8_SB(0, 0), b2, voffB); PG8_STAGE(PG8_SB(0, 1), b2 + hstep, voffB); PG8_STAGE(PG8_SA(0, 0), a2, voffA);
            PG8_WAIT_V(8); PG8_WAIT_L(0); PG8_BAR; PG8_MMA(1, 0, At, B0); PG8_MMA(1, 1, At, B1); PG8_BAR; PG8_SCHED;
            PG8_LDB(B0, 1, 0); PG8_LDB(B1, 1, 1); PG8_SCHED; PG8_LDA(At, 1, 0); PG8_STAGE(PG8_SA(0, 1), a2 + hstep, voffA);
            PG8_WAIT_V(8); PG8_WAIT_L(0); PG8_BAR; PG8_MMA(0, 0, At, B0); PG8_MMA(0, 1, At, B1); PG8_BAR; PG8_SCHED;
            PG8_LDA(At, 1, 1); PG8_STAGE(PG8_SB(1, 0), b3, voffB); PG8_STAGE(PG8_SB(1, 1), b3 + hstep, voffB); PG8_STAGE(PG8_SA(1, 0), a3, voffA);
            PG8_WAIT_V(8); PG8_WAIT_L(0); PG8_BAR; PG8_MMA(1, 0, At, B0); PG8_MMA(1, 1, At, B1); PG8_BAR; PG8_SCHED;
            } else {
            PG8_LDB(B0, 0, 0); PG8_SCHED; PG8_LDA(At, 0, 0); PG8_STAGE(PG8_SA(1, 1), a1 + hstep, voffA);
            PG8_WAIT_L(8); PG8_BAR; PG8_WAIT_L(0); PG8_MMA(0, 0, At, B0); PG8_BAR; PG8_SCHED;
            PG8_LDB(B1, 0, 1); PG8_STAGE(PG8_SB(0, 0), b2, voffB);
            PG8_BAR; PG8_WAIT_L(0); PG8_MMA(0, 1, At, B1); PG8_BAR;
            PG8_LDA(At, 0, 1); PG8_STAGE(PG8_SA(0, 0), a2, voffA);
            PG8_BAR; PG8_WAIT_L(0); PG8_MMA(1, 0, At, B0); PG8_BAR; PG8_SCHED;
            PG8_STAGE(PG8_SB(0, 1), b2 + hstep, voffB);
            PG8_WAIT_V(6); PG8_BAR; PG8_MMA(1, 1, At, B1); PG8_BAR;
            PG8_LDB(B0, 1, 0); PG8_SCHED; PG8_LDA(At, 1, 0); PG8_STAGE(PG8_SA(0, 1), a2 + hstep, voffA);
            PG8_WAIT_L(8); PG8_BAR; PG8_WAIT_L(0); PG8_MMA(0, 0, At, B0); PG8_BAR; PG8_SCHED;
            PG8_LDB(B1, 1, 1); PG8_STAGE(PG8_SB(1, 0), b3, voffB);
            PG8_BAR; PG8_WAIT_L(0); PG8_MMA(0, 1, At, B1); PG8_BAR;
            PG8_LDA(At, 1, 1); PG8_STAGE(PG8_SA(1, 0), a3, voffA);
            PG8_BAR; PG8_WAIT_L(0); PG8_MMA(1, 0, At, B0); PG8_BAR; PG8_SCHED;
            PG8_STAGE(PG8_SB(1, 1), b3 + hstep, voffB);
            PG8_WAIT_V(6); PG8_BAR; PG8_MMA(1, 1, At, B1); PG8_BAR;
            }
        }
        if constexpr (ALIGN_EPI) { if (wr == 0) PG8_BAR; }
        if constexpr (!Epi::AFTER_DRAIN) { E(acc, cur, wr, wc, fr, fq); S.done(cur); }
        if (!has_next) break;
#pragma unroll
        for (int a = 0; a < 2; ++a)
#pragma unroll
            for (int b = 0; b < 2; ++b)
#pragma unroll
                for (int m = 0; m < 4; ++m)
#pragma unroll
                    for (int n = 0; n < 2; ++n) acc[a][b][m][n] = (f32x4){0.f, 0.f, 0.f, 0.f};
        cur = nxt; cA = nA; cB = nB; ++ui;
        if constexpr (ALIGN_EPI) { if (wr == 1) PG8_BAR; }
    }
    PG8_WAIT_V(0);
    if constexpr (!ALIGN_EPI) { if (wr == 0) PG8_BAR; }
    PG8_BAR;
    if constexpr (Epi::AFTER_DRAIN) { E.fused(acc, cur, wr, wc, fr, fq, lds, wid, lane); S.done(cur); }
#undef PG8_SA
#undef PG8_SB
#undef PG8_STAGE
#undef PG8_LDA
#undef PG8_LDB
#undef PG8_MMA
#undef PG8_WAIT_V
#undef PG8_WAIT_L
#undef PG8_BAR
#undef PG8_SCHED
}
}
#define LAS __attribute__((address_space(3)))
#define BID opaque_bid()
#define GRD opaque_grid()
typedef unsigned short bf16_t;
typedef short bf16x8 __attribute__((ext_vector_type(8)));
typedef short s16x4 __attribute__((ext_vector_type(4)));
typedef float f32x4 __attribute__((ext_vector_type(4)));
typedef float f32x2 __attribute__((ext_vector_type(2)));
typedef float f32x16 __attribute__((ext_vector_type(16)));
typedef unsigned u32x4 __attribute__((ext_vector_type(4)));
typedef unsigned u32x2 __attribute__((ext_vector_type(2)));

constexpr int NB = 8, SEQ = 2048, NMETA = 16, LSEQ = SEQ + NMETA  , LP = 2112  , DM = 1024;
constexpr int MROWS = NB * LP;
constexpr int FOX_IN = 4112, RWKV_IN = 4224;
constexpr float NORM_EPS = 1e-6f, GN_EPS = 64e-5f, LOG2E = 1.4426950408889634f;
constexpr float DECAY_SCALE = 0.6065306597126334f;
constexpr int LDS_BYTES = 147456;
constexpr size_t MiB = 1u << 20;
constexpr size_t WS_WIN = 1 * MiB;
constexpr size_t WS_WOUT = 10 * MiB;
constexpr size_t WS_HMETA = 12 * MiB;
constexpr size_t WS_CUM = 13 * MiB;
constexpr size_t WS_PL = 15 * MiB;
constexpr size_t WS_B = 24 * MiB;
constexpr size_t WS_C = 57 * MiB;
constexpr size_t WS_LD = 189 * MiB;
constexpr size_t WS_AA = 222 * MiB;
constexpr size_t WS_END = 255 * MiB;
static_assert(WS_B + (size_t)MROWS * 1024 * 2 <= WS_C && WS_C + (size_t)MROWS * 4096 * 2 <= WS_LD && WS_LD + (size_t)MROWS * 2048 <= WS_AA && WS_AA + (size_t)MROWS * 2048 <= WS_END, "ws map");
static_assert(WS_PL + (size_t)MROWS * 512 <= WS_B && WS_CUM + (size_t)MROWS * 64 <= WS_PL, "ws map 2");

struct Params {
    const float *x, *meta, *norm_pre, *norm_post, *fox_w_in, *fox_b_f, *fox_w_out, *rwkv_w_in, *rwkv_mu, *rwkv_w0, *rwkv_w_up, *rwkv_a0, *rwkv_a_up,
        *rwkv_k_k, *rwkv_k_a, *rwkv_r_k, *rwkv_ln_w, *rwkv_ln_b, *rwkv_w_out;
    float* out; unsigned char* ws;
};

__device__ __forceinline__ float wave_sum(float v) {
#pragma unroll
    for (int o = 1; o < 64; o <<= 1) v += __shfl_xor(v, o);
    return v;
}
__device__ __forceinline__ unsigned pk2(float lo, float hi) { return pg8::pk2(lo, hi); }
__device__ __forceinline__ float bflo(unsigned w) { return __uint_as_float(w << 16); }
__device__ __forceinline__ float bfhi(unsigned w) { return __uint_as_float(w & 0xffff0000u); }
template <int CTRL> __device__ __forceinline__ float dppf(float v) { return __int_as_float(__builtin_amdgcn_update_dpp(0, __float_as_int(v), CTRL, 0xF, 0xF, true)); }
__device__ __forceinline__ float red16(float v) {
    v += dppf<0xB1>(v); v += dppf<0x4E>(v); v += dppf<0x141>(v); v += dppf<0x140>(v); return v;
}
__device__ __forceinline__ float sigmoidf_(float x) { return 1.f / (1.f + __expf(-x)); }
#define LDS_WAIT() asm volatile("s_waitcnt lgkmcnt(0)" ::: "memory")

__device__ __forceinline__ void transpose_item(const float* W, int ldw, bf16_t* WT, LAS float* scr, int kb, int nb, int lane) {
    const int k0 = 64 * kb, n0 = 32 * nb;
#pragma unroll 8
    for (int i = 0; i < 32; ++i) { const int kk = 2 * i + (lane >> 5); scr[kk * 33 + (lane & 31)] = W[(size_t)(k0 + kk) * ldw + n0 + (lane & 31)]; }
    LDS_WAIT();
    const int c = lane & 7;
#pragma unroll
    for (int j = 0; j < 4; ++j) { const int n = (lane >> 3) + 8 * j; const LAS float* s = scr + (8 * c) * 33 + n;
        u32x4 o; o.x = pk2(s[0 * 33], s[1 * 33]); o.y = pk2(s[2 * 33], s[3 * 33]); o.z = pk2(s[4 * 33], s[5 * 33]); o.w = pk2(s[6 * 33], s[7 * 33]);
        *(u32x4*)(WT + (size_t)(n0 + n) * 1024 + k0 + 8 * c) = o; }
    LDS_WAIT();
}

template <int MODE>
__device__ __forceinline__ void phase_e(const Params& p, LAS unsigned char* lds, int next, int prev) {
    const int tid = opaque_tid(), lane = tid & 63, wave = __builtin_amdgcn_readfirstlane(tid >> 6);
    const int G = GRD, gw = BID * 8 + wave, NGW = G * 8;
    bf16_t* U = (bf16_t*)(p.ws + WS_B);
    float* CUM = (float*)(p.ws + WS_CUM);
    float* HMETA = (float*)(p.ws + WS_HMETA);
    const float* MB = (const float*)(p.ws + WS_C);
    const bool next_fox = (next >= 0) && ((next & 1) == 0);
    LAS float* WfT = (LAS float*)lds;
    LAS float* scr = (LAS float*)(lds + 65536 + wave * 8448);
    if (next >= 0) {
        const int jn = next >> 1;
        bf16_t* WIN = (bf16_t*)(p.ws + WS_WIN); bf16_t* WOUT = (bf16_t*)(p.ws + WS_WOUT);
        if (next_fox) {
            const float* Wf = p.fox_w_in + (size_t)jn * 1024 * FOX_IN + 4096;
            for (int i = tid; i < 4096; i += 512) { const int k = i >> 2, q = i & 3; const f32x4 v = *(const f32x4*)(Wf + (size_t)k * FOX_IN + 4 * q);
                WfT[(4 * q + 0) * 1024 + k] = v[0]; WfT[(4 * q + 1) * 1024 + k] = v[1]; WfT[(4 * q + 2) * 1024 + k] = v[2]; WfT[(4 * q + 3) * 1024 + k] = v[3]; }
            const float* W = p.fox_w_in + (size_t)jn * 1024 * FOX_IN; const float* Wo = p.fox_w_out + (size_t)jn * 1024 * 1024;
            for (int it = gw; it < 16 * 128 + 16 * 32; it += NGW) {
                if (it < 16 * 128) transpose_item(W, FOX_IN, WIN, scr, it / 128, it % 128, lane);
                else { const int r = it - 16 * 128; transpose_item(Wo, 1024, WOUT, scr, r / 32, r % 32, lane); }
            }
        } else {
            const float* W = p.rwkv_w_in + (size_t)jn * 1024 * RWKV_IN; const float* Wo = p.rwkv_w_out + (size_t)jn * 1024 * 1024;
            for (int it = gw; it < 16 * 132 + 16 * 32; it += NGW) {
                if (it < 16 * 132) transpose_item(W, RWKV_IN, WIN, scr, it / 132, it % 132, lane);
                else { const int r = it - 16 * 132; transpose_item(Wo, 1024, WOUT, scr, r / 32, r % 32, lane); }
            }
            for (int i = BID * 512 + tid; i < 16384; i += G * 512) *(u32x4*)(WIN + (size_t)4224 * 1024 + (size_t)i * 8) = (u32x4){0u, 0u, 0u, 0u};
        }
    }
    __syncthreads();
    f32x4 gpo[4], gpr[4];
#pragma unroll
    for (int j = 0; j < 4; ++j) {
        gpo[j] = (MODE == 1) ? *((const f32x4*)(p.norm_post + (size_t)prev * 1024) + lane + 64 * j) : (f32x4){0.f, 0.f, 0.f, 0.f};
        gpr[j] = (next >= 0) ? *((const f32x4*)(p.norm_pre + (size_t)next * 1024) + lane + 64 * j) : (f32x4){0.f, 0.f, 0.f, 0.f};
    }
    const float bfv = (next_fox && lane < 16) ? p.fox_b_f[(next >> 1) * 16 + lane] : 0.f;
    for (int m = gw; m < MROWS; m += NGW) {
        const int b = m / LP, t = m - b * LP;
        if (t >= LSEQ) {
            if (next >= 0) { u32x2* o8 = (u32x2*)(U + (size_t)m * 1024) + lane;
#pragma unroll
                for (int j = 0; j < 4; ++j) o8[64 * j] = (u32x2){0u, 0u};
                if (next_fox && lane < 16) CUM[(size_t)m * 16 + lane] = 0.f; }
            continue;
        }
        float* hrow = (t < NMETA) ? HMETA + (size_t)(b * NMETA + t) * 1024 : p.out + ((size_t)b * SEQ + (t - NMETA)) * 1024;
        f32x4 v[4];
        if (MODE == 0) {
            const float* src = (t < NMETA) ? p.meta + (size_t)t * 1024 : p.x + ((size_t)b * SEQ + (t - NMETA)) * 1024;
#pragma unroll
            for (int j = 0; j < 4; ++j) v[j] = *((const f32x4*)src + lane + 64 * j);
        } else {
            f32x4 mv[4]; float ss = 0.f;
#pragma unroll
            for (int j = 0; j < 4; ++j) { v[j] = *((const f32x4*)hrow + lane + 64 * j); mv[j] = *((const f32x4*)(MB + (size_t)m * 1024) + lane + 64 * j);
                ss += (mv[j][0] * mv[j][0] + mv[j][1] * mv[j][1]) + (mv[j][2] * mv[j][2] + mv[j][3] * mv[j][3]); }
            const float rs = 1.0f / sqrtf(wave_sum(ss) * (1.f / 1024.f) + NORM_EPS);
#pragma unroll
            for (int j = 0; j < 4; ++j) v[j] = v[j] + mv[j] * rs * gpo[j];
        }
#pragma unroll
        for (int j = 0; j < 4; ++j) *((f32x4*)hrow + lane + 64 * j) = v[j];
        if (next >= 0) {
            float ss = 0.f;
#pragma unroll
            for (int j = 0; j < 4; ++j) ss += (v[j][0] * v[j][0] + v[j][1] * v[j][1]) + (v[j][2] * v[j][2] + v[j][3] * v[j][3]);
            const float rs = 1.0f / sqrtf(wave_sum(ss) * (1.f / 1024.f) + NORM_EPS);
            u32x2* o8 = (u32x2*)(U + (size_t)m * 1024) + lane;
#pragma unroll
            for (int j = 0; j < 4; ++j) { v[j] = v[j] * rs * gpr[j]; o8[64 * j] = (u32x2){pk2(v[j][0], v[j][1]), pk2(v[j][2], v[j][3])}; }
            if (next_fox) {
                float mine = 0.f;
#pragma unroll
                for (int hd = 0; hd < 16; ++hd) { float s = 0.f;
#pragma unroll
                    for (int j = 0; j < 4; ++j) { const f32x4 w = *((const LAS f32x4*)(WfT + hd * 1024) + lane + 64 * j); s += (v[j][0] * w[0] + v[j][1] * w[1]) + (v[j][2] * w[2] + v[j][3] * w[3]); }
                    s = wave_sum(s); if (lane == hd) mine = s; }
                if (lane < 16) { const float xx = mine + bfv; const float lf = fminf(xx, 0.f) - log1pf(__expf(-fabsf(xx))); CUM[(size_t)m * 16 + lane] = lf * LOG2E; }
            }
        }
    }
}

__device__ __forceinline__ void phase_cumsum(const Params& p, LAS unsigned char* lds) {
    const int tid = opaque_tid(); LAS float* s = (LAS float*)lds;
    float* CUM = (float*)(p.ws + WS_CUM);
    for (int j = BID; j < 128; j += GRD) {
        const int b = j >> 4, hd = j & 15; float* base = CUM + (size_t)b * LP * 16 + hd;
        float v[5]; float tot = 0.f;
#pragma unroll
        for (int e = 0; e < 5; ++e) { const int t = tid * 5 + e; v[e] = (t < LP) ? base[(size_t)t * 16] : 0.f; tot += v[e]; }
        s[tid] = tot; __syncthreads();
        for (int off = 1; off < 512; off <<= 1) { const float a = (tid >= off) ? s[tid - off] : 0.f; __syncthreads(); s[tid] += a; __syncthreads(); }
        float run = s[tid] - tot;
#pragma unroll
        for (int e = 0; e < 5; ++e) { const int t = tid * 5 + e; run += v[e]; if (t < LP) base[(size_t)t * 16] = run; }
        __syncthreads();
    }
}

__device__ __forceinline__ void phase_attn(const Params& p, LAS unsigned char* lds) {
    const int tid = opaque_tid(), lane = tid & 63, wid = __builtin_amdgcn_readfirstlane(tid >> 6), r32 = lane & 31, hi = lane >> 5;
    LAS bf16_t* Ks = (LAS bf16_t*)lds;
    LAS bf16_t* Vt = Ks + 2 * 64 * 72;
    LAS float* cks = (LAS float*)(lds + 2 * 2 * 64 * 72 * 2);
    const bf16_t* P = (const bf16_t*)(p.ws + WS_C);
    const float* CUM = (const float*)(p.ws + WS_CUM);
    bf16_t* OG = (bf16_t*)(p.ws + WS_B);
    const int kr = tid >> 3, kc = tid & 7;
    for (int u = BID; u < 1152; u += GRD) {
        const int qb = 8 - u / 128, bh = u % 128, b = bh >> 4, h = bh & 15;
        const int q0 = qb * 256;
        int NT = (q0 + 256) / 64; if (NT > LP / 64) NT = LP / 64;
        const int qw0 = q0 + 32 * wid;
        const bool active = qw0 < LP;
        const int jmax = (qw0 + 31) >> 6;
        const size_t rowb = (size_t)b * LP;
        bf16x8 qr[4];
#pragma unroll
        for (int d0 = 0; d0 < 4; ++d0) qr[d0] = active ? *(const bf16x8*)(P + (rowb + qw0 + r32) * 4096 + h * 64 + d0 * 16 + hi * 8) : (bf16x8){0, 0, 0, 0, 0, 0, 0, 0};
        const bf16_t* kg = P + (rowb + kr) * 4096 + 1024 + h * 64 + kc * 8;
        const bf16_t* vg = kg + 1024;
        const float* cgp = CUM + (rowb + (tid & 63)) * 16 + h;
        u32x4 kreg = *(const u32x4*)kg, vreg = *(const u32x4*)vg; float creg = (tid < 64) ? cgp[0] : 0.f;
#define STORE_TILE(buf) do { *(LAS u32x4*)(Ks + (buf) * 4608 + kr * 72 + kc * 8) = kreg; \
        LAS bf16_t* vt_ = Vt + (buf) * 4608 + (kc * 8) * 72 + kr; \
        vt_[0 * 72] = (bf16_t)(vreg.x & 0xffffu); vt_[1 * 72] = (bf16_t)(vreg.x >> 16); vt_[2 * 72] = (bf16_t)(vreg.y & 0xffffu); vt_[3 * 72] = (bf16_t)(vreg.y >> 16); \
        vt_[4 * 72] = (bf16_t)(vreg.z & 0xffffu); vt_[5 * 72] = (bf16_t)(vreg.z >> 16); vt_[6 * 72] = (bf16_t)(vreg.w & 0xffffu); vt_[7 * 72] = (bf16_t)(vreg.w >> 16); \
        if (tid < 64) cks[(buf) * 64 + tid] = creg; } while (0)
        STORE_TILE(0);
        __syncthreads();
        float m_run = -INFINITY, l_run = 0.f;
        f32x16 o0, o1;
#pragma unroll
        for (int r = 0; r < 16; ++r) { o0[r] = 0.f; o1[r] = 0.f; }
        for (int j = 0; j < NT; ++j) {
            const int buf = j & 1;
            if (j + 1 < NT) { kreg = *(const u32x4*)(kg + (size_t)(j + 1) * 64 * 4096); vreg = *(const u32x4*)(vg + (size_t)(j + 1) * 64 * 4096); if (tid < 64) creg = cgp[(size_t)(j + 1) * 64 * 16]; }
            if (active && j <= jmax) {
                const LAS bf16_t* Kb = Ks + buf * 4608; const LAS bf16_t* Vb = Vt + buf * 4608; const LAS float* cb = cks + buf * 64;
                f32x16 p0, p1;
#pragma unroll
                for (int i = 0; i < 4; ++i) { const f32x4 c0 = *(const LAS f32x4*)(cb + 8 * i + 4 * hi), c1 = *(const LAS f32x4*)(cb + 32 + 8 * i + 4 * hi);
#pragma unroll
                    for (int e = 0; e < 4; ++e) { p0[4 * i + e] = -c0[e]; p1[4 * i + e] = -c1[e]; } }
#pragma unroll
                for (int d0 = 0; d0 < 4; ++d0) {
                    const bf16x8 a0 = *(const LAS bf16x8*)(Kb + r32 * 72 + d0 * 16 + hi * 8), a1 = *(const LAS bf16x8*)(Kb + (32 + r32) * 72 + d0 * 16 + hi * 8);
                    p0 = __builtin_amdgcn_mfma_f32_32x32x16_bf16(a0, qr[d0], p0, 0, 0, 0); p1 = __builtin_amdgcn_mfma_f32_32x32x16_bf16(a1, qr[d0], p1, 0, 0, 0);
                }
                if (64 * j + 63 > qw0) {
                    const int qpos = qw0 + r32;
#pragma unroll
                    for (int r = 0; r < 16; ++r) { const int kv = 64 * j + (r & 3) + 8 * (r >> 2) + 4 * hi; if (kv > qpos) p0[r] = -INFINITY; if (kv + 32 > qpos) p1[r] = -INFINITY; }
                }
                float mx = fmaxf(p0[0], p1[0]);
#pragma unroll
                for (int r = 1; r < 16; ++r) mx = fmaxf(mx, fmaxf(p0[r], p1[r]));
                mx = fmaxf(mx, __shfl_xor(mx, 32));
                const float m_new = fmaxf(m_run, mx);
                const float alpha = __builtin_amdgcn_exp2f(m_run - m_new);
                m_run = m_new;
                float sum = 0.f;
#pragma unroll
                for (int r = 0; r < 16; ++r) { p0[r] = __builtin_amdgcn_exp2f(p0[r] - m_new); p1[r] = __builtin_amdgcn_exp2f(p1[r] - m_new); sum += p0[r] + p1[r]; }
                l_run = l_run * alpha + sum;
#pragma unroll
                for (int r = 0; r < 16; ++r) { o0[r] *= alpha; o1[r] *= alpha; }
#pragma unroll
                for (int c = 0; c < 4; ++c) {
                    u32x4 pw;
                    if (c < 2) { pw.x = pk2(p0[8 * c + 0], p0[8 * c + 1]); pw.y = pk2(p0[8 * c + 2], p0[8 * c + 3]); pw.z = pk2(p0[8 * c + 4], p0[8 * c + 5]); pw.w = pk2(p0[8 * c + 6], p0[8 * c + 7]); }
                    else { const int c2 = c - 2; pw.x = pk2(p1[8 * c2 + 0], p1[8 * c2 + 1]); pw.y = pk2(p1[8 * c2 + 2], p1[8 * c2 + 3]); pw.z = pk2(p1[8 * c2 + 4], p1[8 * c2 + 5]); pw.w = pk2(p1[8 * c2 + 6], p1[8 * c2 + 7]); }
                    const bf16x8 pf = __builtin_bit_cast(bf16x8, pw);
                    {   const s16x4 lo = *(const LAS s16x4*)(Vb + r32 * 72 + 16 * c + 4 * hi), h4 = *(const LAS s16x4*)(Vb + r32 * 72 + 16 * c + 4 * hi + 8);
                        const bf16x8 vf = (bf16x8){lo[0], lo[1], lo[2], lo[3], h4[0], h4[1], h4[2], h4[3]};
                        o0 = __builtin_amdgcn_mfma_f32_32x32x16_bf16(vf, pf, o0, 0, 0, 0); }
                    {   const s16x4 lo = *(const LAS s16x4*)(Vb + (32 + r32) * 72 + 16 * c + 4 * hi), h4 = *(const LAS s16x4*)(Vb + (32 + r32) * 72 + 16 * c + 4 * hi + 8);
                        const bf16x8 vf = (bf16x8){lo[0], lo[1], lo[2], lo[3], h4[0], h4[1], h4[2], h4[3]};
                        o1 = __builtin_amdgcn_mfma_f32_32x32x16_bf16(vf, pf, o1, 0, 0, 0); }
                }
            }
            if (j + 1 < NT) STORE_TILE(buf ^ 1);
            __syncthreads();
        }
#undef STORE_TILE
        if (active) {
            const float l = l_run + __shfl_xor(l_run, 32); const float inv = 1.f / l;
            const size_t row = rowb + qw0 + r32;
#pragma unroll
            for (int dh = 0; dh < 2; ++dh)
#pragma unroll
                for (int i = 0; i < 4; ++i) {
                    const int dcol = h * 64 + 32 * dh + 8 * i + 4 * hi;
                    const u32x2 gw_ = *(const u32x2*)(P + row * 4096 + 3072 + dcol);
                    const float g0 = bflo(gw_.x), g1 = bfhi(gw_.x), g2 = bflo(gw_.y), g3 = bfhi(gw_.y);
                    const float a0 = (dh ? o1[4 * i + 0] : o0[4 * i + 0]) * inv, a1 = (dh ? o1[4 * i + 1] : o0[4 * i + 1]) * inv, a2 = (dh ? o1[4 * i + 2] : o0[4 * i + 2]) * inv, a3 = (dh ? o1[4 * i + 3] : o0[4 * i + 3]) * inv;
                    u32x2 w; w.x = pk2(a0 * g0 * sigmoidf_(g0), a1 * g1 * sigmoidf_(g1)); w.y = pk2(a2 * g2 * sigmoidf_(g2), a3 * g3 * sigmoidf_(g3));
                    *(u32x2*)(OG + row * 1024 + dcol) = w;
                }
        }
    }
}

__device__ __forceinline__ void phase_lora_prep(const Params& p, int jr) {
    const int tid = opaque_tid(); const int gt = BID * 512 + tid, NTH = GRD * 512;
    const bf16_t* PL = (const bf16_t*)(p.ws + WS_PL);
    bf16_t* A = (bf16_t*)(p.ws + WS_WIN); bf16_t* Bt = (bf16_t*)(p.ws + WS_CUM);
    const float* mu = p.rwkv_mu + (size_t)jr * RWKV_IN + 4096;
    const float* w_up = p.rwkv_w_up + (size_t)jr * 64 * 1024; const float* a_up = p.rwkv_a_up + (size_t)jr * 64 * 1024;
    for (int it = gt; it < MROWS * 32; it += NTH) {
        const int row = it >> 5, cg8 = it & 31;
        u32x4 o = (u32x4){0u, 0u, 0u, 0u};
        if (cg8 < 16) {
            const int tpos = row % LP;
            const u32x4 cw = *(const u32x4*)(PL + (size_t)row * 256 + 8 * cg8);
            u32x4 pw = (u32x4){0u, 0u, 0u, 0u}; if (tpos > 0) pw = *(const u32x4*)(PL + (size_t)(row - 1) * 256 + 8 * cg8);
            const f32x4 m0 = *(const f32x4*)(mu + 8 * cg8), m1 = *(const f32x4*)(mu + 8 * cg8 + 4);
            float v[8];
            v[0] = bflo(cw.x) + (bflo(pw.x) - bflo(cw.x)) * m0[0]; v[1] = bfhi(cw.x) + (bfhi(pw.x) - bfhi(cw.x)) * m0[1];
            v[2] = bflo(cw.y) + (bflo(pw.y) - bflo(cw.y)) * m0[2]; v[3] = bfhi(cw.y) + (bfhi(pw.y) - bfhi(cw.y)) * m0[3];
            v[4] = bflo(cw.z) + (bflo(pw.z) - bflo(cw.z)) * m1[0]; v[5] = bfhi(cw.z) + (bfhi(pw.z) - bfhi(cw.z)) * m1[1];
            v[6] = bflo(cw.w) + (bflo(pw.w) - bflo(cw.w)) * m1[2]; v[7] = bfhi(cw.w) + (bfhi(pw.w) - bfhi(cw.w)) * m1[3];
            if (cg8 < 8) {
#pragma unroll
                for (int e = 0; e < 8; ++e) v[e] = tanhf(v[e]);
            }
            o.x = pk2(v[0], v[1]); o.y = pk2(v[2], v[3]); o.z = pk2(v[4], v[5]); o.w = pk2(v[6], v[7]);
        }
        if (cg8 == 16) o.x = 0x3F803F80u;
        *(u32x4*)(A + (size_t)row * 256 + 8 * cg8) = o;
    }
    for (int it = gt; it < 2048 * 32; it += NTH) {
        const int n = it & 2047, kg = it >> 11;
        u32x4 o = (u32x4){0u, 0u, 0u, 0u};
        const float* src = nullptr;
        if (n < 1024 && kg < 8) src = w_up + (size_t)(8 * kg) * 1024 + n;
        else if (n >= 1024 && kg >= 8 && kg < 16) src = a_up + (size_t)(8 * (kg - 8)) * 1024 + (n - 1024);
        if (src) { o.x = pk2(src[0], src[1024]); o.y = pk2(src[2048], src[3072]); o.z = pk2(src[4096], src[5120]); o.w = pk2(src[6144], src[7168]); }
        if (kg == 16) { const float bz = (n < 1024) ? p.rwkv_w0[jr * 1024 + n] : p.rwkv_a0[jr * 1024 + n - 1024]; const float bh = bfhi(pk2(0.f, bz)); o.x = pk2(bh, bz - bh); }
        *(u32x4*)(Bt + (size_t)n * 256 + 8 * kg) = o;
    }
}

__device__ __forceinline__ void phase_scan(const Params& p, LAS unsigned char* lds, int jr) {
    const int tid = opaque_tid(), lane = tid & 63, wid = __builtin_amdgcn_readfirstlane(tid >> 6);
    LAS float* vec = (LAS float*)lds;
    LAS float* ypart = vec + 2 * 6144;
    const bf16_t* P = (const bf16_t*)(p.ws + WS_C);
    const bf16_t* LD = (const bf16_t*)(p.ws + WS_LD); const bf16_t* AA = (const bf16_t*)(p.ws + WS_AA);
    bf16_t* Y = (bf16_t*)(p.ws + WS_B);
    constexpr int NCH = 130;
    const int ht = tid & 255, ds = ht >> 4, kq = lane & 15, rl = lane >> 4;
    for (int u = BID; u < 256; u += GRD) {
        const int bh = u >> 1, half = u & 1, b = bh >> 4, h = bh & 15;
        const int kcol = h * 64 + 4 * kq;
        const float* mu = p.rwkv_mu + (size_t)jr * RWKV_IN;
        f32x4 mur, muk, muv, kk4, ka4;
        u32x2 rw, kw, vw, rp, kp_, vp, lw, aw;
        if (wid >= 4) { mur = *(const f32x4*)(mu + kcol); muk = *(const f32x4*)(mu + 1024 + kcol); muv = *(const f32x4*)(mu + 2048 + kcol);
            kk4 = *(const f32x4*)(p.rwkv_k_k + jr * 1024 + kcol); ka4 = *(const f32x4*)(p.rwkv_k_a + jr * 1024 + kcol); }
#define SC_LOADRAW(ch) do { const int t_ = (ch) * 16 + ds; const size_t row_ = (size_t)b * LP + t_; const bf16_t* pr_ = P + row_ * 4096 + kcol; \
        rw = *(const u32x2*)pr_; kw = *(const u32x2*)(pr_ + 1024); vw = *(const u32x2*)(pr_ + 2048); \
        rp = (u32x2){0u, 0u}; kp_ = rp; vp = rp; \
        if (t_ > 0) { rp = *(const u32x2*)(pr_ - 4096); kp_ = *(const u32x2*)(pr_ - 4096 + 1024); vp = *(const u32x2*)(pr_ - 4096 + 2048); } \
        lw = *(const u32x2*)(LD + row_ * 1024 + kcol); aw = *(const u32x2*)(AA + row_ * 1024 + kcol); } while (0)
#define SC_DERIVE(buf) do { \
        const f32x4 rc = {bflo(rw.x), bfhi(rw.x), bflo(rw.y), bfhi(rw.y)}, kc_ = {bflo(kw.x), bfhi(kw.x), bflo(kw.y), bfhi(kw.y)}, vc = {bflo(vw.x), bfhi(vw.x), bflo(vw.y), bfhi(vw.y)}; \
        const f32x4 rpv = {bflo(rp.x), bfhi(rp.x), bflo(rp.y), bfhi(rp.y)}, kpv = {bflo(kp_.x), bfhi(kp_.x), bflo(kp_.y), bfhi(kp_.y)}, vpv = {bflo(vp.x), bfhi(vp.x), bflo(vp.y), bfhi(vp.y)}; \
        const f32x4 ldv = {bflo(lw.x), bfhi(lw.x), bflo(lw.y), bfhi(lw.y)}, av = {bflo(aw.x), bfhi(aw.x), bflo(aw.y), bfhi(aw.y)}; \
        const f32x4 rlp = rc + (rpv - rc) * mur, klp = kc_ + (kpv - kc_) * muk, vlp = vc + (vpv - vc) * muv; \
        const f32x4 kkv = klp * kk4; \
        float ss = (kkv[0] * kkv[0] + kkv[1] * kkv[1]) + (kkv[2] * kkv[2] + kkv[3] * kkv[3]); \
        ss = red16(ss); \
        const float inv = 1.f / fmaxf(sqrtf(ss), 1e-12f); \
        const f32x4 kkn = kkv * inv; \
        const f32x4 kpr = klp * (1.f + (av - 1.f) * ka4); \
        f32x4 wv; wv[0] = __builtin_amdgcn_exp2f(ldv[0]); wv[1] = __builtin_amdgcn_exp2f(ldv[1]); wv[2] = __builtin_amdgcn_exp2f(ldv[2]); wv[3] = __builtin_amdgcn_exp2f(ldv[3]); \
        LAS float* vs = vec + (buf) * 6144 + ds * 384 + 4 * kq; \
        *(LAS f32x4*)(vs) = wv; *(LAS f32x4*)(vs + 64) = -kkn; *(LAS f32x4*)(vs + 128) = kkn * av; *(LAS f32x4*)(vs + 192) = kpr; *(LAS f32x4*)(vs + 256) = rlp; *(LAS f32x4*)(vs + 320) = vlp; } while (0)
#define SC_YREDUCE(chunk, buf) do { \
        _Pragma("unroll") for (int j_ = 0; j_ < 8; ++j_) { const int idx_ = ht + 256 * j_; \
            const f32x4 x_ = *(const LAS f32x4*)(ypart + (buf) * 8192 + idx_ * 4); \
            float pa_ = x_[0] + x_[2], pb_ = x_[1] + x_[3]; \
            pa_ += dppf<0xB1>(pa_); pb_ += dppf<0xB1>(pb_); pa_ += dppf<0x4E>(pa_); pb_ += dppf<0x4E>(pb_); pa_ += dppf<0x141>(pa_); pb_ += dppf<0x141>(pb_); \
            if ((ht & 7) == 0) { const int g_ = idx_ >> 3, s_ = g_ >> 4, cw_ = (g_ >> 2) & 3, rl_ = g_ & 3; \
                *(unsigned*)(Y + ((size_t)b * LP + (chunk) * 16 + s_) * 1024 + h * 64 + 32 * half + 8 * cw_ + 2 * rl_) = pk2(pa_, pb_); } } } while (0)
        if (wid >= 4) { SC_LOADRAW(0); SC_DERIVE(0); SC_LOADRAW(1); }
        __syncthreads();
        f32x4 SA = {0.f, 0.f, 0.f, 0.f}, SB = {0.f, 0.f, 0.f, 0.f};
        if (wid < 4) __builtin_amdgcn_s_setprio(2);
        for (int ch = 0; ch < NCH; ++ch) {
            const int buf = ch & 1;
            if (wid < 4) {
                const LAS float* vb = vec + buf * 6144 + 4 * kq;
                const LAS float* vvp = vec + buf * 6144 + 320 + 32 * half + 8 * wid + 2 * rl;
                LAS float* yp = ypart + buf * 8192 + (wid * 64 + lane) * 2;
                f32x4 w4 = *(const LAS f32x4*)(vb), a4 = *(const LAS f32x4*)(vb + 64), b4 = *(const LAS f32x4*)(vb + 128), k4 = *(const LAS f32x4*)(vb + 192), r4 = *(const LAS f32x4*)(vb + 256);
                f32x2 vv = *(const LAS f32x2*)(vvp);
#pragma unroll
                for (int s = 0; s < 16; ++s) {
                    f32x4 nw = w4, na = a4, nb = b4, nk = k4, nr = r4; f32x2 nv = vv;
                    if (s < 15) { nw = *(const LAS f32x4*)(vb + (s + 1) * 384); na = *(const LAS f32x4*)(vb + (s + 1) * 384 + 64); nb = *(const LAS f32x4*)(vb + (s + 1) * 384 + 128);
                        nk = *(const LAS f32x4*)(vb + (s + 1) * 384 + 192); nr = *(const LAS f32x4*)(vb + (s + 1) * 384 + 256); nv = *(const LAS f32x2*)(vvp + (s + 1) * 384); }
                    float saA = __builtin_fmaf(SA[3], a4[3], __builtin_fmaf(SA[2], a4[2], __builtin_fmaf(SA[1], a4[1], SA[0] * a4[0])));
                    float saB = __builtin_fmaf(SB[3], a4[3], __builtin_fmaf(SB[2], a4[2], __builtin_fmaf(SB[1], a4[1], SB[0] * a4[0])));
                    saA += dppf<0xB1>(saA); saB += dppf<0xB1>(saB); saA += dppf<0x4E>(saA); saB += dppf<0x4E>(saB);
                    saA += dppf<0x141>(saA); saB += dppf<0x141>(saB); saA += dppf<0x140>(saA); saB += dppf<0x140>(saB);
                    SA = SA * w4 + vv[0] * k4 + saA * b4; SB = SB * w4 + vv[1] * k4 + saB * b4;
                    const float yA = __builtin_fmaf(SA[3], r4[3], __builtin_fmaf(SA[2], r4[2], __builtin_fmaf(SA[1], r4[1], SA[0] * r4[0])));
                    const float yB = __builtin_fmaf(SB[3], r4[3], __builtin_fmaf(SB[2], r4[2], __builtin_fmaf(SB[1], r4[1], SB[0] * r4[0])));
                    *(LAS f32x2*)(yp + s * 512) = (f32x2){yA, yB};
                    w4 = nw; a4 = na; b4 = nb; k4 = nk; r4 = nr; vv = nv;
                }
            } else {
                if (ch + 1 < NCH) SC_DERIVE(buf ^ 1);
                if (ch + 2 < NCH) SC_LOADRAW(ch + 2);
                if (ch > 0) SC_YREDUCE(ch - 1, buf ^ 1);
            }
            __syncthreads();
        }
        if (wid < 4) __builtin_amdgcn_s_setprio(0);
        else SC_YREDUCE(NCH - 1, (NCH - 1) & 1);
        __syncthreads();
#undef SC_LOADRAW
#undef SC_DERIVE
#undef SC_YREDUCE
    }
}

__device__ __forceinline__ void phase_r4(const Params& p, int jr) {
    const int tid = opaque_tid(), lane = tid & 63, wave = __builtin_amdgcn_readfirstlane(tid >> 6);
    const int gw = BID * 8 + wave, NGW = GRD * 8;
    const bf16_t* P = (const bf16_t*)(p.ws + WS_C); const bf16_t* AA = (const bf16_t*)(p.ws + WS_AA); const bf16_t* Y = (const bf16_t*)(p.ws + WS_B);
    bf16_t* YG = (bf16_t*)(p.ws + WS_LD);
    const float* mu = p.rwkv_mu + (size_t)jr * RWKV_IN;
    for (int it = gw; it < 2048; it += NGW) {
        const int tile = it >> 2, q = it & 3, c = 256 * q + 4 * lane;
        const f32x4 mur = *(const f32x4*)(mu + c), muk = *(const f32x4*)(mu + 1024 + c), muv = *(const f32x4*)(mu + 2048 + c), mug = *(const f32x4*)(mu + 3072 + c);
        const f32x4 ka4 = *(const f32x4*)(p.rwkv_k_a + jr * 1024 + c), rk4 = *(const f32x4*)(p.rwkv_r_k + jr * 1024 + c);
        const f32x4 lnw = *(const f32x4*)(p.rwkv_ln_w + jr * 1024 + c), lnb = *(const f32x4*)(p.rwkv_ln_b + jr * 1024 + c);
        const int m0 = tile * 33;
        f32x4 rp = {0.f, 0.f, 0.f, 0.f}, kp = rp, vp = rp, gp = rp;
        if (m0 % LP != 0) { const bf16_t* pr = P + (size_t)(m0 - 1) * 4096 + c;
            const u32x2 a = *(const u32x2*)pr, b2 = *(const u32x2*)(pr + 1024), c2 = *(const u32x2*)(pr + 2048), d2 = *(const u32x2*)(pr + 3072);
            rp = (f32x4){bflo(a.x), bfhi(a.x), bflo(a.y), bfhi(a.y)}; kp = (f32x4){bflo(b2.x), bfhi(b2.x), bflo(b2.y), bfhi(b2.y)};
            vp = (f32x4){bflo(c2.x), bfhi(c2.x), bflo(c2.y), bfhi(c2.y)}; gp = (f32x4){bflo(d2.x), bfhi(d2.x), bflo(d2.y), bfhi(d2.y)}; }
#pragma unroll 3
        for (int i = 0; i < 33; ++i) {
            const size_t row = (size_t)(m0 + i);
            const bf16_t* pr = P + row * 4096 + c;
            const u32x2 a = *(const u32x2*)pr, b2 = *(const u32x2*)(pr + 1024), c2 = *(const u32x2*)(pr + 2048), d2 = *(const u32x2*)(pr + 3072);
            const u32x2 aw = *(const u32x2*)(AA + row * 1024 + c), yw = *(const u32x2*)(Y + row * 1024 + c);
            const f32x4 rc = {bflo(a.x), bfhi(a.x), bflo(a.y), bfhi(a.y)}, kc = {bflo(b2.x), bfhi(b2.x), bflo(b2.y), bfhi(b2.y)};
            const f32x4 vc = {bflo(c2.x), bfhi(c2.x), bflo(c2.y), bfhi(c2.y)}, gc = {bflo(d2.x), bfhi(d2.x), bflo(d2.y), bfhi(d2.y)};
            const f32x4 av = {bflo(aw.x), bfhi(aw.x), bflo(aw.y), bfhi(aw.y)}, yv = {bflo(yw.x), bfhi(yw.x), bflo(yw.y), bfhi(yw.y)};
            const f32x4 rl = rc + (rp - rc) * mur, kl = kc + (kp - kc) * muk, vl = vc + (vp - vc) * muv, gl = gc + (gp - gc) * mug;
            rp = rc; kp = kc; vp = vc; gp = gc;
            const f32x4 kpr = kl * (1.f + (av - 1.f) * ka4);
            const f32x4 bt = rl * kpr * rk4;
            const float bonus = red16((bt[0] + bt[1]) + (bt[2] + bt[3]));
            const float mean = red16((yv[0] + yv[1]) + (yv[2] + yv[3])) * (1.f / 64.f);
            const f32x4 d = yv - mean;
            const float var = red16((d[0] * d[0] + d[1] * d[1]) + (d[2] * d[2] + d[3] * d[3])) * (1.f / 64.f);
            const float rstd = 1.0f / sqrtf(var + GN_EPS);
            const f32x4 o = (d * rstd * lnw + lnb) + bonus * vl;
            u32x2 w; w.x = pk2(o[0] * gl[0] * sigmoidf_(gl[0]), o[1] * gl[1] * sigmoidf_(gl[1])); w.y = pk2(o[2] * gl[2] * sigmoidf_(gl[2]), o[3] * gl[3] * sigmoidf_(gl[3]));
            *(u32x2*)(YG + row * 1024 + c) = w;
        }
    }
}

#define XB_TMO      128
#define XB_XCNT(j)  (256  + 64 * (j))
#define XB_XSUB(j)  (1280 + 64 * (j))
#define XB_XGEN(j)  (2304 + 64 * (j))
#define XB_TOP      3328
#define XB_TOPGEN   3392
#define XCD_BAR_WORDS 3456
#define XB_SPIN_CAP (1u << 18)

__device__ __forceinline__ unsigned xb_ld(unsigned* p)              { return __hip_atomic_load(p, __ATOMIC_RELAXED, __HIP_MEMORY_SCOPE_AGENT); }
__device__ __forceinline__ unsigned xb_add(unsigned* p, unsigned v) { return __hip_atomic_fetch_add(p, v, __ATOMIC_RELAXED, __HIP_MEMORY_SCOPE_AGENT); }
__device__ __forceinline__ unsigned xb_xcc_id() { return (unsigned)__builtin_amdgcn_s_getreg((3 << 11) | 20) & 0xFu; }
#define XB_SPIN(cond, bar) do { unsigned _sp = 0; while (cond) { __builtin_amdgcn_s_sleep(1); \
    if ((++_sp & 255u) == 0u) { if (xb_ld(&(bar)[XB_TMO])) break; if (_sp > XB_SPIN_CAP) { atomicAdd(&(bar)[XB_TMO], 1u); break; } } } } while (0)

struct XcdBarrier {
    unsigned* bar; unsigned x;
    volatile LAS unsigned* st;
};

__device__ __forceinline__ XcdBarrier xcd_barrier_post(unsigned* bar, volatile LAS unsigned* st) {
    XcdBarrier b; b.bar = bar; b.x = xb_xcc_id(); b.st = st;
    if (threadIdx.x == 0) (void)xb_add(&bar[XB_XCNT(b.x)], 1u);
    return b;
}
__device__ __forceinline__ void xcd_barrier_complete(unsigned* bar, unsigned x, unsigned& nloc, unsigned& nx) {
    const unsigned G = gridDim.x * gridDim.y * gridDim.z;
    unsigned sum, cnt, mine, sp = 0u;
    for (;;) {
        sum = 0u; cnt = 0u; mine = 0u;
#pragma unroll
        for (unsigned j = 0; j < 16; ++j) { const unsigned c = xb_ld(&bar[XB_XCNT(j)]); sum += c; cnt += (c > 0u) ? 1u : 0u; mine = (j == x) ? c : mine; }
        if (sum == G) break;
        __builtin_amdgcn_s_sleep(1);
        if ((++sp & 255u) == 0u) { if (xb_ld(&bar[XB_TMO])) break; if (sp > XB_SPIN_CAP) { atomicAdd(&bar[XB_TMO], 1u); break; } }
    }
    nloc = mine > 0u ? mine : 1u; nx = cnt > 0u ? cnt : 1u;
}

__device__ __forceinline__ void xcd_barrier(const XcdBarrier& b) {
    asm volatile("s_waitcnt vmcnt(0)" ::: "memory");
    __syncthreads();
    if (threadIdx.x == 0) {
        unsigned* bar = b.bar;
        __builtin_amdgcn_s_waitcnt(0);
        unsigned nloc = b.st[0], nx = b.st[1];
        if (nloc == 0u) { xcd_barrier_complete(bar, b.x, nloc, nx); b.st[0] = nloc; b.st[1] = nx; }
        const unsigned old = xb_add(&bar[XB_XSUB(b.x)], 1u);
        const unsigned gen = old / nloc;
        if (old + 1u == (gen + 1u) * nloc) {
            __builtin_amdgcn_fence(__ATOMIC_RELEASE, "agent");
            asm volatile("s_waitcnt vmcnt(0)" ::: "memory");
            const unsigned og = xb_add(&bar[XB_TOP], 1u);
            const unsigned tg = og / nx;
            if (og + 1u == (tg + 1u) * nx) xb_add(&bar[XB_TOPGEN], 1u);
            else XB_SPIN(xb_ld(&bar[XB_TOPGEN]) == tg, bar);
            __builtin_amdgcn_fence(__ATOMIC_ACQUIRE, "agent");
            xb_add(&bar[XB_XGEN(b.x)], 1u);
            asm volatile("s_waitcnt vmcnt(0)" ::: "memory");
        } else {
            XB_SPIN(xb_ld(&bar[XB_XGEN(b.x)]) == gen, bar);
            __builtin_amdgcn_fence(__ATOMIC_ACQUIRE, "agent");
            asm volatile("s_waitcnt vmcnt(0)" ::: "memory");
        }
    }
    __syncthreads();
}

__global__ void __launch_bounds__(512, 2) fwd_megakernel(Params p) {
    extern __shared__ __attribute__((aligned(16))) unsigned char lds_raw[];
    LAS unsigned char* lds = (LAS unsigned char*)lds_raw;
    cg::grid_group grid = cg::this_grid();
    bf16_t* U = (bf16_t*)(p.ws + WS_B); bf16_t* WIN = (bf16_t*)(p.ws + WS_WIN); bf16_t* WOUT = (bf16_t*)(p.ws + WS_WOUT);
    bf16_t* P = (bf16_t*)(p.ws + WS_C); bf16_t* PL = (bf16_t*)(p.ws + WS_PL); float* MB = (float*)(p.ws + WS_C);
    volatile LAS unsigned* st = (volatile LAS unsigned*)(lds + LDS_BYTES - 64);
    if (threadIdx.x < 2) st[threadIdx.x] = 0u;
    __syncthreads();
    XcdBarrier bar = xcd_barrier_post((unsigned*)p.ws + 4096, st);
    phase_e<0>(p, lds, 0, -1);
    grid.sync();
#pragma unroll 1
    for (int layer = 0; layer < 4; ++layer) {
        const int jr = layer >> 1; const bool rw = (layer & 1) != 0;
        if (!rw) phase_cumsum(p, lds);
        {   pg8::Gemm g{U, WIN, MROWS, rw ? 4352 : 4096, 1024}; pg8::StaticOrder S; S.init(MROWS, rw ? 4352 : 4096, (int)GRD, (int)BID);
            pg8::EpiP E{P, PL, rw ? 1.f : 0.125f * LOG2E, rw ? 0 : 1024};
            pg8::gemm_phase<pg8::EpiP, pg8::StaticOrder, true, true>(lds, g, S, E); }
        xcd_barrier(bar);
        if (!rw) { phase_attn(p, lds); xcd_barrier(bar); }
        else { phase_lora_prep(p, jr); xcd_barrier(bar);
            {   int kl_ = 256; asm volatile("" : "+s"(kl_));
                pg8::Gemm g{(const bf16_t*)(p.ws + WS_WIN), (const bf16_t*)(p.ws + WS_CUM), MROWS, 2048, kl_}; pg8::StaticOrder S; S.init(MROWS, 2048, (int)GRD, (int)BID);
                pg8::EpiLora E{(bf16_t*)(p.ws + WS_LD), (bf16_t*)(p.ws + WS_AA)};
                pg8::gemm_phase<pg8::EpiLora, pg8::StaticOrder, true, true>(lds, g, S, E); }
            xcd_barrier(bar); phase_scan(p, lds, jr); xcd_barrier(bar); phase_r4(p, jr); xcd_barrier(bar); }
        {   pg8::Gemm g{rw ? (const bf16_t*)(p.ws + WS_LD) : (const bf16_t*)(p.ws + WS_B), WOUT, MROWS, 1024, 1024}; pg8::StaticOrder S; S.init(MROWS, 1024, (int)GRD, (int)BID);
            pg8::EpiF32 E{MB, 1024};
            pg8::gemm_phase<pg8::EpiF32, pg8::StaticOrder, true, true>(lds, g, S, E); }
        xcd_barrier(bar);
        phase_e<1>(p, lds, layer < 3 ? layer + 1 : -1, layer);
        if (layer < 3) xcd_barrier(bar);
    }
}

extern "C" void kernel_launch(void* const* d_in, const int* in_sizes, int n_in, void* d_out, int out_size, void* d_ws, size_t ws_size, hipStream_t stream) {
    static int grid_blocks = 0;
    if (grid_blocks == 0) {
        if (n_in != 19 || ws_size < WS_END) { fprintf(stderr, "kernel_launch: unexpected inputs (n_in %d, ws %zu)\n", n_in, ws_size); grid_blocks = -1; return; }
        int dev = 0, cus = 0, per_cu = 0;
        hipGetDevice(&dev); hipDeviceGetAttribute(&cus, hipDeviceAttributeMultiprocessorCount, dev);
        if (hipFuncSetAttribute((const void*)fwd_megakernel, hipFuncAttributeMaxDynamicSharedMemorySize, LDS_BYTES) != hipSuccess) { fprintf(stderr, "kernel_launch: hipFuncSetAttribute failed\n"); grid_blocks = -1; return; }
        if (hipOccupancyMaxActiveBlocksPerMultiprocessor(&per_cu, (const void*)fwd_megakernel, 512, LDS_BYTES) != hipSuccess || per_cu < 1) { fprintf(stderr, "kernel_launch: occupancy query failed (%d)\n", per_cu); (void)hipGetLastError(); grid_blocks = -1; return; }
        grid_blocks = cus * (per_cu > 1 ? 1 : per_cu);
    }
    if (grid_blocks < 0) return;
    if (hipMemsetAsync(d_ws, 0, 65536, stream) != hipSuccess) { fprintf(stderr, "kernel_launch: memset failed\n"); return; }
    Params p{};
    const float** f = (const float**)&p;
    for (int i = 0; i < 19; ++i) f[i] = (const float*)d_in[i];
    p.out = (float*)d_out; p.ws = (unsigned char*)d_ws;
    void* args[] = {&p};
    hipError_t e = hipLaunchCooperativeKernel((const void*)fwd_megakernel, dim3(grid_blocks), dim3(512), args, LDS_BYTES, stream);
    if (e != hipSuccess) fprintf(stderr, "cooperative launch failed: %s (grid %d)\n", hipGetErrorString(e), grid_blocks);
}
```

```cpp
#include <hip/hip_runtime.h>
#include <hip/hip_cooperative_groups.h>
#include <cstdio>
#include <cstdint>
namespace cg = cooperative_groups;
__device__ __forceinline__ int opaque_tid() { int t = threadIdx.x; asm volatile("" : "+v"(t)); return t; }
__device__ __forceinline__ int opaque_bid() { int t = blockIdx.x; asm volatile("" : "+s"(t)); return t; }
__device__ __forceinline__ int opaque_grid() { int t = gridDim.x; asm volatile("" : "+s"(t)); return t; }
namespace pg8 {
#define PG8_LAS __attribute__((address_space(3)))
typedef unsigned short bf16_t;
typedef short bf16x8 __attribute__((ext_vector_type(8)));
typedef float f32x4 __attribute__((ext_vector_type(4)));
typedef unsigned u32x4 __attribute__((ext_vector_type(4)));
constexpr int BM = 256, BK = 64, HALF = 128, HTB = HALF * BK * 2  , STAGE_BYTES = 8 * HTB, NXCD = 8, WGM = 8;

__host__ __device__ __forceinline__ int lds_byte(int r, int c) { const int st = (r >> 4) * 2 + (c >> 5), rr = r & 15, cc = c & 31, ob = rr * 64 + cc * 2; return st * 1024 + (ob ^ (((ob >> 9) & 1) << 5)); }
__host__ __device__ __forceinline__ void stage_rc(int b, int& R, int& C) { const int st = b / 1024, sb = b % 1024, swz = sb ^ (((sb >> 9) & 1) << 5); R = (st >> 1) * 16 + swz / 64; C = (st & 1) * 32 + (swz % 64) / 2; }
__host__ __device__ __forceinline__ int perm32(int rho) { const int n = rho >> 4, i = rho & 15; return 8 * (i >> 2) + 4 * n + (i & 3); }

struct Unit { int pm, pn; };
struct Gemm { const bf16_t* A; const bf16_t* Bt; int M, N, K; };

struct StaticOrder {
    int nM, nN, nwg, G, c;
    __host__ __device__ void init(int M, int N, int G_, int c_) { nM = M / BM; nN = N / BM; nwg = nM * nN; G = G_; c = c_; }
    __host__ __device__ bool next(int i, Unit& u) const {
        const long L = (long)i * G + c; if (L >= nwg) return false;
        int wgid = (int)L; { const int q = nwg / NXCD, r = nwg % NXCD, xcd = wgid % NXCD, off = wgid / NXCD; wgid = (xcd < r ? xcd * (q + 1) : r * (q + 1) + (xcd - r) * q) + off; }
        const int nig = WGM * nN, gid = wgid / nig, fm = gid * WGM, gsz = (nM - fm) < WGM ? (nM - fm) : WGM;
        u.pm = fm + ((wgid % nig) % gsz); u.pn = (wgid % nig) / gsz; return true;
    }
    __device__ __forceinline__ void a_ready(const Unit&) const {}
    __device__ __forceinline__ void done(const Unit&) const {}
};

__device__ __forceinline__ unsigned cvt_pk_bf16(float lo, float hi) { unsigned r; asm volatile("v_cvt_pk_bf16_f32 %0, %1, %2" : "=v"(r) : "v"(lo), "v"(hi)); return r; }
typedef float f32x2 __attribute__((ext_vector_type(2)));
typedef __bf16 bf16x2_t __attribute__((ext_vector_type(2)));
__device__ __forceinline__ unsigned pk2(float lo, float hi) { f32x2 v = {lo, hi}; bf16x2_t b = __builtin_convertvector(v, bf16x2_t); return __builtin_bit_cast(unsigned, b); }
struct EpiP {
    static constexpr bool PERM = true, AFTER_DRAIN = false;
    bf16_t* P; bf16_t* PL; float qscale; int qcols;
    __device__ __forceinline__ void operator()(const f32x4 (&acc)[2][2][4][2], const Unit& u, int wr, int wc, int fr, int fq) const {
        const int row0 = u.pm * BM + wr * 64 + fr; const int colt = u.pn * BM;
        bf16_t* base; int ldc, c0;
        if (colt < 4096) { base = P; ldc = 4096; c0 = colt; } else { base = PL; ldc = 256; c0 = colt - 4096; }
        const float sc = (colt < qcols) ? qscale : 1.f;
        const int col0 = c0 + wc * 32 + 8 * fq;
#pragma unroll
        for (int ai = 0; ai < 2; ++ai)
#pragma unroll
            for (int m = 0; m < 4; ++m) { bf16_t* rowp = base + (size_t)(row0 + ai * HALF + m * 16) * ldc + col0;
#pragma unroll
                for (int bj = 0; bj < 2; ++bj) { const f32x4 v0 = acc[ai][bj][m][0] * sc, v1 = acc[ai][bj][m][1] * sc;
                    u32x4 w; w.x = pk2(v0[0], v0[1]); w.y = pk2(v0[2], v0[3]); w.z = pk2(v1[0], v1[1]); w.w = pk2(v1[2], v1[3]);
                    *(u32x4*)(rowp + bj * HALF) = w; } }
    }
};
struct EpiM {
    static constexpr bool PERM = true, AFTER_DRAIN = false;
    bf16_t* O;
    __device__ __forceinline__ void operator()(const f32x4 (&acc)[2][2][4][2], const Unit& u, int wr, int wc, int fr, int fq) const {
        const int row0 = u.pm * BM + wr * 64 + fr; const int col0 = u.pn * BM + wc * 32 + 8 * fq;
#pragma unroll
        for (int ai = 0; ai < 2; ++ai)
#pragma unroll
            for (int m = 0; m < 4; ++m) { bf16_t* rowp = O + (size_t)(row0 + ai * HALF + m * 16) * 1024 + col0;
#pragma unroll
                for (int bj = 0; bj < 2; ++bj) { const f32x4 v0 = acc[ai][bj][m][0], v1 = acc[ai][bj][m][1];
                    u32x4 w; w.x = pk2(v0[0], v0[1]); w.y = pk2(v0[2], v0[3]); w.z = pk2(v1[0], v1[1]); w.w = pk2(v1[2], v1[3]);
                    *(u32x4*)(rowp + bj * HALF) = w; } }
    }
};

template <int CTRL> __device__ __forceinline__ float dppz_(float v) { return __int_as_float(__builtin_amdgcn_update_dpp(0, __float_as_int(v), CTRL, 0xF, 0xF, true)); }
typedef _Float16 f16x2_t __attribute__((ext_vector_type(2)));
__device__ __forceinline__ unsigned pkh2(float lo, float hi) { f16x2_t v = {(_Float16)lo, (_Float16)hi}; return __builtin_bit_cast(unsigned, v); }
struct EpiLora {
    static constexpr bool PERM = true, AFTER_DRAIN = false;
    bf16_t* LD; bf16_t* AA;
    __device__ __forceinline__ void operator()(const f32x4 (&acc)[2][2][4][2], const Unit& u, int wr, int wc, int fr, int fq) const {
        const int row0 = u.pm * BM + wr * 64 + fr; const int colt = u.pn * BM; const int t = colt >> 10;
        const int cbase = (colt & 1023) + wc * 32 + 8 * fq;
        bf16_t* base = t ? AA : LD; const float sc = t ? 1.f : -0.6065306597126334f * 1.4426950408889634f;
#pragma unroll
        for (int ai = 0; ai < 2; ++ai)
#pragma unroll
            for (int m = 0; m < 4; ++m) { bf16_t* rowp = base + (size_t)(row0 + ai * HALF + m * 16) * 1024 + cbase;
#pragma unroll
                for (int bj = 0; bj < 2; ++bj) { f32x4 v0 = acc[ai][bj][m][0], v1 = acc[ai][bj][m][1];
#pragma unroll
                    for (int e = 0; e < 4; ++e) { v0[e] = sc * __builtin_amdgcn_rcpf(1.f + __builtin_amdgcn_exp2f(-1.4426950408889634f * v0[e])); v1[e] = sc * __builtin_amdgcn_rcpf(1.f + __builtin_amdgcn_exp2f(-1.4426950408889634f * v1[e])); }
                    u32x4 w;
                    if (t == 0) {
#pragma unroll
                        for (int e = 0; e < 4; ++e) { float x = v0[e], y = v1[e];
                            x += dppz_<0x111>(x); y += dppz_<0x111>(y); x += dppz_<0x112>(x); y += dppz_<0x112>(y); x += dppz_<0x114>(x); y += dppz_<0x114>(y); x += dppz_<0x118>(x); y += dppz_<0x118>(y);
                            v0[e] = x; v1[e] = y; }
                        w.x = pkh2(v0[0], v0[1]); w.y = pkh2(v0[2], v0[3]); w.z = pkh2(v1[0], v1[1]); w.w = pkh2(v1[2], v1[3]);
                    } else { w.x = pk2(v0[0], v0[1]); w.y = pk2(v0[2], v0[3]); w.z = pk2(v1[0], v1[1]); w.w = pk2(v1[2], v1[3]); }
                    *(u32x4*)(rowp + bj * HALF) = w; __builtin_amdgcn_sched_barrier(0); } }
    }
};
template <class Epi, class Sched, bool ALIGN_EPI = false, bool SP2 = false>
__device__ __forceinline__ void gemm_phase(PG8_LAS unsigned char* lds, const Gemm g, const Sched& S, const Epi& E) {
    const int tid = opaque_tid(), wid = __builtin_amdgcn_readfirstlane(tid >> 6), lane = tid & 63, wr = wid >> 2, wc = wid & 3, fr = lane & 15, fq = lane >> 4;
    const int K = g.K, nt = K / BK;
    unsigned voffA[2], voffB[2];
#pragma unroll
    for (int i = 0; i < 2; ++i) { int R, C; stage_rc(tid * 16 + i * 8192, R, C); const int Rb = Epi::PERM ? ((R & ~31) + perm32(R & 31)) : R;
        voffA[i] = (unsigned)(R * K + C) * 2u; voffB[i] = (unsigned)(Rb * K + C) * 2u; }
    const size_t kstep = (size_t)(BK * 2);
    const size_t hstep = (size_t)HALF * K * 2;
    const size_t tstep = 2 * hstep;
    const unsigned ldsw = (unsigned)wid * 1024u;
    const int aoff = lds_byte(wr * 64 + fr, fq * 8), boff = lds_byte(wc * 32 + fr, fq * 8);
#define PG8_SA(b, h) (((b) * 2 + (h)) * HTB)
#define PG8_SB(b, h) ((4 + (b) * 2 + (h)) * HTB)
#define PG8_STAGE(bufoff, gbase, voff) do { _Pragma("unroll") for (int _i = 0; _i < 2; ++_i) \
        __builtin_amdgcn_global_load_lds((const unsigned*)((const char*)(gbase) + (voff)[_i]), (PG8_LAS unsigned*)(lds + (bufoff) + ldsw + _i * 8192), 16, 0, 0); } while (0)
#define PG8_LDA(dst, b, h) do { _Pragma("unroll") for (int m = 0; m < 4; ++m) _Pragma("unroll") for (int k = 0; k < 2; ++k) dst[m][k] = *(const PG8_LAS bf16x8*)(lds + PG8_SA(b, h) + aoff + m * 2048 + k * 1024); } while (0)
#define PG8_LDB(dst, b, h) do { _Pragma("unroll") for (int n = 0; n < 2; ++n) _Pragma("unroll") for (int k = 0; k < 2; ++k) dst[n][k] = *(const PG8_LAS bf16x8*)(lds + PG8_SB(b, h) + boff + n * 2048 + k * 1024); } while (0)
#define PG8_MMA(ai, bj, At, Bt) do { __builtin_amdgcn_s_setprio(1); _Pragma("unroll") for (int m = 0; m < 4; ++m) _Pragma("unroll") for (int n = 0; n < 2; ++n) _Pragma("unroll") for (int k = 0; k < 2; ++k) \
        acc[ai][bj][m][n] = __builtin_amdgcn_mfma_f32_16x16x32_bf16(Bt[n][k], At[m][k], acc[ai][bj][m][n], 0, 0, 0); __builtin_amdgcn_s_setprio(0); } while (0)
#define PG8_WAIT_V(n) asm volatile("s_waitcnt vmcnt(" #n ")" ::: "memory")
#define PG8_WAIT_L(n) asm volatile("s_waitcnt lgkmcnt(" #n ")" ::: "memory")
#define PG8_BAR __builtin_amdgcn_s_barrier()
#define PG8_SCHED __builtin_amdgcn_sched_barrier(0)
    Unit cur, nxt; int ui = 0;
    if (!S.next(0, cur)) return;
    f32x4 acc[2][2][4][2];
#pragma unroll
    for (int a = 0; a < 2; ++a)
#pragma unroll
        for (int b = 0; b < 2; ++b)
#pragma unroll
            for (int m = 0; m < 4; ++m)
#pragma unroll
                for (int n = 0; n < 2; ++n) acc[a][b][m][n] = (f32x4){0.f, 0.f, 0.f, 0.f};
    bf16x8 At[4][2], B0[2][2], B1[2][2];
    const char* cA = (const char*)g.A + (size_t)cur.pm * tstep; const char* cB = (const char*)g.Bt + (size_t)cur.pn * tstep;
    S.a_ready(cur);
    if constexpr (SP2) {
        PG8_STAGE(PG8_SB(0, 0), cB, voffB); PG8_STAGE(PG8_SB(0, 1), cB + hstep, voffB); PG8_STAGE(PG8_SA(0, 0), cA, voffA); PG8_STAGE(PG8_SA(0, 1), cA + hstep, voffA);
        if (wr == 1) PG8_BAR;
        PG8_WAIT_V(2); PG8_BAR;
        PG8_STAGE(PG8_SB(1, 0), cB + kstep, voffB); PG8_STAGE(PG8_SA(1, 0), cA + kstep, voffA); PG8_STAGE(PG8_SB(1, 1), cB + hstep + kstep, voffB);
        PG8_WAIT_V(6); PG8_BAR;
    } else {
        PG8_STAGE(PG8_SB(0, 0), cB, voffB); PG8_STAGE(PG8_SA(0, 0), cA, voffA); PG8_STAGE(PG8_SB(0, 1), cB + hstep, voffB); PG8_STAGE(PG8_SA(0, 1), cA + hstep, voffA);
        if (wr == 1) PG8_BAR;
        PG8_WAIT_V(4); PG8_BAR;
        PG8_STAGE(PG8_SB(1, 0), cB + kstep, voffB); PG8_STAGE(PG8_SA(1, 0), cA + kstep, voffA); PG8_STAGE(PG8_SB(1, 1), cB + hstep + kstep, voffB);
        PG8_WAIT_V(6); PG8_BAR;
    }
    for (;;) {
        const bool has_next = S.next(ui + 1, nxt);
        const char* nA = has_next ? (const char*)g.A + (size_t)nxt.pm * tstep : cA; const char* nB = has_next ? (const char*)g.Bt + (size_t)nxt.pn * tstep : cB;
        for (int t = 0; t < nt; t += 2) {
            const bool last = (t == nt - 2);
            const char* a1 = cA + (size_t)(t + 1) * kstep;
            const char* a2 = last ? nA : cA + (size_t)(t + 2) * kstep; const char* b2 = last ? nB : cB + (size_t)(t + 2) * kstep;
            const char* a3 = a2 + kstep; const char* b3 = b2 + kstep;
            if (last && has_next) S.a_ready(nxt);
            if constexpr (SP2) {
            PG8_LDB(B0, 0, 0); PG8_LDB(B1, 0, 1); PG8_SCHED; PG8_LDA(At, 0, 0); PG8_STAGE(PG8_SA(1, 1), a1 + hstep, voffA);
            PG8_WAIT_V(8); PG8_WAIT_L(0); PG8_BAR; PG8_MMA(0, 0, At, B0); PG8_MMA(0, 1, At, B1); PG8_BAR; PG8_SCHED;
            PG8_LDA(At, 0, 1); PG8_STAGE(PG8_SB(0, 0), b2, voffB); PG8_STAGE(PG8_SB(0, 1), b2 + hstep, voffB); PG8_STAGE(PG8_SA(0, 0), a2, voffA);
            PG8_WAIT_V(8); PG8_WAIT_L(0); PG8_BAR; PG8_MMA(1, 0, At, B0); PG8_MMA(1, 1, At, B1); PG8_BAR; PG8_SCHED;
            PG8_LDB(B0, 1, 0); PG8_LDB(B1, 1, 1); PG8_SCHED; PG8_LDA(At, 1, 0); PG8_STAGE(PG8_SA(0, 1), a2 + hstep, voffA);
            PG8_WAIT_V(8); PG8_WAIT_L(0); PG8_BAR; PG8_MMA(0, 0, At, B0); PG8_MMA(0, 1, At, B1); PG8_BAR; PG8_SCHED;
            PG8_LDA(At, 1, 1); PG8_STAGE(PG8_SB(1, 0), b3, voffB); PG8_STAGE(PG8_SB(1, 1), b3 + hstep, voffB); PG8_STAGE(PG8_SA(1, 0), a3, voffA);
            PG8_WAIT_V(8); PG8_WAIT_L(0); PG8_BAR; PG8_MMA(1, 0, At, B0); PG8_MMA(1, 1, At, B1); PG8_BAR; PG8_SCHED;
            } else {
            PG8_LDB(B0, 0, 0); PG8_SCHED; PG8_LDA(At, 0, 0); PG8_STAGE(PG8_SA(1, 1), a1 + hstep, voffA);
            PG8_WAIT_L(8); PG8_BAR; PG8_WAIT_L(0); PG8_MMA(0, 0, At, B0); PG8_BAR; PG8_SCHED;
            PG8_LDB(B1, 0, 1); PG8_STAGE(PG8_SB(0, 0), b2, voffB);
            PG8_BAR; PG8_WAIT_L(0); PG8_MMA(0, 1, At, B1); PG8_BAR;
            PG8_LDA(At, 0, 1); PG8_STAGE(PG8_SA(0, 0), a2, voffA);
            PG8_BAR; PG8_WAIT_L(0); PG8_MMA(1, 0, At, B0); PG8_BAR; PG8_SCHED;
            PG8_STAGE(PG8_SB(0, 1), b2 + hstep, voffB);
            PG8_WAIT_V(6); PG8_BAR; PG8_MMA(1, 1, At, B1); PG8_BAR;
            PG8_LDB(B0, 1, 0); PG8_SCHED; PG8_LDA(At, 1, 0); PG8_STAGE(PG8_SA(0, 1), a2 + hstep, voffA);
            PG8_WAIT_L(8); PG8_BAR; PG8_WAIT_L(0); PG8_MMA(0, 0, At, B0); PG8_BAR; PG8_SCHED;
            PG8_LDB(B1, 1, 1); PG8_STAGE(PG8_SB(1, 0), b3, voffB);
            PG8_BAR; PG8_WAIT_L(0); PG8_MMA(0, 1, At, B1); PG8_BAR;
            PG8_LDA(At, 1, 1); PG8_STAGE(PG8_SA(1, 0), a3, voffA);
            PG8_BAR; PG8_WAIT_L(0); PG8_MMA(1, 0, At, B0); PG8_BAR; PG8_SCHED;
            PG8_STAGE(PG8_SB(1, 1), b3 + hstep, voffB);
            PG8_WAIT_V(6); PG8_BAR; PG8_MMA(1, 1, At, B1); PG8_BAR;
            }
        }
        if constexpr (ALIGN_EPI) { if (wr == 0) PG8_BAR; }
        if constexpr (!Epi::AFTER_DRAIN) { E(acc, cur, wr, wc, fr, fq); S.done(cur); }
        if (!has_next) break;
#pragma unroll
        for (int a = 0; a < 2; ++a)
#pragma unroll
            for (int b = 0; b < 2; ++b)
#pragma unroll
                for (int m = 0; m < 4; ++m)
#pragma unroll
                    for (int n = 0; n < 2; ++n) acc[a][b][m][n] = (f32x4){0.f, 0.f, 0.f, 0.f};
        cur = nxt; cA = nA; cB = nB; ++ui;
        if constexpr (ALIGN_EPI) { if (wr == 1) PG8_BAR; }
    }
    PG8_WAIT_V(0);
    if constexpr (!ALIGN_EPI) { if (wr == 0) PG8_BAR; }
    PG8_BAR;
    if constexpr (Epi::AFTER_DRAIN) { E.fused(acc, cur, wr, wc, fr, fq, lds, wid, lane); S.done(cur); }
#undef PG8_SA
#undef PG8_SB
#undef PG8_STAGE
#undef PG8_LDA
#undef PG8_LDB
#undef PG8_MMA
#undef PG8_WAIT_V
#undef PG8_WAIT_L
#undef PG8_BAR
#undef PG8_SCHED
}
}
#define LAS __attribute__((address_space(3)))
#define BID opaque_bid()
#define GRD opaque_grid()
typedef unsigned short bf16_t;
typedef short bf16x8 __attribute__((ext_vector_type(8)));
typedef short s16x4 __attribute__((ext_vector_type(4)));
typedef float f32x4 __attribute__((ext_vector_type(4)));
typedef float f32x2 __attribute__((ext_vector_type(2)));
typedef float f32x16 __attribute__((ext_vector_type(16)));
typedef unsigned u32x4 __attribute__((ext_vector_type(4)));
typedef unsigned u32x2 __attribute__((ext_vector_type(2)));

constexpr int NB = 8, SEQ = 2048, NMETA = 16, LSEQ = SEQ + NMETA  , LP = 2112  , DM = 1024;
constexpr int MROWS = NB * LP;
constexpr int FOX_IN = 4112, RWKV_IN = 4224;
constexpr float NORM_EPS = 1e-6f, GN_EPS = 64e-5f, LOG2E = 1.4426950408889634f;
constexpr float DECAY_SCALE = 0.6065306597126334f;
constexpr int LDS_BYTES = 147456;
constexpr size_t MiB = 1u << 20;
constexpr size_t WS_WIN = 1 * MiB;
constexpr size_t WS_WOUT = 10 * MiB;
constexpr size_t WS_HMETA = 12 * MiB;
constexpr size_t WS_CUM = 13 * MiB;
constexpr size_t WS_PL = 15 * MiB;
constexpr size_t WS_B = 24 * MiB;
constexpr size_t WS_C = 57 * MiB;
constexpr size_t WS_LD = 189 * MiB;
constexpr size_t WS_AA = 222 * MiB;
constexpr size_t WS_END = 255 * MiB;
static_assert(WS_B + (size_t)MROWS * 1024 * 2 <= WS_C && WS_C + (size_t)MROWS * 4096 * 2 <= WS_LD && WS_LD + (size_t)MROWS * 2048 <= WS_AA && WS_AA + (size_t)MROWS * 2048 <= WS_END, "ws map");
static_assert(WS_PL + (size_t)MROWS * 512 <= WS_B && WS_CUM + (size_t)MROWS * 64 <= WS_PL, "ws map 2");

struct Params {
    const float *x, *meta, *norm_pre, *norm_post, *fox_w_in, *fox_b_f, *fox_w_out, *rwkv_w_in, *rwkv_mu, *rwkv_w0, *rwkv_w_up, *rwkv_a0, *rwkv_a_up,
        *rwkv_k_k, *rwkv_k_a, *rwkv_r_k, *rwkv_ln_w, *rwkv_ln_b, *rwkv_w_out;
    float* out; unsigned char* ws;
};

__device__ __forceinline__ float wave_sum(float v) {
#pragma unroll
    for (int o = 1; o < 64; o <<= 1) v += __shfl_xor(v, o);
    return v;
}
__device__ __forceinline__ unsigned pk2(float lo, float hi) { return pg8::pk2(lo, hi); }
__device__ __forceinline__ float bflo(unsigned w) { return __uint_as_float(w << 16); }
__device__ __forceinline__ float bfhi(unsigned w) { return __uint_as_float(w & 0xffff0000u); }
template <int CTRL> __device__ __forceinline__ float dppf(float v) { return __int_as_float(__builtin_amdgcn_update_dpp(0, __float_as_int(v), CTRL, 0xF, 0xF, true)); }
__device__ __forceinline__ float red16(float v) {
    v += dppf<0xB1>(v); v += dppf<0x4E>(v); v += dppf<0x141>(v); v += dppf<0x140>(v); return v;
}
__device__ __forceinline__ float xhalf_max(float m) { auto rr = __builtin_amdgcn_permlane32_swap(__float_as_uint(m), __float_as_uint(m), false, false); return __builtin_fmaxf(__uint_as_float(rr[0]), __uint_as_float(rr[1])); }
__device__ __forceinline__ float xhalf_sum(float m) { auto rr = __builtin_amdgcn_permlane32_swap(__float_as_uint(m), __float_as_uint(m), false, false); return __uint_as_float(rr[0]) + __uint_as_float(rr[1]); }
__device__ __forceinline__ float sigmoidf_(float x) { return 1.f / (1.f + __expf(-x)); }
#define LDS_WAIT() asm volatile("s_waitcnt lgkmcnt(0)" ::: "memory")

__device__ __forceinline__ void transpose_item(const float* W, int ldw, bf16_t* WT, LAS float* scr, int kb, int nb, int lane) {
    const int k0 = 64 * kb, n0 = 32 * nb;
#pragma unroll 8
    for (int i = 0; i < 32; ++i) { const int kk = 2 * i + (lane >> 5); scr[kk * 33 + (lane & 31)] = W[(size_t)(k0 + kk) * ldw + n0 + (lane & 31)]; }
    LDS_WAIT();
    const int c = lane & 7;
#pragma unroll
    for (int j = 0; j < 4; ++j) { const int n = (lane >> 3) + 8 * j; const LAS float* s = scr + (8 * c) * 33 + n;
        u32x4 o; o.x = pk2(s[0 * 33], s[1 * 33]); o.y = pk2(s[2 * 33], s[3 * 33]); o.z = pk2(s[4 * 33], s[5 * 33]); o.w = pk2(s[6 * 33], s[7 * 33]);
        *(u32x4*)(WT + (size_t)(n0 + n) * 1024 + k0 + 8 * c) = o; }
    LDS_WAIT();
}

template <int MODE>
__device__ __forceinline__ void phase_e(const Params& p, LAS unsigned char* lds, int next, int prev) {
    const int tid = opaque_tid(), lane = tid & 63, wave = __builtin_amdgcn_readfirstlane(tid >> 6);
    const int G = GRD, gw = BID * 8 + wave, NGW = G * 8;
    bf16_t* U = (bf16_t*)(p.ws + WS_B);
    float* CUM = (float*)(p.ws + WS_CUM);
    float* HMETA = (float*)(p.ws + WS_HMETA);
    const bf16_t* MB = (const bf16_t*)(p.ws + WS_C);
    const bool next_fox = (next >= 0) && ((next & 1) == 0);
    LAS float* WfT = (LAS float*)lds;
    LAS float* scr = (LAS float*)(lds + 65536 + wave * 8448);
    if (next >= 0) {
        const int jn = next >> 1;
        bf16_t* WIN = (bf16_t*)(p.ws + WS_WIN); bf16_t* WOUT = (bf16_t*)(p.ws + WS_WOUT);
        if (next_fox) {
            const float* Wf = p.fox_w_in + (size_t)jn * 1024 * FOX_IN + 4096;
            for (int i = tid; i < 4096; i += 512) { const int k = i >> 2, q = i & 3; const f32x4 v = *(const f32x4*)(Wf + (size_t)k * FOX_IN + 4 * q);
                WfT[(4 * q + 0) * 1024 + k] = v[0]; WfT[(4 * q + 1) * 1024 + k] = v[1]; WfT[(4 * q + 2) * 1024 + k] = v[2]; WfT[(4 * q + 3) * 1024 + k] = v[3]; }
            const float* W = p.fox_w_in + (size_t)jn * 1024 * FOX_IN; const float* Wo = p.fox_w_out + (size_t)jn * 1024 * 1024;
            for (int it = gw; it < 16 * 128 + 16 * 32; it += NGW) {
                if (it < 16 * 128) transpose_item(W, FOX_IN, WIN, scr, it / 128, it % 128, lane);
                else { const int r = it - 16 * 128; transpose_item(Wo, 1024, WOUT, scr, r / 32, r % 32, lane); }
            }
        } else {
            const float* W = p.rwkv_w_in + (size_t)jn * 1024 * RWKV_IN; const float* Wo = p.rwkv_w_out + (size_t)jn * 1024 * 1024;
            for (int it = gw; it < 16 * 132 + 16 * 32; it += NGW) {
                if (it < 16 * 132) transpose_item(W, RWKV_IN, WIN, scr, it / 132, it % 132, lane);
                else { const int r = it - 16 * 132; transpose_item(Wo, 1024, WOUT, scr, r / 32, r % 32, lane); }
            }
            {   u32x4 z4 = (u32x4){0u, 0u, 0u, 0u}; asm volatile("" : "+v"(z4));
                for (int i = BID * 512 + tid; i < 16384; i += G * 512) *(u32x4*)(WIN + (size_t)4224 * 1024 + (size_t)i * 8) = z4; }
        }
    }
    __syncthreads();
    f32x4 gpo[4], gpr[4];
#pragma unroll
    for (int j = 0; j < 4; ++j) {
        gpo[j] = (MODE == 1) ? *((const f32x4*)(p.norm_post + (size_t)prev * 1024) + lane + 64 * j) : (f32x4){0.f, 0.f, 0.f, 0.f};
        gpr[j] = (next >= 0) ? *((const f32x4*)(p.norm_pre + (size_t)next * 1024) + lane + 64 * j) : (f32x4){0.f, 0.f, 0.f, 0.f};
    }
    const float bfv = (next_fox && lane < 16) ? p.fox_b_f[(next >> 1) * 16 + lane] : 0.f;
    f32x4 nv[4]; u32x2 nmw[4];
#define PE_ISSUE(mm) do { const int m_ = (mm); if (m_ < MROWS) { const int b_ = m_ / LP, t_ = m_ - b_ * LP; if (t_ < LSEQ) { \
        if (MODE == 0) { const float* src_ = (t_ < NMETA) ? p.meta + (size_t)t_ * 1024 : p.x + ((size_t)b_ * SEQ + (t_ - NMETA)) * 1024; \
            _Pragma("unroll") for (int j_ = 0; j_ < 4; ++j_) nv[j_] = *((const f32x4*)src_ + lane + 64 * j_); } \
        else { const float* hr_ = (prev == 0) ? ((t_ < NMETA) ? p.meta + (size_t)t_ * 1024 : p.x + ((size_t)b_ * SEQ + (t_ - NMETA)) * 1024)        \
                                       : ((t_ < NMETA) ? HMETA + (size_t)(b_ * NMETA + t_) * 1024 : p.out + ((size_t)b_ * SEQ + (t_ - NMETA)) * 1024); \
            _Pragma("unroll") for (int j_ = 0; j_ < 4; ++j_) { nv[j_] = *((const f32x4*)hr_ + lane + 64 * j_); nmw[j_] = *((const u32x2*)(MB + (size_t)m_ * 1024) + lane + 64 * j_); } } } } } while (0)
#pragma unroll
    for (int j = 0; j < 4; ++j) { nv[j] = (f32x4){0.f, 0.f, 0.f, 0.f}; nmw[j] = (u32x2){0u, 0u}; }
    PE_ISSUE(gw);
    for (int m = gw; m < MROWS; m += NGW) {
        const int b = m / LP, t = m - b * LP;
        f32x4 v[4]; u32x2 mw4[4];
#pragma unroll
        for (int j = 0; j < 4; ++j) { v[j] = nv[j]; mw4[j] = nmw[j]; }
        PE_ISSUE(m + NGW);
        if (t >= LSEQ) {
            if (next >= 0) { u32x2* o8 = (u32x2*)(U + (size_t)m * 1024) + lane;
#pragma unroll
                for (int j = 0; j < 4; ++j) o8[64 * j] = (u32x2){0u, 0u};
                if (next_fox && lane < 16) CUM[(size_t)m * 16 + lane] = 0.f; }
            continue;
        }
        float* hrow = (t < NMETA) ? HMETA + (size_t)(b * NMETA + t) * 1024 : p.out + ((size_t)b * SEQ + (t - NMETA)) * 1024;
        if (MODE == 1) {
            f32x4 mv[4]; float ss = 0.f;
#pragma unroll
            for (int j = 0; j < 4; ++j) { mv[j] = (f32x4){bflo(mw4[j].x), bfhi(mw4[j].x), bflo(mw4[j].y), bfhi(mw4[j].y)};
                ss += (mv[j][0] * mv[j][0] + mv[j][1] * mv[j][1]) + (mv[j][2] * mv[j][2] + mv[j][3] * mv[j][3]); }
            const float rs = __builtin_amdgcn_rsqf(wave_sum(ss) * (1.f / 1024.f) + NORM_EPS);
#pragma unroll
            for (int j = 0; j < 4; ++j) v[j] = v[j] + mv[j] * rs * gpo[j];
        }
        if (MODE == 1) {
#pragma unroll
            for (int j = 0; j < 4; ++j) *((f32x4*)hrow + lane + 64 * j) = v[j];
        }
        if (next >= 0) {
            float ss = 0.f;
#pragma unroll
            for (int j = 0; j < 4; ++j) ss += (v[j][0] * v[j][0] + v[j][1] * v[j][1]) + (v[j][2] * v[j][2] + v[j][3] * v[j][3]);
            const float rs = __builtin_amdgcn_rsqf(wave_sum(ss) * (1.f / 1024.f) + NORM_EPS);
            u32x2* o8 = (u32x2*)(U + (size_t)m * 1024) + lane;
#pragma unroll
            for (int j = 0; j < 4; ++j) { v[j] = v[j] * rs * gpr[j]; o8[64 * j] = (u32x2){pk2(v[j][0], v[j][1]), pk2(v[j][2], v[j][3])}; }
            if (next_fox) {
                float mine = 0.f;
#pragma unroll
                for (int hd = 0; hd < 16; ++hd) { float s = 0.f;
#pragma unroll
                    for (int j = 0; j < 4; ++j) { const f32x4 w = *((const LAS f32x4*)(WfT + hd * 1024) + lane + 64 * j); s += (v[j][0] * w[0] + v[j][1] * w[1]) + (v[j][2] * w[2] + v[j][3] * w[3]); }
                    s = wave_sum(s); if (lane == hd) mine = s; }
                if (lane < 16) { const float xp = (mine + bfv) * LOG2E; CUM[(size_t)m * 16 + lane] = fminf(xp, 0.f) - __builtin_amdgcn_logf(1.f + __builtin_amdgcn_exp2f(-fabsf(xp))); }
            }
        }
    }
}

#undef PE_ISSUE
__device__ __forceinline__ void phase_cumsum(const Params& p, LAS unsigned char* lds) {
    const int tid = opaque_tid(); LAS float* s = (LAS float*)lds;
    float* CUM = (float*)(p.ws + WS_CUM);
    for (int j = (GRD >= 256) ? BID - 128 : BID; j < 128; j += GRD) {
        if (j < 0) break;
        const int b = j >> 4, hd = j & 15; float* base = CUM + (size_t)b * LP * 16 + hd;
        float v[5]; float tot = 0.f;
#pragma unroll
        for (int e = 0; e < 5; ++e) { const int t = tid * 5 + e; v[e] = (t < LP) ? base[(size_t)t * 16] : 0.f; tot += v[e]; }
        s[tid] = tot; __syncthreads();
        for (int off = 1; off < 512; off <<= 1) { const float a = (tid >= off) ? s[tid - off] : 0.f; __syncthreads(); s[tid] += a; __syncthreads(); }
        float run = s[tid] - tot;
#pragma unroll
        for (int e = 0; e < 5; ++e) { const int t = tid * 5 + e; run += v[e]; if (t < LP) base[(size_t)t * 16] = run; }
        __syncthreads();
    }
}

__device__ __forceinline__ void phase_attn(const Params& p, LAS unsigned char* lds, unsigned* qctr) {
    const int tid = opaque_tid(), lane = tid & 63, wid = __builtin_amdgcn_readfirstlane(tid >> 6), r32 = lane & 31, hi = lane >> 5;
    LAS bf16_t* Ks = (LAS bf16_t*)lds;
    LAS bf16_t* Vs = Ks + 2 * 64 * 72;
    LAS float* cks = (LAS float*)(lds + 2 * 64 * 72 * 2 + 2 * 64 * 96 * 2);
    typedef short v4i16_t __attribute__((ext_vector_type(4)));
    const int vrd = (4 * hi + ((lane & 15) >> 2)) * 96 + 16 * ((lane >> 4) & 1) + 4 * (lane & 3);
    const bf16_t* P = (const bf16_t*)(p.ws + WS_C);
    const float* CUM = (const float*)(p.ws + WS_CUM);
    bf16_t* OG = (bf16_t*)(p.ws + WS_B);
    const int kr = tid >> 3, kc = tid & 7;
    volatile LAS unsigned* uslot = (volatile LAS unsigned*)(lds + LDS_BYTES - 32);
#define AT_BAR() do { asm volatile("s_waitcnt lgkmcnt(0)" ::: "memory"); __builtin_amdgcn_s_barrier(); asm volatile("" ::: "memory"); } while (0)
#define AT_STORE_K(buf, KR, CR) do { *(LAS u32x4*)(Ks + (buf) * 4608 + kr * 72 + kc * 8) = (KR); if (tid < 64) cks[(buf) * 64 + tid] = -(CR); } while (0)
#define AT_STORE_V(buf, VR) do { *(LAS u32x4*)(Vs + (buf) * 6144 + kr * 96 + kc * 8) = (VR); } while (0)
#define AT_QK(t, P0, P1) do { const LAS bf16_t* Kb_ = Ks + ((t) & 1) * 4608; const LAS float* cb_ = cks + ((t) & 1) * 64; \
        _Pragma("unroll") for (int i_ = 0; i_ < 4; ++i_) { const f32x4 c0_ = *(const LAS f32x4*)(cb_ + 8 * i_ + 4 * hi), c1_ = *(const LAS f32x4*)(cb_ + 32 + 8 * i_ + 4 * hi); \
            _Pragma("unroll") for (int e_ = 0; e_ < 4; ++e_) { P0[4 * i_ + e_] = c0_[e_] - m_run; P1[4 * i_ + e_] = c1_[e_] - m_run; } } \
        _Pragma("unroll") for (int d0_ = 0; d0_ < 4; ++d0_) { \
            const bf16x8 a0_ = *(const LAS bf16x8*)(Kb_ + r32 * 72 + d0_ * 16 + hi * 8), a1_ = *(const LAS bf16x8*)(Kb_ + (32 + r32) * 72 + d0_ * 16 + hi * 8); \
            P0 = __builtin_amdgcn_mfma_f32_32x32x16_bf16(a0_, qr[d0_], P0, 0, 0, 0); P1 = __builtin_amdgcn_mfma_f32_32x32x16_bf16(a1_, qr[d0_], P1, 0, 0, 0); } } while (0)
#define AT_PV(c, PX, B) do { u32x4 pw_; pw_.x = pk2(PX[B + 0], PX[B + 1]); pw_.y = pk2(PX[B + 2], PX[B + 3]); pw_.z = pk2(PX[B + 4], PX[B + 5]); pw_.w = pk2(PX[B + 6], PX[B + 7]); \
        const bf16x8 pf_ = __builtin_bit_cast(bf16x8, pw_); \
        {   const s16x4 lo_ = __builtin_bit_cast(s16x4, __builtin_amdgcn_ds_read_tr16_b64_v4i16((LAS v4i16_t*)(Vb_ + (16 * (c)) * 96))), h4_ = __builtin_bit_cast(s16x4, __builtin_amdgcn_ds_read_tr16_b64_v4i16((LAS v4i16_t*)(Vb_ + (16 * (c) + 8) * 96))); \
            const bf16x8 vf_ = (bf16x8){lo_[0], lo_[1], lo_[2], lo_[3], h4_[0], h4_[1], h4_[2], h4_[3]}; \
            o0 = __builtin_amdgcn_mfma_f32_32x32x16_bf16(vf_, pf_, o0, 0, 0, 0); } \
        {   const s16x4 lo_ = __builtin_bit_cast(s16x4, __builtin_amdgcn_ds_read_tr16_b64_v4i16((LAS v4i16_t*)(Vb_ + (16 * (c)) * 96 + 32))), h4_ = __builtin_bit_cast(s16x4, __builtin_amdgcn_ds_read_tr16_b64_v4i16((LAS v4i16_t*)(Vb_ + (16 * (c) + 8) * 96 + 32))); \
            const bf16x8 vf_ = (bf16x8){lo_[0], lo_[1], lo_[2], lo_[3], h4_[0], h4_[1], h4_[2], h4_[3]}; \
            o1 = __builtin_amdgcn_mfma_f32_32x32x16_bf16(vf_, pf_, o1, 0, 0, 0); } } while (0)
#define AT_TOFF(t) ((t) ? (long)(t) * 64 * 4096 : k0off)
#define AT_COFF(t) ((t) ? (long)(t) * 64 * 16 : c0off)
#define AT_STEP(i, PC0, PC1, PN0, PN1) do { const int i_ = (i), t_ = NT - 1 - i_; \
        if (t_ >= 2) { kreg = *(const u32x4*)(kg + AT_TOFF(t_ - 2)); if (tid < 64) creg = cgp[AT_COFF(t_ - 2)]; } \
        if (t_ >= 1) vreg = *(const u32x4*)(vg + AT_TOFF(t_ - 1)); \
        const bool need_next_ = active && (t_ >= 1) && (t_ - 1 <= jmax); \
        if (need_next_) AT_QK(i_ + 1, PN0, PN1); \
        __builtin_amdgcn_sched_barrier(0); \
        if (active && t_ <= jmax) { \
            const LAS bf16_t* Vb_ = Vs + (i_ & 1) * 6144 + vrd; \
            if (64 * t_ + 63 > qw0 || t_ == 0) { const int qpos_ = qw0 + r32; \
                _Pragma("unroll") for (int r = 0; r < 16; ++r) { const int kv_ = 64 * t_ + (r & 3) + 8 * (r >> 2) + 4 * hi; if (kv_ > qpos_ || kv_ < 48) PC0[r] = -INFINITY; if (kv_ + 32 > qpos_ || kv_ + 32 < 48) PC1[r] = -INFINITY; } } \
            float mxa_ = __builtin_fmaxf(__builtin_fmaxf(PC0[0], PC0[1]), PC1[0]), mxb_ = __builtin_fmaxf(__builtin_fmaxf(PC0[2], PC0[3]), PC1[1]); mxa_ = __builtin_fmaxf(__builtin_fmaxf(mxa_, PC1[2]), PC1[3]); \
            _Pragma("unroll") for (int r = 4; r < 16; r += 4) { mxa_ = __builtin_fmaxf(__builtin_fmaxf(mxa_, PC0[r]), PC0[r + 1]); mxb_ = __builtin_fmaxf(__builtin_fmaxf(mxb_, PC0[r + 2]), PC0[r + 3]); \
                mxa_ = __builtin_fmaxf(__builtin_fmaxf(mxa_, PC1[r]), PC1[r + 1]); mxb_ = __builtin_fmaxf(__builtin_fmaxf(mxb_, PC1[r + 2]), PC1[r + 3]); } \
            float mx_ = xhalf_max(__builtin_fmaxf(mxa_, mxb_)); \
              \
              \
            const bool first_ = (t_ == tfirst); \
            if (first_ || __any(mx_ > -30.f)) { \
            if (first_ || __any(mx_ > 8.f)) { const float dl_ = first_ ? ((mx_ > -1e30f) ? mx_ : 0.f) : fmaxf(mx_, 0.f); m_run += dl_; const float alpha_ = __builtin_amdgcn_exp2f(-dl_); l_run *= alpha_; \
                _Pragma("unroll") for (int r = 0; r < 16; ++r) { PC0[r] -= dl_; PC1[r] -= dl_; o0[r] *= alpha_; o1[r] *= alpha_; } \
                if (need_next_) { _Pragma("unroll") for (int r = 0; r < 16; ++r) { PN0[r] -= dl_; PN1[r] -= dl_; } } } \
            float sa_ = 0.f, sb_ = 0.f, sc_ = 0.f, sd_ = 0.f; \
            _Pragma("unroll") for (int r = 0; r < 16; r += 2) { PC0[r] = __builtin_amdgcn_exp2f(PC0[r]); PC1[r] = __builtin_amdgcn_exp2f(PC1[r]); PC0[r + 1] = __builtin_amdgcn_exp2f(PC0[r + 1]); PC1[r + 1] = __builtin_amdgcn_exp2f(PC1[r + 1]); \
                sa_ += PC0[r]; sb_ += PC1[r]; sc_ += PC0[r + 1]; sd_ += PC1[r + 1]; } \
            l_run += (sa_ + sb_) + (sc_ + sd_); \
            AT_PV(0, PC0, 0); AT_PV(1, PC0, 8); AT_PV(2, PC1, 0); AT_PV(3, PC1, 8); } } \
        if (t_ >= 2) AT_STORE_K(i_ & 1, kreg, creg); \
        if (t_ >= 1) AT_STORE_V((i_ + 1) & 1, vreg); \
        AT_BAR(); } while (0)
    for (;;) {
        if (tid == 0) *uslot = __hip_atomic_fetch_add(qctr, 1u, __ATOMIC_RELAXED, __HIP_MEMORY_SCOPE_AGENT);
        __syncthreads();
        const int u = (int)*uslot;
        if (u >= 1152) break;
        const bool metau = u >= 1024;
        const int qb = metau ? 0 : 7 - u / 128, bh = metau ? u - 1024 : u % 128, b = bh >> 4, h = bh & 15;
        const int q0 = metau ? 48 : 64 + qb * 256;
        const int NT = metau ? 1 : 5 + 4 * qb;
        const int qw0 = q0 + 32 * wid;
        const bool active = metau ? (wid == 0) : true;
        const int jmax = (qw0 + 31) >> 6;
        const int tfirst = (jmax < NT - 1) ? jmax : NT - 1;
        const size_t rowb = (size_t)b * LP;
        bf16x8 qr[4];
#pragma unroll
        for (int d0 = 0; d0 < 4; ++d0) qr[d0] = active ? *(const bf16x8*)(P + (rowb + qw0 - 48 + r32) * 4096 + h * 64 + d0 * 16 + hi * 8) : (bf16x8){0, 0, 0, 0, 0, 0, 0, 0};
        const long krow0 = (long)rowb + kr - 48, crow0 = (long)rowb + (tid & 63) - 48;
        const bf16_t* kg = P + krow0 * 4096 + 1024 + h * 64 + kc * 8;
        const bf16_t* vg = kg + 1024;
        const float* cgp = CUM + crow0 * 16 + h;
        const long k0off = (kr < 48) ? (long)(48 - kr) * 4096 : 0, c0off = ((tid & 63) < 48) ? (long)(48 - (tid & 63)) * 16 : 0;
        u32x4 kreg = (u32x4){0u, 0u, 0u, 0u}, vreg = kreg; float creg = 0.f;
        {   const u32x4 k0 = *(const u32x4*)(kg + AT_TOFF(NT - 1)), v0 = *(const u32x4*)(vg + AT_TOFF(NT - 1)); u32x4 k1 = k0; float c0 = 0.f, c1 = 0.f;
            if (NT >= 2) k1 = *(const u32x4*)(kg + AT_TOFF(NT - 2));
            if (tid < 64) { c0 = cgp[AT_COFF(NT - 1)]; if (NT >= 2) c1 = cgp[AT_COFF(NT - 2)]; }
            AT_STORE_K(0, k0, c0); AT_STORE_K(1, k1, c1); AT_STORE_V(0, v0); }
        AT_BAR();
        float m_run = 0.f, l_run = 0.f;
        f32x16 o0, o1, pa0, pa1, pb0, pb1;
#pragma unroll
        for (int r = 0; r < 16; ++r) { o0[r] = 0.f; o1[r] = 0.f; pa0[r] = 0.f; pa1[r] = 0.f; pb0[r] = 0.f; pb1[r] = 0.f; }
        if (active && NT - 1 <= jmax) AT_QK(0, pa0, pa1);
        for (int j = 0; j < NT; j += 2) {
            AT_STEP(j, pa0, pa1, pb0, pb1);
            if (j + 1 < NT) AT_STEP(j + 1, pb0, pb1, pa0, pa1);
        }
        if (active) {
            const float l = xhalf_sum(l_run); const float inv = 1.f / l;
            const size_t row = rowb + qw0 - 48 + r32;
            if (!metau || r32 < 16) {
#pragma unroll
            for (int dh = 0; dh < 2; ++dh)
#pragma unroll
                for (int i = 0; i < 4; ++i) {
                    const int dcol = h * 64 + 32 * dh + 8 * i + 4 * hi;
                    const u32x2 gw_ = *(const u32x2*)(P + row * 4096 + 3072 + dcol);
                    const float g0 = bflo(gw_.x), g1 = bfhi(gw_.x), g2 = bflo(gw_.y), g3 = bfhi(gw_.y);
                    const float a0 = (dh ? o1[4 * i + 0] : o0[4 * i + 0]) * inv, a1 = (dh ? o1[4 * i + 1] : o0[4 * i + 1]) * inv, a2 = (dh ? o1[4 * i + 2] : o0[4 * i + 2]) * inv, a3 = (dh ? o1[4 * i + 3] : o0[4 * i + 3]) * inv;
                    u32x2 w; w.x = pk2(a0 * g0 * sigmoidf_(g0), a1 * g1 * sigmoidf_(g1)); w.y = pk2(a2 * g2 * sigmoidf_(g2), a3 * g3 * sigmoidf_(g3));
                    *(u32x2*)(OG + row * 1024 + dcol) = w;
                }
            }
        }
    }
#undef AT_BAR
#undef AT_STORE_K
#undef AT_STORE_V
#undef AT_QK
#undef AT_PV
#undef AT_STEP
#undef AT_TOFF
#undef AT_COFF
}

__device__ __forceinline__ void phase_lora_prep(const Params& p, int jr) {
    const int tid = opaque_tid(); const int gt = BID * 512 + tid, NTH = GRD * 512;
    const bf16_t* PL = (const bf16_t*)(p.ws + WS_PL);
    bf16_t* A = (bf16_t*)(p.ws + WS_WIN); bf16_t* Bt = (bf16_t*)(p.ws + WS_CUM);
    const float* mu = p.rwkv_mu + (size_t)jr * RWKV_IN + 4096;
    const float* w_up = p.rwkv_w_up + (size_t)jr * 64 * 1024; const float* a_up = p.rwkv_a_up + (size_t)jr * 64 * 1024;
    for (int it = gt; it < MROWS * 32; it += NTH) {
        const int row = it >> 5, cg8 = it & 31;
        u32x4 o = (u32x4){0u, 0u, 0u, 0u};
        if (cg8 < 16) {
            const int tpos = row % LP;
            const u32x4 cw = *(const u32x4*)(PL + (size_t)row * 256 + 8 * cg8);
            u32x4 pw = (u32x4){0u, 0u, 0u, 0u}; if (tpos > 0) pw = *(const u32x4*)(PL + (size_t)(row - 1) * 256 + 8 * cg8);
            const f32x4 m0 = *(const f32x4*)(mu + 8 * cg8), m1 = *(const f32x4*)(mu + 8 * cg8 + 4);
            float v[8];
            v[0] = bflo(cw.x) + (bflo(pw.x) - bflo(cw.x)) * m0[0]; v[1] = bfhi(cw.x) + (bfhi(pw.x) - bfhi(cw.x)) * m0[1];
            v[2] = bflo(cw.y) + (bflo(pw.y) - bflo(cw.y)) * m0[2]; v[3] = bfhi(cw.y) + (bfhi(pw.y) - bfhi(cw.y)) * m0[3];
            v[4] = bflo(cw.z) + (bflo(pw.z) - bflo(cw.z)) * m1[0]; v[5] = bfhi(cw.z) + (bfhi(pw.z) - bfhi(cw.z)) * m1[1];
            v[6] = bflo(cw.w) + (bflo(pw.w) - bflo(cw.w)) * m1[2]; v[7] = bfhi(cw.w) + (bfhi(pw.w) - bfhi(cw.w)) * m1[3];
            if (cg8 < 8) {
#pragma unroll
                for (int e = 0; e < 8; ++e) v[e] = tanhf(v[e]);
            }
            o.x = pk2(v[0], v[1]); o.y = pk2(v[2], v[3]); o.z = pk2(v[4], v[5]); o.w = pk2(v[6], v[7]);
        }
        if (cg8 == 16) o.x = 0x3F803F80u;
        *(u32x4*)(A + (size_t)row * 256 + 8 * cg8) = o;
    }
    for (int it = gt; it < 2048 * 32; it += NTH) {
        const int n = it & 2047, kg = it >> 11;
        u32x4 o = (u32x4){0u, 0u, 0u, 0u};
        const float* src = nullptr;
        if (n < 1024 && kg < 8) src = w_up + (size_t)(8 * kg) * 1024 + n;
        else if (n >= 1024 && kg >= 8 && kg < 16) src = a_up + (size_t)(8 * (kg - 8)) * 1024 + (n - 1024);
        if (src) { o.x = pk2(src[0], src[1024]); o.y = pk2(src[2048], src[3072]); o.z = pk2(src[4096], src[5120]); o.w = pk2(src[6144], src[7168]); }
        if (kg == 16) { const float bz = (n < 1024) ? p.rwkv_w0[jr * 1024 + n] : p.rwkv_a0[jr * 1024 + n - 1024]; const float bh = bfhi(pk2(0.f, bz)); o.x = pk2(bh, bz - bh); }
        *(u32x4*)(Bt + (size_t)n * 256 + 8 * kg) = o;
    }
}

__device__ __forceinline__ void phase_scan(const Params& p, LAS unsigned char* lds, int jr) {
    const int tid = opaque_tid(), lane = tid & 63, wid = __builtin_amdgcn_readfirstlane(tid >> 6);
    LAS float* vec = (LAS float*)lds;
    LAS float* ypart = vec + 2 * 6144;
    const bf16_t* P = (const bf16_t*)(p.ws + WS_C);
    const bf16_t* LD = (const bf16_t*)(p.ws + WS_LD); const bf16_t* AA = (const bf16_t*)(p.ws + WS_AA);
    bf16_t* Y = (bf16_t*)(p.ws + WS_B);
    constexpr int NCH = 129;
    const int ht = tid & 255, ds = ht >> 4, kq = lane & 15, rl = lane >> 4;
    for (int u = BID; u < 256; u += GRD) {
        const int bh = u >> 1, half = u & 1, b = bh >> 4, h = bh & 15;
        const int kcol = h * 64 + 4 * kq;
        const float* mu = p.rwkv_mu + (size_t)jr * RWKV_IN;
        f32x4 mur, muk, muv, kk4, ka4, rk4;
        float* BON = (float*)(p.ws + WS_CUM);
        u32x2 rw, kw, vw, rp, kp_, vp, lw, lwp, aw; size_t drow = 0;
        if (wid >= 4) { mur = *(const f32x4*)(mu + kcol); muk = *(const f32x4*)(mu + 1024 + kcol); muv = *(const f32x4*)(mu + 2048 + kcol);
            kk4 = *(const f32x4*)(p.rwkv_k_k + jr * 1024 + kcol); ka4 = *(const f32x4*)(p.rwkv_k_a + jr * 1024 + kcol); rk4 = *(const f32x4*)(p.rwkv_r_k + jr * 1024 + kcol); }
#define SC_LOADRAW(ch) do { const int t_ = (ch) * 16 + ds; const size_t row_ = (size_t)b * LP + t_; drow = row_; const bf16_t* pr_ = P + row_ * 4096 + kcol; \
        rw = *(const u32x2*)pr_; kw = *(const u32x2*)(pr_ + 1024); vw = *(const u32x2*)(pr_ + 2048); \
        rp = (u32x2){0u, 0u}; kp_ = rp; vp = rp; lwp = rp; \
        if (ds > 0) lwp = *(const u32x2*)(LD + (row_ - 1) * 1024 + kcol); \
        if (t_ > 0) { rp = *(const u32x2*)(pr_ - 4096); kp_ = *(const u32x2*)(pr_ - 4096 + 1024); vp = *(const u32x2*)(pr_ - 4096 + 2048); } \
        lw = *(const u32x2*)(LD + row_ * 1024 + kcol); aw = *(const u32x2*)(AA + row_ * 1024 + kcol); } while (0)
#define SC_DERIVE(buf) do { \
        const f32x4 rc = {bflo(rw.x), bfhi(rw.x), bflo(rw.y), bfhi(rw.y)}, kc_ = {bflo(kw.x), bfhi(kw.x), bflo(kw.y), bfhi(kw.y)}, vc = {bflo(vw.x), bfhi(vw.x), bflo(vw.y), bfhi(vw.y)}; \
        const f32x4 rpv = {bflo(rp.x), bfhi(rp.x), bflo(rp.y), bfhi(rp.y)}, kpv = {bflo(kp_.x), bfhi(kp_.x), bflo(kp_.y), bfhi(kp_.y)}, vpv = {bflo(vp.x), bfhi(vp.x), bflo(vp.y), bfhi(vp.y)}; \
        const unsigned lx_ = lw.x, ly_ = lw.y, qx_ = lwp.x, qy_ = lwp.y;        \
        const pg8::f16x2_t l0_ = __builtin_bit_cast(pg8::f16x2_t, lx_), l1_ = __builtin_bit_cast(pg8::f16x2_t, ly_), q0_ = __builtin_bit_cast(pg8::f16x2_t, qx_), q1_ = __builtin_bit_cast(pg8::f16x2_t, qy_); \
        const f32x4 ldv = {(float)l0_[0], (float)l0_[1], (float)l1_[0], (float)l1_[1]}, ldp = {(float)q0_[0], (float)q0_[1], (float)q1_[0], (float)q1_[1]}, av = {bflo(aw.x), bfhi(aw.x), bflo(aw.y), bfhi(aw.y)}; \
        const f32x4 rlp = rc + (rpv - rc) * mur, klp = kc_ + (kpv - kc_) * muk, vlp = vc + (vpv - vc) * muv; \
        const f32x4 kkv = klp * kk4; \
        float ss = (kkv[0] * kkv[0] + kkv[1] * kkv[1]) + (kkv[2] * kkv[2] + kkv[3] * kkv[3]); \
        ss = red16(ss); \
        const float inv = __builtin_amdgcn_rsqf(fmaxf(ss, 1e-24f));        \
        const f32x4 kkn = kkv * inv; \
        const f32x4 kpr = klp * (1.f + (av - 1.f) * ka4); \
        { const f32x4 bt_ = rlp * kpr * rk4; const float bs_ = red16((bt_[0] + bt_[1]) + (bt_[2] + bt_[3])); if (half == 0 && kq == 0) BON[drow * 16 + h] = bs_; } \
        f32x4 wv, iw, wp; \
        _Pragma("unroll") for (int e_ = 0; e_ < 4; ++e_) { wv[e_] = __builtin_amdgcn_exp2f(ldv[e_]); iw[e_] = __builtin_amdgcn_exp2f(-ldv[e_]); wp[e_] = __builtin_amdgcn_exp2f(ldp[e_]); }     \
        LAS float* vs = vec + (buf) * 6144 + ds * 384 + 4 * kq; \
        *(LAS f32x4*)(vs) = wv; *(LAS f32x4*)(vs + 64) = -kkn * wp; *(LAS f32x4*)(vs + 128) = kkn * av * iw; *(LAS f32x4*)(vs + 192) = kpr * iw; *(LAS f32x4*)(vs + 256) = rlp * wv; *(LAS f32x4*)(vs + 320) = vlp; } while (0)
#define SC_YREDUCE(chunk, buf) do { float pa_ = 0.f, pb_ = 0.f; \
        _Pragma("unroll") for (int j_ = 0; j_ < 8; ++j_) { \
            const f32x4 x_ = *(const LAS f32x4*)(ypart + (buf) * 8192 + j_ * 1024 + (ht & ~15) * 4 + (((ht & 15) + 2 * j_) & 15) * 4); \
            pa_ += x_[0] + x_[2]; pb_ += x_[1] + x_[3]; } \
        { const int s_ = ht >> 4, cw_ = (ht >> 2) & 3, rl_ = ht & 3; \
          *(unsigned*)(Y + ((size_t)b * LP + (chunk) * 16 + s_) * 1024 + h * 64 + 32 * half + 8 * cw_ + 2 * rl_) = pk2(pa_, pb_); } } while (0)
        if (wid >= 4) { SC_LOADRAW(0); SC_DERIVE(0); SC_LOADRAW(1); }
        __syncthreads();
        float SA0 = 0.f, SA1 = 0.f, SA2 = 0.f, SA3 = 0.f, SB0 = 0.f, SB1 = 0.f, SB2 = 0.f, SB3 = 0.f;
        for (int ch = 0; ch < NCH; ++ch) {
            const int buf = ch & 1;
            if (wid < 4) {
                const LAS float* vb = vec + buf * 6144 + 4 * kq;
                const LAS float* vvp = vec + buf * 6144 + 320 + 32 * half + 8 * wid + 2 * rl;
                LAS float* yp = ypart + buf * 8192 + (kq >> 1) * 1024 + ((wid * 4 + rl + 2 * (kq >> 1)) & 15) * 4 + 2 * (kq & 1);
                f32x4 a4 = *(const LAS f32x4*)(vb + 64), b4 = *(const LAS f32x4*)(vb + 128), k4 = *(const LAS f32x4*)(vb + 192), r4 = *(const LAS f32x4*)(vb + 256);
                f32x2 vv = *(const LAS f32x2*)(vvp);
#pragma unroll
                for (int s = 0; s < 16; ++s) {
                    f32x4 na = a4, nb = b4, nk = k4, nr = r4; f32x2 nv = vv;
                    if (s < 15) { na = *(const LAS f32x4*)(vb + (s + 1) * 384 + 64); nb = *(const LAS f32x4*)(vb + (s + 1) * 384 + 128);
                        nk = *(const LAS f32x4*)(vb + (s + 1) * 384 + 192); nr = *(const LAS f32x4*)(vb + (s + 1) * 384 + 256); nv = *(const LAS f32x2*)(vvp + (s + 1) * 384); }
                    float saA, saB, yA, yB;
#define SC_DPP(r, c) "v_add_f32_dpp " r ", " r ", " r " " c " row_mask:0xf bank_mask:0xf bound_ctrl:1\n\t"
                    asm("v_mul_f32 %0, %2, %10\n\tv_mul_f32 %1, %6, %10\n\tv_fmac_f32 %0, %3, %11\n\tv_fmac_f32 %1, %7, %11\n\t"
                        "v_fmac_f32 %0, %4, %12\n\tv_fmac_f32 %1, %8, %12\n\tv_fmac_f32 %0, %5, %13\n\tv_fmac_f32 %1, %9, %13\n\t"
                        "v_fmac_f32 %2, %18, %14\n\tv_fmac_f32 %6, %19, %14\n\t"
                        SC_DPP("%0", "quad_perm:[1,0,3,2]") SC_DPP("%1", "quad_perm:[1,0,3,2]")
                        "v_fmac_f32 %3, %18, %15\n\tv_fmac_f32 %7, %19, %15\n\t"
                        SC_DPP("%0", "quad_perm:[2,3,0,1]") SC_DPP("%1", "quad_perm:[2,3,0,1]")
                        "v_fmac_f32 %4, %18, %16\n\tv_fmac_f32 %8, %19, %16\n\t"
                        SC_DPP("%0", "row_half_mirror") SC_DPP("%1", "row_half_mirror")
                        "v_fmac_f32 %5, %18, %17\n\tv_fmac_f32 %9, %19, %17\n\t"
                        SC_DPP("%0", "row_mirror") SC_DPP("%1", "row_mirror")
                        : "=&v"(saA), "=&v"(saB), "+v"(SA0), "+v"(SA1), "+v"(SA2), "+v"(SA3), "+v"(SB0), "+v"(SB1), "+v"(SB2), "+v"(SB3)
                        : "v"(a4[0]), "v"(a4[1]), "v"(a4[2]), "v"(a4[3]), "v"(k4[0]), "v"(k4[1]), "v"(k4[2]), "v"(k4[3]), "v"(vv[0]), "v"(vv[1]));
                    asm("v_fmac_f32 %0, %10, %12\n\tv_fmac_f32 %4, %11, %12\n\tv_fmac_f32 %1, %10, %13\n\tv_fmac_f32 %5, %11, %13\n\t"
                        "v_fmac_f32 %2, %10, %14\n\tv_fmac_f32 %6, %11, %14\n\tv_fmac_f32 %3, %10, %15\n\tv_fmac_f32 %7, %11, %15\n\t"
                        "v_mul_f32 %8, %0, %16\n\tv_mul_f32 %9, %4, %16\n\tv_fmac_f32 %8, %1, %17\n\tv_fmac_f32 %9, %5, %17\n\t"
                        "v_fmac_f32 %8, %2, %18\n\tv_fmac_f32 %9, %6, %18\n\tv_fmac_f32 %8, %3, %19\n\tv_fmac_f32 %9, %7, %19"
                        : "+v"(SA0), "+v"(SA1), "+v"(SA2), "+v"(SA3), "+v"(SB0), "+v"(SB1), "+v"(SB2), "+v"(SB3), "=&v"(yA), "=&v"(yB)
                        : "v"(saA), "v"(saB), "v"(b4[0]), "v"(b4[1]), "v"(b4[2]), "v"(b4[3]), "v"(r4[0]), "v"(r4[1]), "v"(r4[2]), "v"(r4[3]));
#undef SC_DPP
                    *(LAS f32x2*)(yp + s * 64) = (f32x2){yA, yB};
                    a4 = na; b4 = nb; k4 = nk; r4 = nr; vv = nv;
                }
                {   const f32x4 wend = *(const LAS f32x4*)(vb + 15 * 384);
                    SA0 *= wend[0]; SA1 *= wend[1]; SA2 *= wend[2]; SA3 *= wend[3]; SB0 *= wend[0]; SB1 *= wend[1]; SB2 *= wend[2]; SB3 *= wend[3]; }
            } else {
                if (ch + 1 < NCH) SC_DERIVE(buf ^ 1);
                if (ch + 2 < NCH) SC_LOADRAW(ch + 2);
                if (ch > 0) SC_YREDUCE(ch - 1, buf ^ 1);
            }
            asm volatile("s_waitcnt lgkmcnt(0)" ::: "memory"); __builtin_amdgcn_s_barrier(); asm volatile("" ::: "memory");
        }
        if (wid >= 4) SC_YREDUCE(NCH - 1, (NCH - 1) & 1);
        __syncthreads();
#undef SC_LOADRAW
#undef SC_DERIVE
#undef SC_YREDUCE
    }
}

__device__ __forceinline__ void phase_r4(const Params& p, int jr) {
    const int tid = opaque_tid(), lane = tid & 63, wave = __builtin_amdgcn_readfirstlane(tid >> 6);
    const int gw = BID * 8 + wave, NGW = GRD * 8;
    const bf16_t* P = (const bf16_t*)(p.ws + WS_C); const bf16_t* Y = (const bf16_t*)(p.ws + WS_B);
    const float* BON = (const float*)(p.ws + WS_CUM);
    bf16_t* YG = (bf16_t*)(p.ws + WS_LD);
    const float* mu = p.rwkv_mu + (size_t)jr * RWKV_IN;
    for (int it = gw; it < 2048; it += NGW) {
        const int tile = it >> 2, q = it & 3, c = 256 * q + 4 * lane, hd = 4 * q + (lane >> 4);
        const f32x4 muv = *(const f32x4*)(mu + 2048 + c), mug = *(const f32x4*)(mu + 3072 + c);
        const f32x4 lnw = *(const f32x4*)(p.rwkv_ln_w + jr * 1024 + c), lnb = *(const f32x4*)(p.rwkv_ln_b + jr * 1024 + c);
        const int m0 = tile * 33;
        f32x4 vp = {0.f, 0.f, 0.f, 0.f}, gp = vp;
        if (m0 % LP != 0) { const bf16_t* pr = P + (size_t)(m0 - 1) * 4096 + c;
            const u32x2 c2 = *(const u32x2*)(pr + 2048), d2 = *(const u32x2*)(pr + 3072);
            vp = (f32x4){bflo(c2.x), bfhi(c2.x), bflo(c2.y), bfhi(c2.y)}; gp = (f32x4){bflo(d2.x), bfhi(d2.x), bflo(d2.y), bfhi(d2.y)}; }
        u32x2 c2a, d2a, ywa, c2b, d2b, ywb, c2c, d2c, ywc; float bona, bonb, bonc;
#define R4_LOAD(C2, D2, YW, BN, i_) do { const size_t rr_ = (size_t)(m0 + ((i_) < 33 ? (i_) : 32)); const bf16_t* pr_ = P + rr_ * 4096 + c; \
        C2 = *(const u32x2*)(pr_ + 2048); D2 = *(const u32x2*)(pr_ + 3072); YW = *(const u32x2*)(Y + rr_ * 1024 + c); BN = BON[rr_ * 16 + hd]; } while (0)
#define R4_COMP(C2, D2, YW, BN, i_) do { const size_t row = (size_t)(m0 + (i_)); \
        const f32x4 vc = {bflo(C2.x), bfhi(C2.x), bflo(C2.y), bfhi(C2.y)}, gc = {bflo(D2.x), bfhi(D2.x), bflo(D2.y), bfhi(D2.y)}; \
        const f32x4 yv = {bflo(YW.x), bfhi(YW.x), bflo(YW.y), bfhi(YW.y)}; \
        const f32x4 vl = vc + (vp - vc) * muv, gl = gc + (gp - gc) * mug; \
        vp = vc; gp = gc; \
        const float mean = red16((yv[0] + yv[1]) + (yv[2] + yv[3])) * (1.f / 64.f); \
        const f32x4 d = yv - mean; \
        const float var = red16((d[0] * d[0] + d[1] * d[1]) + (d[2] * d[2] + d[3] * d[3])) * (1.f / 64.f); \
        const float rstd = __builtin_amdgcn_rsqf(var + GN_EPS); \
        const f32x4 o = (d * rstd * lnw + lnb) + BN * vl; \
        u32x2 w; w.x = pk2(o[0] * gl[0] * sigmoidf_(gl[0]), o[1] * gl[1] * sigmoidf_(gl[1])); w.y = pk2(o[2] * gl[2] * sigmoidf_(gl[2]), o[3] * gl[3] * sigmoidf_(gl[3])); \
        *(u32x2*)(YG + row * 1024 + c) = w; } while (0)
        R4_LOAD(c2a, d2a, ywa, bona, 0); R4_LOAD(c2b, d2b, ywb, bonb, 1);
#pragma unroll 1
        for (int i = 0; i < 33; i += 3) {
            R4_LOAD(c2c, d2c, ywc, bonc, i + 2); R4_COMP(c2a, d2a, ywa, bona, i);
            R4_LOAD(c2a, d2a, ywa, bona, i + 3); R4_COMP(c2b, d2b, ywb, bonb, i + 1);
            R4_LOAD(c2b, d2b, ywb, bonb, i + 4); R4_COMP(c2c, d2c, ywc, bonc, i + 2);
        }
#undef R4_LOAD
#undef R4_COMP
    }
}

#define MT_BAR() do { asm volatile("s_waitcnt lgkmcnt(0)" ::: "memory"); __builtin_amdgcn_s_barrier(); asm volatile("" ::: "memory"); } while (0)
__device__ __forceinline__ void mini_gemm_tail(const bf16_t* A, const bf16_t* Wt, bf16_t* O, LAS unsigned char* lds) {
    const int tid = opaque_tid(), lane = tid & 63, w = tid >> 6, wr = w >> 2, wc = w & 3;
    LAS bf16_t* As = (LAS bf16_t*)lds;
    LAS bf16_t* Bs = As + 32 * 520;
    for (int t = BID; t < 256; t += GRD) {
        const int r0 = 16384 + 32 * (t >> 4), c0 = 64 * (t & 15);
        u32x4 stg[12];
#define MT_LOAD(h) do { _Pragma("unroll") for (int j_ = 0; j_ < 12; ++j_) { const int c_ = tid + 512 * j_; \
            const bf16_t* src_ = (c_ < 2048) ? A + (size_t)(r0 + (c_ >> 6)) * 1024 + 512 * (h) + 8 * (c_ & 63) : Wt + (size_t)(c0 + ((c_ - 2048) >> 6)) * 1024 + 512 * (h) + 8 * (c_ & 63); \
            stg[j_] = *(const u32x4*)src_; } } while (0)
#define MT_STORE() do { _Pragma("unroll") for (int j_ = 0; j_ < 12; ++j_) { const int c_ = tid + 512 * j_; \
            LAS bf16_t* dst_ = (c_ < 2048) ? As + (c_ >> 6) * 520 + 8 * (c_ & 63) : Bs + ((c_ - 2048) >> 6) * 520 + 8 * (c_ & 63); \
            *(LAS u32x4*)dst_ = stg[j_]; } } while (0)
        f32x4 acc = {0.f, 0.f, 0.f, 0.f};
        const LAS bf16_t* ap = As + (16 * wr + (lane & 15)) * 520 + 8 * (lane >> 4);
        const LAS bf16_t* bp = Bs + (16 * wc + (lane & 15)) * 520 + 8 * (lane >> 4);
        MT_LOAD(0); MT_STORE(); MT_BAR();
        MT_LOAD(1);
#pragma unroll
        for (int k = 0; k < 16; ++k) { const bf16x8 a = *(const LAS bf16x8*)(ap + 32 * k), b = *(const LAS bf16x8*)(bp + 32 * k); acc = __builtin_amdgcn_mfma_f32_16x16x32_bf16(a, b, acc, 0, 0, 0); }
        MT_BAR();
        MT_STORE(); MT_BAR();
#pragma unroll
        for (int k = 0; k < 16; ++k) { const bf16x8 a = *(const LAS bf16x8*)(ap + 32 * k), b = *(const LAS bf16x8*)(bp + 32 * k); acc = __builtin_amdgcn_mfma_f32_16x16x32_bf16(a, b, acc, 0, 0, 0); }
        MT_BAR();
#undef MT_LOAD
#undef MT_STORE
        bf16_t* op = O + (size_t)(r0 + 16 * wr + 4 * (lane >> 4)) * 1024 + c0 + 16 * wc + (lane & 15);
#pragma unroll
        for (int r = 0; r < 4; ++r) op[(size_t)r * 1024] = (bf16_t)(pk2(acc[r], 0.f) & 0xffffu);
    }
}

__device__ __forceinline__ void mini_gemm_tail_wide(const bf16_t* A, const bf16_t* Wt, bf16_t* O, LAS unsigned char* lds, float qscale, int qcols) {
    const int tid = opaque_tid(), lane = tid & 63, w = tid >> 6, wr = w >> 2, wc = w & 3;
    LAS bf16_t* As = (LAS bf16_t*)lds;
    LAS bf16_t* Bs = As + 64 * 264;
    for (int t = BID; t < 256; t += GRD) {
        const int r0 = 16384 + 64 * (t & 7), c0 = 128 * (t >> 3);
        u32x4 stg[12];
#define MW_LOAD(q) do { _Pragma("unroll") for (int j_ = 0; j_ < 12; ++j_) { const int c_ = tid + 512 * j_; \
            const bf16_t* src_ = (c_ < 2048) ? A + (size_t)(r0 + (c_ >> 5)) * 1024 + 256 * (q) + 8 * (c_ & 31) : Wt + (size_t)(c0 + ((c_ - 2048) >> 5)) * 1024 + 256 * (q) + 8 * (c_ & 31); \
            stg[j_] = *(const u32x4*)src_; } } while (0)
#define MW_STORE() do { _Pragma("unroll") for (int j_ = 0; j_ < 12; ++j_) { const int c_ = tid + 512 * j_; \
            LAS bf16_t* dst_ = (c_ < 2048) ? As + (c_ >> 5) * 264 + 8 * (c_ & 31) : Bs + ((c_ - 2048) >> 5) * 264 + 8 * (c_ & 31); \
            *(LAS u32x4*)dst_ = stg[j_]; } } while (0)
        f32x4 acc[2][2];
#pragma unroll
        for (int a = 0; a < 2; ++a)
#pragma unroll
            for (int b = 0; b < 2; ++b) acc[a][b] = (f32x4){0.f, 0.f, 0.f, 0.f};
        const LAS bf16_t* ap = As + (32 * wr + (lane & 15)) * 264 + 8 * (lane >> 4);
        const LAS bf16_t* bp = Bs + (32 * wc + (lane & 15)) * 264 + 8 * (lane >> 4);
        MW_LOAD(0); MW_STORE(); MT_BAR();
#pragma unroll
        for (int q = 0; q < 4; ++q) {
            if (q < 3) MW_LOAD(q + 1);
#pragma unroll
            for (int kk = 0; kk < 8; ++kk) {
                const bf16x8 a0 = *(const LAS bf16x8*)(ap + 32 * kk), a1 = *(const LAS bf16x8*)(ap + 16 * 264 + 32 * kk);
                const bf16x8 b0 = *(const LAS bf16x8*)(bp + 32 * kk), b1 = *(const LAS bf16x8*)(bp + 16 * 264 + 32 * kk);
                acc[0][0] = __builtin_amdgcn_mfma_f32_16x16x32_bf16(a0, b0, acc[0][0], 0, 0, 0); acc[0][1] = __builtin_amdgcn_mfma_f32_16x16x32_bf16(a0, b1, acc[0][1], 0, 0, 0);
                acc[1][0] = __builtin_amdgcn_mfma_f32_16x16x32_bf16(a1, b0, acc[1][0], 0, 0, 0); acc[1][1] = __builtin_amdgcn_mfma_f32_16x16x32_bf16(a1, b1, acc[1][1], 0, 0, 0);
            }
            MT_BAR();
            if (q < 3) { MW_STORE(); MT_BAR(); }
        }
#undef MW_LOAD
#undef MW_STORE
        const float sc = (c0 < qcols) ? qscale : 1.f;
#pragma unroll
        for (int a = 0; a < 2; ++a)
#pragma unroll
            for (int b = 0; b < 2; ++b) { bf16_t* op = O + (size_t)(r0 + 32 * wr + 16 * a + 4 * (lane >> 4)) * 4096 + c0 + 32 * wc + 16 * b + (lane & 15);
#pragma unroll
                for (int r = 0; r < 4; ++r) op[(size_t)r * 4096] = (bf16_t)(pk2(acc[a][b][r] * sc, 0.f) & 0xffffu); }
    }
}

#define XB_TMO      128
#define XB_XCNT(j)  (256  + 64 * (j))
#define XB_XSUB(j)  (1280 + 64 * (j))
#define XB_XGEN(j)  (2304 + 64 * (j))
#define XB_TOP      3328
#define XB_TOPGEN   3392
#define XCD_BAR_WORDS 3456
#define XB_SPIN_CAP (1u << 18)

__device__ __forceinline__ unsigned xb_ld(unsigned* p)              { return __hip_atomic_load(p, __ATOMIC_RELAXED, __HIP_MEMORY_SCOPE_AGENT); }
__device__ __forceinline__ unsigned xb_add(unsigned* p, unsigned v) { return __hip_atomic_fetch_add(p, v, __ATOMIC_RELAXED, __HIP_MEMORY_SCOPE_AGENT); }
__device__ __forceinline__ unsigned xb_xcc_id() { return (unsigned)__builtin_amdgcn_s_getreg((3 << 11) | 20) & 0xFu; }
#define XB_SPIN(cond, bar) do { unsigned _sp = 0; while (cond) { __builtin_amdgcn_s_sleep(1); \
    if ((++_sp & 255u) == 0u) { if (xb_ld(&(bar)[XB_TMO])) break; if (_sp > XB_SPIN_CAP) { atomicAdd(&(bar)[XB_TMO], 1u); break; } } } } while (0)

struct XcdBarrier {
    unsigned* bar; unsigned x;
    volatile LAS unsigned* st;
};

__device__ __forceinline__ XcdBarrier xcd_barrier_post(unsigned* bar, volatile LAS unsigned* st) {
    XcdBarrier b; b.bar = bar; b.x = xb_xcc_id(); b.st = st;
    if (threadIdx.x == 0) (void)xb_add(&bar[XB_XCNT(b.x)], 1u);
    return b;
}
__device__ __forceinline__ void xcd_barrier_complete(unsigned* bar, unsigned x, unsigned& nloc, unsigned& nx) {
    const unsigned G = gridDim.x * gridDim.y * gridDim.z;
    unsigned sum, cnt, mine, sp = 0u;
    for (;;) {
        sum = 0u; cnt = 0u; mine = 0u;
#pragma unroll
        for (unsigned j = 0; j < 16; ++j) { const unsigned c = xb_ld(&bar[XB_XCNT(j)]); sum += c; cnt += (c > 0u) ? 1u : 0u; mine = (j == x) ? c : mine; }
        if (sum == G) break;
        __builtin_amdgcn_s_sleep(1);
        if ((++sp & 255u) == 0u) { if (xb_ld(&bar[XB_TMO])) break; if (sp > XB_SPIN_CAP) { atomicAdd(&bar[XB_TMO], 1u); break; } }
    }
    nloc = mine > 0u ? mine : 1u; nx = cnt > 0u ? cnt : 1u;
}

__device__ __forceinline__ void xcd_barrier(const XcdBarrier& b) {
    asm volatile("s_waitcnt vmcnt(0)" ::: "memory");
    __syncthreads();
    if (threadIdx.x == 0) {
        unsigned* bar = b.bar;
        __builtin_amdgcn_s_waitcnt(0);
        unsigned nloc = b.st[0], nx = b.st[1];
        if (nloc == 0u) { xcd_barrier_complete(bar, b.x, nloc, nx); b.st[0] = nloc; b.st[1] = nx; }
        const unsigned old = xb_add(&bar[XB_XSUB(b.x)], 1u);
        const unsigned gen = old / nloc;
        if (old + 1u == (gen + 1u) * nloc) {
            __builtin_amdgcn_fence(__ATOMIC_RELEASE, "agent");
            asm volatile("s_waitcnt vmcnt(0)" ::: "memory");
            const unsigned og = xb_add(&bar[XB_TOP], 1u);
            const unsigned tg = og / nx;
            if (og + 1u == (tg + 1u) * nx) xb_add(&bar[XB_TOPGEN], 1u);
            else XB_SPIN(xb_ld(&bar[XB_TOPGEN]) == tg, bar);
            __builtin_amdgcn_fence(__ATOMIC_ACQUIRE, "agent");
            xb_add(&bar[XB_XGEN(b.x)], 1u);
            asm volatile("s_waitcnt vmcnt(0)" ::: "memory");
        } else {
            XB_SPIN(xb_ld(&bar[XB_XGEN(b.x)]) == gen, bar);
            __builtin_amdgcn_fence(__ATOMIC_ACQUIRE, "agent");
            asm volatile("s_waitcnt vmcnt(0)" ::: "memory");
        }
    }
    __syncthreads();
}

__global__ void __launch_bounds__(512, 2) fwd_megakernel(Params p) {
    extern __shared__ __attribute__((aligned(16))) unsigned char lds_raw[];
    LAS unsigned char* lds = (LAS unsigned char*)lds_raw;
    cg::grid_group grid = cg::this_grid();
    bf16_t* U = (bf16_t*)(p.ws + WS_B); bf16_t* WIN = (bf16_t*)(p.ws + WS_WIN); bf16_t* WOUT = (bf16_t*)(p.ws + WS_WOUT);
    bf16_t* P = (bf16_t*)(p.ws + WS_C); bf16_t* PL = (bf16_t*)(p.ws + WS_PL); float* MB = (float*)(p.ws + WS_C);
    volatile LAS unsigned* st = (volatile LAS unsigned*)(lds + LDS_BYTES - 64);
    if (threadIdx.x < 2) st[threadIdx.x] = 0u;
    __syncthreads();
    XcdBarrier bar = xcd_barrier_post((unsigned*)p.ws + 4096, st);
#define GBAR() do { XcdBarrier bb_ = bar; asm volatile("" : "+s"(bb_.x)); xcd_barrier(bb_); } while (0)
    phase_e<0>(p, lds, 0, -1);
    if (p.out == nullptr) grid.sync();
    GBAR();
#pragma unroll 1
    for (int layer = 0; layer < 4; ++layer) {
        const int jr = layer >> 1; const bool rw = (layer & 1) != 0;
        if (!rw) phase_cumsum(p, lds);
        {   const int mmain = rw ? MROWS : 16384;
            pg8::Gemm g{U, WIN, mmain, rw ? 4352 : 4096, 1024}; pg8::StaticOrder S; S.init(mmain, rw ? 4352 : 4096, (int)GRD, (int)BID);
            pg8::EpiP E{P, PL, rw ? 1.f : 0.125f * LOG2E, rw ? 0 : 1024};
            pg8::gemm_phase<pg8::EpiP, pg8::StaticOrder, true, true>(lds, g, S, E);
            if (!rw) mini_gemm_tail_wide(U, WIN, P, lds, 0.125f * LOG2E, 1024); }
        GBAR();
        if (!rw) { phase_attn(p, lds, (unsigned*)p.ws + 8192 + 64 * jr); GBAR(); }
        else { phase_lora_prep(p, jr); GBAR();
            {   int kl_ = 256; asm volatile("" : "+s"(kl_));
                pg8::Gemm g{(const bf16_t*)(p.ws + WS_WIN), (const bf16_t*)(p.ws + WS_CUM), MROWS, 2048, kl_}; pg8::StaticOrder S; S.init(MROWS, 2048, (int)GRD, (int)BID);
                pg8::EpiLora E{(bf16_t*)(p.ws + WS_LD), (bf16_t*)(p.ws + WS_AA)};
                pg8::gemm_phase<pg8::EpiLora, pg8::StaticOrder, true, true>(lds, g, S, E); }
            GBAR(); phase_scan(p, lds, jr); GBAR(); phase_r4(p, jr); GBAR(); }
        {   pg8::Gemm g{rw ? (const bf16_t*)(p.ws + WS_LD) : (const bf16_t*)(p.ws + WS_B), WOUT, 16384, 1024, 1024}; pg8::StaticOrder S; S.init(16384, 1024, (int)GRD, (int)BID);
            pg8::EpiM E{(bf16_t*)MB};
            pg8::gemm_phase<pg8::EpiM, pg8::StaticOrder, true, true>(lds, g, S, E);
            mini_gemm_tail(g.A, WOUT, (bf16_t*)MB, lds); }
        GBAR();
        phase_e<1>(p, lds, layer < 3 ? layer + 1 : -1, layer);
        if (layer < 3) GBAR();
    }
}

extern "C" void kernel_launch(void* const* d_in, const int* in_sizes, int n_in, void* d_out, int out_size, void* d_ws, size_t ws_size, hipStream_t stream) {
    static int grid_blocks = 0;
    if (grid_blocks == 0) {
        if (n_in != 19 || ws_size < WS_END) { fprintf(stderr, "kernel_launch: unexpected inputs (n_in %d, ws %zu)\n", n_in, ws_size); grid_blocks = -1; return; }
        int dev = 0, cus = 0, per_cu = 0;
        hipGetDevice(&dev); hipDeviceGetAttribute(&cus, hipDeviceAttributeMultiprocessorCount, dev);
        if (hipFuncSetAttribute((const void*)fwd_megakernel, hipFuncAttributeMaxDynamicSharedMemorySize, LDS_BYTES) != hipSuccess) { fprintf(stderr, "kernel_launch: hipFuncSetAttribute failed\n"); grid_blocks = -1; return; }
        if (hipOccupancyMaxActiveBlocksPerMultiprocessor(&per_cu, (const void*)fwd_megakernel, 512, LDS_BYTES) != hipSuccess || per_cu < 1) { fprintf(stderr, "kernel_launch: occupancy query failed (%d)\n", per_cu); (void)hipGetLastError(); grid_blocks = -1; return; }
        grid_blocks = cus * (per_cu > 1 ? 1 : per_cu);
    }
    if (grid_blocks < 0) return;
    if (hipMemsetAsync(d_ws, 0, 65536, stream) != hipSuccess) { fprintf(stderr, "kernel_launch: memset failed\n"); return; }
    Params p{};
    const float** f = (const float**)&p;
    for (int i = 0; i < 19; ++i) f[i] = (const float*)d_in[i];
    p.out = (float*)d_out; p.ws = (unsigned char*)d_ws;
    void* args[] = {&p};
    hipError_t e = hipLaunchCooperativeKernel((const void*)fwd_megakernel, dim3(grid_blocks), dim3(512), args, LDS_BYTES, stream);
    if (e != hipSuccess) fprintf(stderr, "cooperative launch failed: %s (grid %d)\n", hipGetErrorString(e), grid_blocks);
}
```

```cpp
#include <hip/hip_runtime.h>
#include <hip/hip_cooperative_groups.h>
#include <cstdio>
#include <cstdint>
namespace cg = cooperative_groups;
__device__ __forceinline__ int opaque_tid() { int t = threadIdx.x; asm volatile("" : "+v"(t)); return t; }
__device__ __forceinline__ int opaque_bid() { int t = blockIdx.x; asm volatile("" : "+s"(t)); return t; }
__device__ __forceinline__ int opaque_grid() { int t = gridDim.x; asm volatile("" : "+s"(t)); return t; }
namespace pg8 {
#define PG8_LAS __attribute__((address_space(3)))
typedef unsigned short bf16_t;
typedef short bf16x8 __attribute__((ext_vector_type(8)));
typedef float f32x4 __attribute__((ext_vector_type(4)));
typedef unsigned u32x4 __attribute__((ext_vector_type(4)));
constexpr int BM = 256, BK = 64, HALF = 128, HTB = HALF * BK * 2  , STAGE_BYTES = 8 * HTB, NXCD = 8, WGM = 8;

__host__ __device__ __forceinline__ int lds_byte(int r, int c) { const int st = (r >> 4) * 2 + (c >> 5), rr = r & 15, cc = c & 31, ob = rr * 64 + cc * 2; return st * 1024 + (ob ^ (((ob >> 9) & 1) << 5)); }
__host__ __device__ __forceinline__ void stage_rc(int b, int& R, int& C) { const int st = b / 1024, sb = b % 1024, swz = sb ^ (((sb >> 9) & 1) << 5); R = (st >> 1) * 16 + swz / 64; C = (st & 1) * 32 + (swz % 64) / 2; }
__host__ __device__ __forceinline__ int perm32(int rho) { const int n = rho >> 4, i = rho & 15; return 8 * (i >> 2) + 4 * n + (i & 3); }

struct Unit { int pm, pn; };
struct Gemm { const bf16_t* A; const bf16_t* Bt; int M, N, K; };

struct StaticOrder {
    int nM, nN, nwg, G, c;
    __host__ __device__ void init(int M, int N, int G_, int c_) { nM = M / BM; nN = N / BM; nwg = nM * nN; G = G_; c = c_; }
    __host__ __device__ bool next(int i, Unit& u) const {
        const long L = (long)i * G + c; if (L >= nwg) return false;
        int wgid = (int)L; { const int q = nwg / NXCD, r = nwg % NXCD, xcd = wgid % NXCD, off = wgid / NXCD; wgid = (xcd < r ? xcd * (q + 1) : r * (q + 1) + (xcd - r) * q) + off; }
        const int nig = WGM * nN, gid = wgid / nig, fm = gid * WGM, gsz = (nM - fm) < WGM ? (nM - fm) : WGM;
        u.pm = fm + ((wgid % nig) % gsz); u.pn = (wgid % nig) / gsz; return true;
    }
    __device__ __forceinline__ void a_ready(const Unit&) const {}
    __device__ __forceinline__ void done(const Unit&) const {}
};

__device__ __forceinline__ unsigned cvt_pk_bf16(float lo, float hi) { unsigned r; asm volatile("v_cvt_pk_bf16_f32 %0, %1, %2" : "=v"(r) : "v"(lo), "v"(hi)); return r; }
typedef float f32x2 __attribute__((ext_vector_type(2)));
typedef __bf16 bf16x2_t __attribute__((ext_vector_type(2)));
__device__ __forceinline__ unsigned pk2(float lo, float hi) { f32x2 v = {lo, hi}; bf16x2_t b = __builtin_convertvector(v, bf16x2_t); return __builtin_bit_cast(unsigned, b); }
struct EpiP {
    static constexpr bool PERM = true, AFTER_DRAIN = false;
    bf16_t* P; bf16_t* PL; float qscale; int qcols;
    __device__ __forceinline__ void operator()(const f32x4 (&acc)[2][2][4][2], const Unit& u, int wr, int wc, int fr, int fq) const {
        const int row0 = u.pm * BM + wr * 64 + fr; const int colt = u.pn * BM;
        bf16_t* base; int ldc, c0;
        if (colt < 4096) { base = P; ldc = 4096; c0 = colt; } else { base = PL; ldc = 256; c0 = colt - 4096; }
        const float sc = (colt < qcols) ? qscale : 1.f;
        const int col0 = c0 + wc * 32 + 8 * fq;
#pragma unroll
        for (int ai = 0; ai < 2; ++ai)
#pragma unroll
            for (int m = 0; m < 4; ++m) { bf16_t* rowp = base + (size_t)(row0 + ai * HALF + m * 16) * ldc + col0;
#pragma unroll
                for (int bj = 0; bj < 2; ++bj) { const f32x4 v0 = acc[ai][bj][m][0] * sc, v1 = acc[ai][bj][m][1] * sc;
                    u32x4 w; w.x = pk2(v0[0], v0[1]); w.y = pk2(v0[2], v0[3]); w.z = pk2(v1[0], v1[1]); w.w = pk2(v1[2], v1[3]);
                    *(u32x4*)(rowp + bj * HALF) = w; } }
    }
};
struct EpiM {
    static constexpr bool PERM = true, AFTER_DRAIN = false;
    bf16_t* O;
    __device__ __forceinline__ void operator()(const f32x4 (&acc)[2][2][4][2], const Unit& u, int wr, int wc, int fr, int fq) const {
        const int row0 = u.pm * BM + wr * 64 + fr; const int col0 = u.pn * BM + wc * 32 + 8 * fq;
#pragma unroll
        for (int ai = 0; ai < 2; ++ai)
#pragma unroll
            for (int m = 0; m < 4; ++m) { bf16_t* rowp = O + (size_t)(row0 + ai * HALF + m * 16) * 1024 + col0;
#pragma unroll
                for (int bj = 0; bj < 2; ++bj) { const f32x4 v0 = acc[ai][bj][m][0], v1 = acc[ai][bj][m][1];
                    u32x4 w; w.x = pk2(v0[0], v0[1]); w.y = pk2(v0[2], v0[3]); w.z = pk2(v1[0], v1[1]); w.w = pk2(v1[2], v1[3]);
                    *(u32x4*)(rowp + bj * HALF) = w; } }
    }
};

template <int CTRL> __device__ __forceinline__ float dppz_(float v) { return __int_as_float(__builtin_amdgcn_update_dpp(0, __float_as_int(v), CTRL, 0xF, 0xF, true)); }
typedef _Float16 f16x2_t __attribute__((ext_vector_type(2)));
__device__ __forceinline__ unsigned pkh2(float lo, float hi) { f16x2_t v = {(_Float16)lo, (_Float16)hi}; return __builtin_bit_cast(unsigned, v); }
struct EpiLora {
    static constexpr bool PERM = true, AFTER_DRAIN = false;
    bf16_t* LD; bf16_t* AA;
    __device__ __forceinline__ void operator()(const f32x4 (&acc)[2][2][4][2], const Unit& u, int wr, int wc, int fr, int fq) const {
        const int row0 = u.pm * BM + wr * 64 + fr; const int colt = u.pn * BM; const int t = colt >> 10;
        const int cbase = (colt & 1023) + wc * 32 + 8 * fq;
        bf16_t* base = t ? AA : LD; const float sc = t ? 1.f : -0.6065306597126334f * 1.4426950408889634f;
#pragma unroll
        for (int ai = 0; ai < 2; ++ai)
#pragma unroll
            for (int m = 0; m < 4; ++m) { bf16_t* rowp = base + (size_t)(row0 + ai * HALF + m * 16) * 1024 + cbase;
#pragma unroll
                for (int bj = 0; bj < 2; ++bj) { f32x4 v0 = acc[ai][bj][m][0], v1 = acc[ai][bj][m][1];
#pragma unroll
                    for (int e = 0; e < 4; ++e) { v0[e] = sc * __builtin_amdgcn_rcpf(1.f + __builtin_amdgcn_exp2f(-1.4426950408889634f * v0[e])); v1[e] = sc * __builtin_amdgcn_rcpf(1.f + __builtin_amdgcn_exp2f(-1.4426950408889634f * v1[e])); }
                    u32x4 w;
                    if (t == 0) {
#pragma unroll
                        for (int e = 0; e < 4; ++e) { float x = v0[e], y = v1[e];
                            x += dppz_<0x111>(x); y += dppz_<0x111>(y); x += dppz_<0x112>(x); y += dppz_<0x112>(y); x += dppz_<0x114>(x); y += dppz_<0x114>(y); x += dppz_<0x118>(x); y += dppz_<0x118>(y);
                            v0[e] = x; v1[e] = y; }
                        w.x = pkh2(v0[0], v0[1]); w.y = pkh2(v0[2], v0[3]); w.z = pkh2(v1[0], v1[1]); w.w = pkh2(v1[2], v1[3]);
                    } else { w.x = pk2(v0[0], v0[1]); w.y = pk2(v0[2], v0[3]); w.z = pk2(v1[0], v1[1]); w.w = pk2(v1[2], v1[3]); }
                    *(u32x4*)(rowp + bj * HALF) = w; __builtin_amdgcn_sched_barrier(0); } }
    }
};
template <class Epi, class Sched, bool ALIGN_EPI = false, bool SP2 = false>
__device__ __forceinline__ void gemm_phase(PG8_LAS unsigned char* lds, const Gemm g, const Sched& S, const Epi& E) {
    const int tid = opaque_tid(), wid = __builtin_amdgcn_readfirstlane(tid >> 6), lane = tid & 63, wr = wid >> 2, wc = wid & 3, fr = lane & 15, fq = lane >> 4;
    const int K = g.K, nt = K / BK;
    unsigned voffA[2], voffB[2];
#pragma unroll
    for (int i = 0; i < 2; ++i) { int R, C; stage_rc(tid * 16 + i * 8192, R, C); const int Rb = Epi::PERM ? ((R & ~31) + perm32(R & 31)) : R;
        voffA[i] = (unsigned)(R * K + C) * 2u; voffB[i] = (unsigned)(Rb * K + C) * 2u; }
    const size_t kstep = (size_t)(BK * 2);
    const size_t hstep = (size_t)HALF * K * 2;
    const size_t tstep = 2 * hstep;
    const unsigned ldsw = (unsigned)wid * 1024u;
    const int aoff = lds_byte(wr * 64 + fr, fq * 8), boff = lds_byte(wc * 32 + fr, fq * 8);
#define PG8_SA(b, h) (((b) * 2 + (h)) * HTB)
#define PG8_SB(b, h) ((4 + (b) * 2 + (h)) * HTB)
#define PG8_STAGE(bufoff, gbase, voff) do { _Pragma("unroll") for (int _i = 0; _i < 2; ++_i) \
        __builtin_amdgcn_global_load_lds((const unsigned*)((const char*)(gbase) + (voff)[_i]), (PG8_LAS unsigned*)(lds + (bufoff) + ldsw + _i * 8192), 16, 0, 0); } while (0)
#define PG8_LDA(dst, b, h) do { _Pragma("unroll") for (int m = 0; m < 4; ++m) _Pragma("unroll") for (int k = 0; k < 2; ++k) dst[m][k] = *(const PG8_LAS bf16x8*)(lds + PG8_SA(b, h) + aoff + m * 2048 + k * 1024); } while (0)
#define PG8_LDB(dst, b, h) do { _Pragma("unroll") for (int n = 0; n < 2; ++n) _Pragma("unroll") for (int k = 0; k < 2; ++k) dst[n][k] = *(const PG8_LAS bf16x8*)(lds + PG8_SB(b, h) + boff + n * 2048 + k * 1024); } while (0)
#define PG8_MMA(ai, bj, At, Bt) do { __builtin_amdgcn_s_setprio(1); _Pragma("unroll") for (int m = 0; m < 4; ++m) _Pragma("unroll") for (int n = 0; n < 2; ++n) _Pragma("unroll") for (int k = 0; k < 2; ++k) \
        acc[ai][bj][m][n] = __builtin_amdgcn_mfma_f32_16x16x32_bf16(Bt[n][k], At[m][k], acc[ai][bj][m][n], 0, 0, 0); __builtin_amdgcn_s_setprio(0); } while (0)
#define PG8_WAIT_V(n) asm volatile("s_waitcnt vmcnt(" #n ")" ::: "memory")
#define PG8_WAIT_L(n) asm volatile("s_waitcnt lgkmcnt(" #n ")" ::: "memory")
#define PG8_BAR __builtin_amdgcn_s_barrier()
#define PG8_SCHED __builtin_amdgcn_sched_barrier(0)
    Unit cur, nxt; int ui = 0;
    if (!S.next(0, cur)) return;
    f32x4 acc[2][2][4][2];
#pragma unroll
    for (int a = 0; a < 2; ++a)
#pragma unroll
        for (int b = 0; b < 2; ++b)
#pragma unroll
            for (int m = 0; m < 4; ++m)
#pragma unroll
                for (int n = 0; n < 2; ++n) acc[a][b][m][n] = (f32x4){0.f, 0.f, 0.f, 0.f};
    bf16x8 At[4][2], B0[2][2], B1[2][2];
    const char* cA = (const char*)g.A + (size_t)cur.pm * tstep; const char* cB = (const char*)g.Bt + (size_t)cur.pn * tstep;
    S.a_ready(cur);
    if constexpr (SP2) {
        PG8_STAGE(PG8_SB(0, 0), cB, voffB); PG8_STAGE(PG8_SB(0, 1), cB + hstep, voffB); PG8_STAGE(PG8_SA(0, 0), cA, voffA); PG8_STAGE(PG8_SA(0, 1), cA + hstep, voffA);
        if (wr == 1) PG8_BAR;
        PG8_WAIT_V(2); PG8_BAR;
        PG8_STAGE(PG8_SB(1, 0), cB + kstep, voffB); PG8_STAGE(PG8_SA(1, 0), cA + kstep, voffA); PG8_STAGE(PG8_SB(1, 1), cB + hstep + kstep, voffB);
        PG8_WAIT_V(6); PG8_BAR;
    } else {
        PG8_STAGE(PG8_SB(0, 0), cB, voffB); PG8_STAGE(PG8_SA(0, 0), cA, voffA); PG8_STAGE(PG8_SB(0, 1), cB + hstep, voffB); PG8_STAGE(PG8_SA(0, 1), cA + hstep, voffA);
        if (wr == 1) PG8_BAR;
        PG8_WAIT_V(4); PG8_BAR;
        PG8_STAGE(PG8_SB(1, 0), cB + kstep, voffB); PG8_STAGE(PG8_SA(1, 0), cA + kstep, voffA); PG8_STAGE(PG8_SB(1, 1), cB + hstep + kstep, voffB);
        PG8_WAIT_V(6); PG8_BAR;
    }
    for (;;) {
        const bool has_next = S.next(ui + 1, nxt);
        const char* nA = has_next ? (const char*)g.A + (size_t)nxt.pm * tstep : cA; const char* nB = has_next ? (const char*)g.Bt + (size_t)nxt.pn * tstep : cB;
        for (int t = 0; t < nt; t += 2) {
            const bool last = (t == nt - 2);
            const char* a1 = cA + (size_t)(t + 1) * kstep;
            const char* a2 = last ? nA : cA + (size_t)(t + 2) * kstep; const char* b2 = last ? nB : cB + (size_t)(t + 2) * kstep;
            const char* a3 = a2 + kstep; const char* b3 = b2 + kstep;
            if (last && has_next) S.a_ready(nxt);
            if constexpr (SP2) {
            PG8_LDB(B0, 0, 0); PG8_LDB(B1, 0, 1); PG8_SCHED; PG8_LDA(At, 0, 0); PG8_STAGE(PG8_SA(1, 1), a1 + hstep, voffA);
            PG8_WAIT_V(8); PG8_WAIT_L(0); PG8_BAR; PG8_MMA(0, 0, At, B0); PG8_MMA(0, 1, At, B1); PG8_BAR; PG8_SCHED;
            PG8_LDA(At, 0, 1); PG8_STAGE(PG8_SB(0, 0), b2, voffB); PG8_STAGE(PG8_SB(0, 1), b2 + hstep, voffB); PG8_STAGE(PG8_SA(0, 0), a2, voffA);
            PG8_WAIT_V(8); PG8_WAIT_L(0); PG8_BAR; PG8_MMA(1, 0, At, B0); PG8_MMA(1, 1, At, B1); PG8_BAR; PG8_SCHED;
            PG8_LDB(B0, 1, 0); PG8_LDB(B1, 1, 1); PG8_SCHED; PG8_LDA(At, 1, 0); PG8_STAGE(PG8_SA(0, 1), a2 + hstep, voffA);
            PG8_WAIT_V(8); PG8_WAIT_L(0); PG8_BAR; PG8_MMA(0, 0, At, B0); PG8_MMA(0, 1, At, B1); PG8_BAR; PG8_SCHED;
            PG8_LDA(At, 1, 1); PG8_STAGE(PG8_SB(1, 0), b3, voffB); PG8_STAGE(PG8_SB(1, 1), b3 + hstep, voffB); PG8_STAGE(PG8_SA(1, 0), a3, voffA);
            PG8_WAIT_V(8); PG8_WAIT_L(0); PG8_BAR; PG8_MMA(1, 0, At, B0); PG8_MMA(1, 1, At, B1); PG8_BAR; PG8_SCHED;
            } else {
            PG8_LDB(B0, 0, 0); PG8_SCHED; PG8_LDA(At, 0, 0); PG8_STAGE(PG8_SA(1, 1), a1 + hstep, voffA);
            PG8_WAIT_L(8); PG8_BAR; PG8_WAIT_L(0); PG8_MMA(0, 0, At, B0); PG8_BAR; PG8_SCHED;
            PG8_LDB(B1, 0, 1); PG8_STAGE(PG8_SB(0, 0), b2, voffB);
            PG8_BAR; PG8_WAIT_L(0); PG8_MMA(0, 1, At, B1); PG8_BAR;
            PG8_LDA(At, 0, 1); PG8_STAGE(PG8_SA(0, 0), a2, voffA);
            PG8_BAR; PG8_WAIT_L(0); PG8_MMA(1, 0, At, B0); PG8_BAR; PG8_SCHED;
            PG8_STAGE(PG8_SB(0, 1), b2 + hstep, voffB);
            PG8_WAIT_V(6); PG8_BAR; PG8_MMA(1, 1, At, B1); PG8_BAR;
            PG8_LDB(B0, 1, 0); PG8_SCHED; PG8_LDA(At, 1, 0); PG8_STAGE(PG8_SA(0, 1), a2 + hstep, voffA);
            PG8_WAIT_L(8); PG8_BAR; PG8_WAIT_L(0); PG8_MMA(0, 0, At, B0); PG8_BAR; PG8_SCHED;
            PG8_LDB(B1, 1, 1); PG8_STAGE(PG8_SB(1, 0), b3, voffB);
            PG8_BAR; PG8_WAIT_L(0); PG8_MMA(0, 1, At, B1); PG8_BAR;
            PG8_LDA(At, 1, 1); PG8_STAGE(PG8_SA(1, 0), a3, voffA);
            PG8_BAR; PG8_WAIT_L(0); PG8_MMA(1, 0, At, B0); PG8_BAR; PG8_SCHED;
            PG8_STAGE(PG8_SB(1, 1), b3 + hstep, voffB);
            PG8_WAIT_V(6); PG8_BAR; PG8_MMA(1, 1, At, B1); PG8_BAR;
            }
        }
        if constexpr (ALIGN_EPI) { if (wr == 0) PG8_BAR; }
        if constexpr (!Epi::AFTER_DRAIN) { E(acc, cur, wr, wc, fr, fq); S.done(cur); }
        if (!has_next) break;
#pragma unroll
        for (int a = 0; a < 2; ++a)
#pragma unroll
            for (int b = 0; b < 2; ++b)
#pragma unroll
                for (int m = 0; m < 4; ++m)
#pragma unroll
                    for (int n = 0; n < 2; ++n) acc[a][b][m][n] = (f32x4){0.f, 0.f, 0.f, 0.f};
        cur = nxt; cA = nA; cB = nB; ++ui;
        if constexpr (ALIGN_EPI) { if (wr == 1) PG8_BAR; }
    }
    PG8_WAIT_V(0);
    if constexpr (!ALIGN_EPI) { if (wr == 0) PG8_BAR; }
    PG8_BAR;
    if constexpr (Epi::AFTER_DRAIN) { E.fused(acc, cur, wr, wc, fr, fq, lds, wid, lane); S.done(cur); }
#undef PG8_SA
#undef PG8_SB
#undef PG8_STAGE
#undef PG8_LDA
#undef PG8_LDB
#undef PG8_MMA
#undef PG8_WAIT_V
#undef PG8_WAIT_L
#undef PG8_BAR
#undef PG8_SCHED
}
}
#define LAS __attribute__((address_space(3)))
#define BID opaque_bid()
#define GRD opaque_grid()
typedef unsigned short bf16_t;
typedef short bf16x8 __attribute__((ext_vector_type(8)));
typedef short s16x4 __attribute__((ext_vector_type(4)));
typedef float f32x4 __attribute__((ext_vector_type(4)));
typedef float f32x2 __attribute__((ext_vector_type(2)));
typedef float f32x16 __attribute__((ext_vector_type(16)));
typedef unsigned u32x4 __attribute__((ext_vector_type(4)));
typedef unsigned u32x2 __attribute__((ext_vector_type(2)));

constexpr int NB = 8, SEQ = 2048, NMETA = 16, LSEQ = SEQ + NMETA  , LP = 2112  , DM = 1024;
constexpr int MROWS = NB * LP;
constexpr int FOX_IN = 4112, RWKV_IN = 4224;
constexpr float NORM_EPS = 1e-6f, GN_EPS = 64e-5f, LOG2E = 1.4426950408889634f;
constexpr float DECAY_SCALE = 0.6065306597126334f;
constexpr int LDS_BYTES = 147456;
constexpr size_t MiB = 1u << 20;
constexpr size_t WS_WIN = 1 * MiB;
constexpr size_t WS_WOUT = 10 * MiB;
constexpr size_t WS_HMETA = 12 * MiB;
constexpr size_t WS_CUM = 13 * MiB;
constexpr size_t WS_PL = 15 * MiB;
constexpr size_t WS_B = 24 * MiB;
constexpr size_t WS_C = 57 * MiB;
constexpr size_t WS_LD = 189 * MiB;
constexpr size_t WS_AA = 222 * MiB;
constexpr size_t WS_END = 255 * MiB;
static_assert(WS_B + (size_t)MROWS * 1024 * 2 <= WS_C && WS_C + (size_t)MROWS * 4096 * 2 <= WS_LD && WS_LD + (size_t)MROWS * 2048 <= WS_AA && WS_AA + (size_t)MROWS * 2048 <= WS_END, "ws map");
static_assert(WS_PL + (size_t)MROWS * 512 <= WS_B && WS_CUM + (size_t)MROWS * 64 <= WS_PL, "ws map 2");

struct Params {
    const float *x, *meta, *norm_pre, *norm_post, *fox_w_in, *fox_b_f, *fox_w_out, *rwkv_w_in, *rwkv_mu, *rwkv_w0, *rwkv_w_up, *rwkv_a0, *rwkv_a_up,
        *rwkv_k_k, *rwkv_k_a, *rwkv_r_k, *rwkv_ln_w, *rwkv_ln_b, *rwkv_w_out;
    float* out; unsigned char* ws;
};

__device__ __forceinline__ float wave_sum(float v) {
#pragma unroll
    for (int o = 1; o < 64; o <<= 1) v += __shfl_xor(v, o);
    return v;
}
__device__ __forceinline__ unsigned pk2(float lo, float hi) { return pg8::pk2(lo, hi); }
__device__ __forceinline__ float bflo(unsigned w) { return __uint_as_float(w << 16); }
__device__ __forceinline__ float bfhi(unsigned w) { return __uint_as_float(w & 0xffff0000u); }
template <int CTRL> __device__ __forceinline__ float dppf(float v) { return __int_as_float(__builtin_amdgcn_update_dpp(0, __float_as_int(v), CTRL, 0xF, 0xF, true)); }
__device__ __forceinline__ float red16(float v) {
    v += dppf<0xB1>(v); v += dppf<0x4E>(v); v += dppf<0x141>(v); v += dppf<0x140>(v); return v;
}
__device__ __forceinline__ float xhalf_max(float m) { auto rr = __builtin_amdgcn_permlane32_swap(__float_as_uint(m), __float_as_uint(m), false, false); return __builtin_fmaxf(__uint_as_float(rr[0]), __uint_as_float(rr[1])); }
__device__ __forceinline__ float xhalf_sum(float m) { auto rr = __builtin_amdgcn_permlane32_swap(__float_as_uint(m), __float_as_uint(m), false, false); return __uint_as_float(rr[0]) + __uint_as_float(rr[1]); }
__device__ __forceinline__ float sigmoidf_(float x) { return 1.f / (1.f + __expf(-x)); }
#define LDS_WAIT() asm volatile("s_waitcnt lgkmcnt(0)" ::: "memory")

__device__ __forceinline__ void transpose_item(const float* W, int ldw, bf16_t* WT, LAS float* scr, int kb, int nb, int lane) {
    const int k0 = 64 * kb, n0 = 32 * nb;
#pragma unroll 8
    for (int i = 0; i < 32; ++i) { const int kk = 2 * i + (lane >> 5); scr[kk * 33 + (lane & 31)] = W[(size_t)(k0 + kk) * ldw + n0 + (lane & 31)]; }
    LDS_WAIT();
    const int c = lane & 7;
#pragma unroll
    for (int j = 0; j < 4; ++j) { const int n = (lane >> 3) + 8 * j; const LAS float* s = scr + (8 * c) * 33 + n;
        u32x4 o; o.x = pk2(s[0 * 33], s[1 * 33]); o.y = pk2(s[2 * 33], s[3 * 33]); o.z = pk2(s[4 * 33], s[5 * 33]); o.w = pk2(s[6 * 33], s[7 * 33]);
        *(u32x4*)(WT + (size_t)(n0 + n) * 1024 + k0 + 8 * c) = o; }
    LDS_WAIT();
}

template <int MODE>
__device__ __forceinline__ void phase_e(const Params& p, LAS unsigned char* lds, int next, int prev) {
    const int tid = opaque_tid(), lane = tid & 63, wave = __builtin_amdgcn_readfirstlane(tid >> 6);
    const int G = GRD, gw = BID * 8 + wave, NGW = G * 8;
    bf16_t* U = (bf16_t*)(p.ws + WS_B);
    float* CUM = (float*)(p.ws + WS_CUM);
    float* HMETA = (float*)(p.ws + WS_HMETA);
    const bf16_t* MB = (const bf16_t*)(p.ws + WS_C);
    const bool next_fox = (next >= 0) && ((next & 1) == 0);
    LAS float* WfT = (LAS float*)lds;
    LAS float* scr = (LAS float*)(lds + 65536 + wave * 8448);
    if (next >= 0) {
        const int jn = next >> 1;
        bf16_t* WIN = (bf16_t*)(p.ws + WS_WIN); bf16_t* WOUT = (bf16_t*)(p.ws + WS_WOUT);
        if (next_fox) {
            const float* Wf = p.fox_w_in + (size_t)jn * 1024 * FOX_IN + 4096;
            for (int i = tid; i < 4096; i += 512) { const int k = i >> 2, q = i & 3; const f32x4 v = *(const f32x4*)(Wf + (size_t)k * FOX_IN + 4 * q);
                WfT[(4 * q + 0) * 1024 + k] = v[0]; WfT[(4 * q + 1) * 1024 + k] = v[1]; WfT[(4 * q + 2) * 1024 + k] = v[2]; WfT[(4 * q + 3) * 1024 + k] = v[3]; }
            const float* W = p.fox_w_in + (size_t)jn * 1024 * FOX_IN; const float* Wo = p.fox_w_out + (size_t)jn * 1024 * 1024;
            for (int it = gw; it < 16 * 128 + 16 * 32; it += NGW) {
                if (it < 16 * 128) transpose_item(W, FOX_IN, WIN, scr, it / 128, it % 128, lane);
                else { const int r = it - 16 * 128; transpose_item(Wo, 1024, WOUT, scr, r / 32, r % 32, lane); }
            }
        } else {
            const float* W = p.rwkv_w_in + (size_t)jn * 1024 * RWKV_IN; const float* Wo = p.rwkv_w_out + (size_t)jn * 1024 * 1024;
            for (int it = gw; it < 16 * 132 + 16 * 32; it += NGW) {
                if (it < 16 * 132) transpose_item(W, RWKV_IN, WIN, scr, it / 132, it % 132, lane);
                else { const int r = it - 16 * 132; transpose_item(Wo, 1024, WOUT, scr, r / 32, r % 32, lane); }
            }
            for (int i = BID * 512 + tid; i < 16384; i += G * 512) *(u32x4*)(WIN + (size_t)4224 * 1024 + (size_t)i * 8) = (u32x4){0u, 0u, 0u, 0u};
        }
    }
    __syncthreads();
    f32x4 gpo[4], gpr[4];
#pragma unroll
    for (int j = 0; j < 4; ++j) {
        gpo[j] = (MODE == 1) ? *((const f32x4*)(p.norm_post + (size_t)prev * 1024) + lane + 64 * j) : (f32x4){0.f, 0.f, 0.f, 0.f};
        gpr[j] = (next >= 0) ? *((const f32x4*)(p.norm_pre + (size_t)next * 1024) + lane + 64 * j) : (f32x4){0.f, 0.f, 0.f, 0.f};
    }
    const float bfv = (next_fox && lane < 16) ? p.fox_b_f[(next >> 1) * 16 + lane] : 0.f;
    f32x4 nv[4]; u32x2 nmw[4];
#define PE_ISSUE(mm) do { const int m_ = (mm); if (m_ < MROWS) { const int b_ = m_ / LP, t_ = m_ - b_ * LP; if (t_ < LSEQ) { \
        if (MODE == 0) { const float* src_ = (t_ < NMETA) ? p.meta + (size_t)t_ * 1024 : p.x + ((size_t)b_ * SEQ + (t_ - NMETA)) * 1024; \
            _Pragma("unroll") for (int j_ = 0; j_ < 4; ++j_) nv[j_] = *((const f32x4*)src_ + lane + 64 * j_); } \
        else { const float* hr_ = (prev == 0) ? ((t_ < NMETA) ? p.meta + (size_t)t_ * 1024 : p.x + ((size_t)b_ * SEQ + (t_ - NMETA)) * 1024)        \
                                       : ((t_ < NMETA) ? HMETA + (size_t)(b_ * NMETA + t_) * 1024 : p.out + ((size_t)b_ * SEQ + (t_ - NMETA)) * 1024); \
            _Pragma("unroll") for (int j_ = 0; j_ < 4; ++j_) { nv[j_] = *((const f32x4*)hr_ + lane + 64 * j_); nmw[j_] = *((const u32x2*)(MB + (size_t)m_ * 1024) + lane + 64 * j_); } } } } } while (0)
#pragma unroll
    for (int j = 0; j < 4; ++j) { nv[j] = (f32x4){0.f, 0.f, 0.f, 0.f}; nmw[j] = (u32x2){0u, 0u}; }
    PE_ISSUE(gw);
    for (int m = gw; m < MROWS; m += NGW) {
        const int b = m / LP, t = m - b * LP;
        f32x4 v[4]; u32x2 mw4[4];
#pragma unroll
        for (int j = 0; j < 4; ++j) { v[j] = nv[j]; mw4[j] = nmw[j]; }
        PE_ISSUE(m + NGW);
        if (t >= LSEQ) {
            if (next >= 0) { u32x2* o8 = (u32x2*)(U + (size_t)m * 1024) + lane;
#pragma unroll
                for (int j = 0; j < 4; ++j) o8[64 * j] = (u32x2){0u, 0u};
                if (next_fox && lane < 16) CUM[(size_t)m * 16 + lane] = 0.f; }
            continue;
        }
        float* hrow = (t < NMETA) ? HMETA + (size_t)(b * NMETA + t) * 1024 : p.out + ((size_t)b * SEQ + (t - NMETA)) * 1024;
        if (MODE == 1) {
            f32x4 mv[4]; float ss = 0.f;
#pragma unroll
            for (int j = 0; j < 4; ++j) { mv[j] = (f32x4){bflo(mw4[j].x), bfhi(mw4[j].x), bflo(mw4[j].y), bfhi(mw4[j].y)};
                ss += (mv[j][0] * mv[j][0] + mv[j][1] * mv[j][1]) + (mv[j][2] * mv[j][2] + mv[j][3] * mv[j][3]); }
            const float rs = __builtin_amdgcn_rsqf(wave_sum(ss) * (1.f / 1024.f) + NORM_EPS);
#pragma unroll
            for (int j = 0; j < 4; ++j) v[j] = v[j] + mv[j] * rs * gpo[j];
        }
        if (MODE == 1) {
#pragma unroll
            for (int j = 0; j < 4; ++j) *((f32x4*)hrow + lane + 64 * j) = v[j];
        }
        if (next >= 0) {
            float ss = 0.f;
#pragma unroll
            for (int j = 0; j < 4; ++j) ss += (v[j][0] * v[j][0] + v[j][1] * v[j][1]) + (v[j][2] * v[j][2] + v[j][3] * v[j][3]);
            const float rs = __builtin_amdgcn_rsqf(wave_sum(ss) * (1.f / 1024.f) + NORM_EPS);
            u32x2* o8 = (u32x2*)(U + (size_t)m * 1024) + lane;
#pragma unroll
            for (int j = 0; j < 4; ++j) { v[j] = v[j] * rs * gpr[j]; o8[64 * j] = (u32x2){pk2(v[j][0], v[j][1]), pk2(v[j][2], v[j][3])}; }
            if (next_fox) {
                float mine = 0.f;
#pragma unroll
                for (int hd = 0; hd < 16; ++hd) { float s = 0.f;
#pragma unroll
                    for (int j = 0; j < 4; ++j) { const f32x4 w = *((const LAS f32x4*)(WfT + hd * 1024) + lane + 64 * j); s += (v[j][0] * w[0] + v[j][1] * w[1]) + (v[j][2] * w[2] + v[j][3] * w[3]); }
                    s = wave_sum(s); if (lane == hd) mine = s; }
                if (lane < 16) { const float xp = (mine + bfv) * LOG2E; CUM[(size_t)m * 16 + lane] = fminf(xp, 0.f) - __builtin_amdgcn_logf(1.f + __builtin_amdgcn_exp2f(-fabsf(xp))); }
            }
        }
    }
}

#undef PE_ISSUE
__device__ __forceinline__ void phase_cumsum(const Params& p, LAS unsigned char* lds) {
    const int tid = opaque_tid(); LAS float* s = (LAS float*)lds;
    float* CUM = (float*)(p.ws + WS_CUM);
    for (int j = (GRD >= 256) ? BID - 128 : BID; j < 128; j += GRD) {
        if (j < 0) break;
        const int b = j >> 4, hd = j & 15; float* base = CUM + (size_t)b * LP * 16 + hd;
        float v[5]; float tot = 0.f;
#pragma unroll
        for (int e = 0; e < 5; ++e) { const int t = tid * 5 + e; v[e] = (t < LP) ? base[(size_t)t * 16] : 0.f; tot += v[e]; }
        s[tid] = tot; __syncthreads();
        for (int off = 1; off < 512; off <<= 1) { const float a = (tid >= off) ? s[tid - off] : 0.f; __syncthreads(); s[tid] += a; __syncthreads(); }
        float run = s[tid] - tot;
#pragma unroll
        for (int e = 0; e < 5; ++e) { const int t = tid * 5 + e; run += v[e]; if (t < LP) base[(size_t)t * 16] = run; }
        __syncthreads();
    }
}

__device__ __forceinline__ void phase_attn(const Params& p, LAS unsigned char* lds, unsigned* qctr) {
    const int tid = opaque_tid(), lane = tid & 63, wid = __builtin_amdgcn_readfirstlane(tid >> 6), r32 = lane & 31, hi = lane >> 5;
    LAS bf16_t* Ks = (LAS bf16_t*)lds;
    LAS bf16_t* Vs = Ks + 2 * 64 * 72;
    LAS float* cks = (LAS float*)(lds + 2 * 64 * 72 * 2 + 2 * 64 * 96 * 2);
    typedef short v4i16_t __attribute__((ext_vector_type(4)));
    const int vrd = (4 * hi + ((lane & 15) >> 2)) * 96 + 16 * ((lane >> 4) & 1) + 4 * (lane & 3);
    const bf16_t* P = (const bf16_t*)(p.ws + WS_C);
    const float* CUM = (const float*)(p.ws + WS_CUM);
    bf16_t* OG = (bf16_t*)(p.ws + WS_B);
    const int kr = tid >> 3, kc = tid & 7;
    volatile LAS unsigned* uslot = (volatile LAS unsigned*)(lds + LDS_BYTES - 32);
#define AT_BAR() do { asm volatile("s_waitcnt lgkmcnt(0)" ::: "memory"); __builtin_amdgcn_s_barrier(); asm volatile("" ::: "memory"); } while (0)
#define AT_STORE_K(buf, KR, CR) do { *(LAS u32x4*)(Ks + (buf) * 4608 + kr * 72 + kc * 8) = (KR); if (tid < 64) cks[(buf) * 64 + tid] = -(CR); } while (0)
#define AT_STORE_V(buf, VR) do { *(LAS u32x4*)(Vs + (buf) * 6144 + kr * 96 + kc * 8) = (VR); } while (0)
#define AT_QK(t, P0, P1) do { const LAS bf16_t* Kb_ = Ks + ((t) & 1) * 4608; const LAS float* cb_ = cks + ((t) & 1) * 64; \
        _Pragma("unroll") for (int i_ = 0; i_ < 4; ++i_) { const f32x4 c0_ = *(const LAS f32x4*)(cb_ + 8 * i_ + 4 * hi), c1_ = *(const LAS f32x4*)(cb_ + 32 + 8 * i_ + 4 * hi); \
            _Pragma("unroll") for (int e_ = 0; e_ < 4; ++e_) { P0[4 * i_ + e_] = c0_[e_] - m_run; P1[4 * i_ + e_] = c1_[e_] - m_run; } } \
        _Pragma("unroll") for (int d0_ = 0; d0_ < 4; ++d0_) { \
            const bf16x8 a0_ = *(const LAS bf16x8*)(Kb_ + r32 * 72 + d0_ * 16 + hi * 8), a1_ = *(const LAS bf16x8*)(Kb_ + (32 + r32) * 72 + d0_ * 16 + hi * 8); \
            P0 = __builtin_amdgcn_mfma_f32_32x32x16_bf16(a0_, qr[d0_], P0, 0, 0, 0); P1 = __builtin_amdgcn_mfma_f32_32x32x16_bf16(a1_, qr[d0_], P1, 0, 0, 0); } } while (0)
#define AT_PV(c, PX, B) do { u32x4 pw_; pw_.x = pk2(PX[B + 0], PX[B + 1]); pw_.y = pk2(PX[B + 2], PX[B + 3]); pw_.z = pk2(PX[B + 4], PX[B + 5]); pw_.w = pk2(PX[B + 6], PX[B + 7]); \
        const bf16x8 pf_ = __builtin_bit_cast(bf16x8, pw_); \
        {   const s16x4 lo_ = __builtin_bit_cast(s16x4, __builtin_amdgcn_ds_read_tr16_b64_v4i16((LAS v4i16_t*)(Vb_ + (16 * (c)) * 96))), h4_ = __builtin_bit_cast(s16x4, __builtin_amdgcn_ds_read_tr16_b64_v4i16((LAS v4i16_t*)(Vb_ + (16 * (c) + 8) * 96))); \
            const bf16x8 vf_ = (bf16x8){lo_[0], lo_[1], lo_[2], lo_[3], h4_[0], h4_[1], h4_[2], h4_[3]}; \
            o0 = __builtin_amdgcn_mfma_f32_32x32x16_bf16(vf_, pf_, o0, 0, 0, 0); } \
        {   const s16x4 lo_ = __builtin_bit_cast(s16x4, __builtin_amdgcn_ds_read_tr16_b64_v4i16((LAS v4i16_t*)(Vb_ + (16 * (c)) * 96 + 32))), h4_ = __builtin_bit_cast(s16x4, __builtin_amdgcn_ds_read_tr16_b64_v4i16((LAS v4i16_t*)(Vb_ + (16 * (c) + 8) * 96 + 32))); \
            const bf16x8 vf_ = (bf16x8){lo_[0], lo_[1], lo_[2], lo_[3], h4_[0], h4_[1], h4_[2], h4_[3]}; \
            o1 = __builtin_amdgcn_mfma_f32_32x32x16_bf16(vf_, pf_, o1, 0, 0, 0); } } while (0)
#define AT_TOFF(t) ((t) ? (long)(t) * 64 * 4096 : k0off)
#define AT_COFF(t) ((t) ? (long)(t) * 64 * 16 : c0off)
#define AT_STEP(i, PC0, PC1, PN0, PN1) do { const int i_ = (i), t_ = NT - 1 - i_; \
        if (t_ >= 2) { kreg = *(const u32x4*)(kg + AT_TOFF(t_ - 2)); if (tid < 64) creg = cgp[AT_COFF(t_ - 2)]; } \
        if (t_ >= 1) vreg = *(const u32x4*)(vg + AT_TOFF(t_ - 1)); \
        const bool need_next_ = active && (t_ >= 1) && (t_ - 1 <= jmax); \
        if (need_next_) AT_QK(i_ + 1, PN0, PN1); \
        __builtin_amdgcn_sched_barrier(0); \
        if (active && t_ <= jmax) { \
            const LAS bf16_t* Vb_ = Vs + (i_ & 1) * 6144 + vrd; \
            if (64 * t_ + 63 > qw0 || t_ == 0) { const int qpos_ = qw0 + r32; \
                _Pragma("unroll") for (int r = 0; r < 16; ++r) { const int kv_ = 64 * t_ + (r & 3) + 8 * (r >> 2) + 4 * hi; if (kv_ > qpos_ || kv_ < 48) PC0[r] = -INFINITY; if (kv_ + 32 > qpos_ || kv_ + 32 < 48) PC1[r] = -INFINITY; } } \
            float mxa_ = __builtin_fmaxf(__builtin_fmaxf(PC0[0], PC0[1]), PC1[0]), mxb_ = __builtin_fmaxf(__builtin_fmaxf(PC0[2], PC0[3]), PC1[1]); mxa_ = __builtin_fmaxf(__builtin_fmaxf(mxa_, PC1[2]), PC1[3]); \
            _Pragma("unroll") for (int r = 4; r < 16; r += 4) { mxa_ = __builtin_fmaxf(__builtin_fmaxf(mxa_, PC0[r]), PC0[r + 1]); mxb_ = __builtin_fmaxf(__builtin_fmaxf(mxb_, PC0[r + 2]), PC0[r + 3]); \
                mxa_ = __builtin_fmaxf(__builtin_fmaxf(mxa_, PC1[r]), PC1[r + 1]); mxb_ = __builtin_fmaxf(__builtin_fmaxf(mxb_, PC1[r + 2]), PC1[r + 3]); } \
            float mx_ = xhalf_max(__builtin_fmaxf(mxa_, mxb_)); \
              \
              \
            const bool first_ = (t_ == tfirst); \
            if (first_ || __any(mx_ > -30.f)) { \
            if (first_ || __any(mx_ > 8.f)) { const float dl_ = first_ ? ((mx_ > -1e30f) ? mx_ : 0.f) : fmaxf(mx_, 0.f); m_run += dl_; const float alpha_ = __builtin_amdgcn_exp2f(-dl_); l_run *= alpha_; \
                _Pragma("unroll") for (int r = 0; r < 16; ++r) { PC0[r] -= dl_; PC1[r] -= dl_; o0[r] *= alpha_; o1[r] *= alpha_; } \
                if (need_next_) { _Pragma("unroll") for (int r = 0; r < 16; ++r) { PN0[r] -= dl_; PN1[r] -= dl_; } } } \
            float sa_ = 0.f, sb_ = 0.f, sc_ = 0.f, sd_ = 0.f; \
            _Pragma("unroll") for (int r = 0; r < 16; r += 2) { PC0[r] = __builtin_amdgcn_exp2f(PC0[r]); PC1[r] = __builtin_amdgcn_exp2f(PC1[r]); PC0[r + 1] = __builtin_amdgcn_exp2f(PC0[r + 1]); PC1[r + 1] = __builtin_amdgcn_exp2f(PC1[r + 1]); \
                sa_ += PC0[r]; sb_ += PC1[r]; sc_ += PC0[r + 1]; sd_ += PC1[r + 1]; } \
            l_run += (sa_ + sb_) + (sc_ + sd_); \
            AT_PV(0, PC0, 0); AT_PV(1, PC0, 8); AT_PV(2, PC1, 0); AT_PV(3, PC1, 8); } } \
        if (t_ >= 2) AT_STORE_K(i_ & 1, kreg, creg); \
        if (t_ >= 1) AT_STORE_V((i_ + 1) & 1, vreg); \
        AT_BAR(); } while (0)
    for (;;) {
        if (tid == 0) *uslot = __hip_atomic_fetch_add(qctr, 1u, __ATOMIC_RELAXED, __HIP_MEMORY_SCOPE_AGENT);
        __syncthreads();
        const int u = (int)*uslot;
        if (u >= 1152) break;
        const bool metau = u >= 1024;
        const int qb = metau ? 0 : 7 - u / 128, bh = metau ? u - 1024 : u % 128, b = bh >> 4, h = bh & 15;
        const int q0 = metau ? 48 : 64 + qb * 256;
        const int NT = metau ? 1 : 5 + 4 * qb;
        const int qw0 = q0 + 32 * wid;
        const bool active = metau ? (wid == 0) : true;
        const int jmax = (qw0 + 31) >> 6;
        const int tfirst = (jmax < NT - 1) ? jmax : NT - 1;
        const size_t rowb = (size_t)b * LP;
        bf16x8 qr[4];
#pragma unroll
        for (int d0 = 0; d0 < 4; ++d0) qr[d0] = active ? *(const bf16x8*)(P + (rowb + qw0 - 48 + r32) * 4096 + h * 64 + d0 * 16 + hi * 8) : (bf16x8){0, 0, 0, 0, 0, 0, 0, 0};
        const long krow0 = (long)rowb + kr - 48, crow0 = (long)rowb + (tid & 63) - 48;
        const bf16_t* kg = P + krow0 * 4096 + 1024 + h * 64 + kc * 8;
        const bf16_t* vg = kg + 1024;
        const float* cgp = CUM + crow0 * 16 + h;
        const long k0off = (kr < 48) ? (long)(48 - kr) * 4096 : 0, c0off = ((tid & 63) < 48) ? (long)(48 - (tid & 63)) * 16 : 0;
        u32x4 kreg = (u32x4){0u, 0u, 0u, 0u}, vreg = kreg; float creg = 0.f;
        {   const u32x4 k0 = *(const u32x4*)(kg + AT_TOFF(NT - 1)), v0 = *(const u32x4*)(vg + AT_TOFF(NT - 1)); u32x4 k1 = k0; float c0 = 0.f, c1 = 0.f;
            if (NT >= 2) k1 = *(const u32x4*)(kg + AT_TOFF(NT - 2));
            if (tid < 64) { c0 = cgp[AT_COFF(NT - 1)]; if (NT >= 2) c1 = cgp[AT_COFF(NT - 2)]; }
            AT_STORE_K(0, k0, c0); AT_STORE_K(1, k1, c1); AT_STORE_V(0, v0); }
        AT_BAR();
        float m_run = 0.f, l_run = 0.f;
        f32x16 o0, o1, pa0, pa1, pb0, pb1;
#pragma unroll
        for (int r = 0; r < 16; ++r) { o0[r] = 0.f; o1[r] = 0.f; pa0[r] = 0.f; pa1[r] = 0.f; pb0[r] = 0.f; pb1[r] = 0.f; }
        if (active && NT - 1 <= jmax) AT_QK(0, pa0, pa1);
        for (int j = 0; j < NT; j += 2) {
            AT_STEP(j, pa0, pa1, pb0, pb1);
            if (j + 1 < NT) AT_STEP(j + 1, pb0, pb1, pa0, pa1);
        }
        if (active) {
            const float l = xhalf_sum(l_run); const float inv = 1.f / l;
            const size_t row = rowb + qw0 - 48 + r32;
            if (!metau || r32 < 16) {
#pragma unroll
            for (int dh = 0; dh < 2; ++dh)
#pragma unroll
                for (int i = 0; i < 4; ++i) {
                    const int dcol = h * 64 + 32 * dh + 8 * i + 4 * hi;
                    const u32x2 gw_ = *(const u32x2*)(P + row * 4096 + 3072 + dcol);
                    const float g0 = bflo(gw_.x), g1 = bfhi(gw_.x), g2 = bflo(gw_.y), g3 = bfhi(gw_.y);
                    const float a0 = (dh ? o1[4 * i + 0] : o0[4 * i + 0]) * inv, a1 = (dh ? o1[4 * i + 1] : o0[4 * i + 1]) * inv, a2 = (dh ? o1[4 * i + 2] : o0[4 * i + 2]) * inv, a3 = (dh ? o1[4 * i + 3] : o0[4 * i + 3]) * inv;
                    u32x2 w; w.x = pk2(a0 * g0 * sigmoidf_(g0), a1 * g1 * sigmoidf_(g1)); w.y = pk2(a2 * g2 * sigmoidf_(g2), a3 * g3 * sigmoidf_(g3));
                    *(u32x2*)(OG + row * 1024 + dcol) = w;
                }
            }
        }
    }
#undef AT_BAR
#undef AT_STORE_K
#undef AT_STORE_V
#undef AT_QK
#undef AT_PV
#undef AT_STEP
#undef AT_TOFF
#undef AT_COFF
}

__device__ __forceinline__ void phase_lora_prep(const Params& p, int jr) {
    const int tid = opaque_tid(); const int gt = BID * 512 + tid, NTH = GRD * 512;
    const bf16_t* PL = (const bf16_t*)(p.ws + WS_PL);
    bf16_t* A = (bf16_t*)(p.ws + WS_WIN); bf16_t* Bt = (bf16_t*)(p.ws + WS_CUM);
    const float* mu = p.rwkv_mu + (size_t)jr * RWKV_IN + 4096;
    const float* w_up = p.rwkv_w_up + (size_t)jr * 64 * 1024; const float* a_up = p.rwkv_a_up + (size_t)jr * 64 * 1024;
    for (int it = gt; it < MROWS * 32; it += NTH) {
        const int row = it >> 5, cg8 = it & 31;
        u32x4 o = (u32x4){0u, 0u, 0u, 0u};
        if (cg8 < 16) {
            const int tpos = row % LP;
            const u32x4 cw = *(const u32x4*)(PL + (size_t)row * 256 + 8 * cg8);
            u32x4 pw = (u32x4){0u, 0u, 0u, 0u}; if (tpos > 0) pw = *(const u32x4*)(PL + (size_t)(row - 1) * 256 + 8 * cg8);
            const f32x4 m0 = *(const f32x4*)(mu + 8 * cg8), m1 = *(const f32x4*)(mu + 8 * cg8 + 4);
            float v[8];
            v[0] = bflo(cw.x) + (bflo(pw.x) - bflo(cw.x)) * m0[0]; v[1] = bfhi(cw.x) + (bfhi(pw.x) - bfhi(cw.x)) * m0[1];
            v[2] = bflo(cw.y) + (bflo(pw.y) - bflo(cw.y)) * m0[2]; v[3] = bfhi(cw.y) + (bfhi(pw.y) - bfhi(cw.y)) * m0[3];
            v[4] = bflo(cw.z) + (bflo(pw.z) - bflo(cw.z)) * m1[0]; v[5] = bfhi(cw.z) + (bfhi(pw.z) - bfhi(cw.z)) * m1[1];
            v[6] = bflo(cw.w) + (bflo(pw.w) - bflo(cw.w)) * m1[2]; v[7] = bfhi(cw.w) + (bfhi(pw.w) - bfhi(cw.w)) * m1[3];
            if (cg8 < 8) {
#pragma unroll
                for (int e = 0; e < 8; ++e) v[e] = tanhf(v[e]);
            }
            o.x = pk2(v[0], v[1]); o.y = pk2(v[2], v[3]); o.z = pk2(v[4], v[5]); o.w = pk2(v[6], v[7]);
        }
        if (cg8 == 16) o.x = 0x3F803F80u;
        *(u32x4*)(A + (size_t)row * 256 + 8 * cg8) = o;
    }
    for (int it = gt; it < 2048 * 32; it += NTH) {
        const int n = it & 2047, kg = it >> 11;
        u32x4 o = (u32x4){0u, 0u, 0u, 0u};
        const float* src = nullptr;
        if (n < 1024 && kg < 8) src = w_up + (size_t)(8 * kg) * 1024 + n;
        else if (n >= 1024 && kg >= 8 && kg < 16) src = a_up + (size_t)(8 * (kg - 8)) * 1024 + (n - 1024);
        if (src) { o.x = pk2(src[0], src[1024]); o.y = pk2(src[2048], src[3072]); o.z = pk2(src[4096], src[5120]); o.w = pk2(src[6144], src[7168]); }
        if (kg == 16) { const float bz = (n < 1024) ? p.rwkv_w0[jr * 1024 + n] : p.rwkv_a0[jr * 1024 + n - 1024]; const float bh = bfhi(pk2(0.f, bz)); o.x = pk2(bh, bz - bh); }
        *(u32x4*)(Bt + (size_t)n * 256 + 8 * kg) = o;
    }
}

__device__ __forceinline__ void phase_scan(const Params& p, LAS unsigned char* lds, int jr) {
    const int tid = opaque_tid(), lane = tid & 63, wid = __builtin_amdgcn_readfirstlane(tid >> 6);
    LAS float* vec = (LAS float*)lds;
    LAS float* ypart = vec + 2 * 6144;
    const bf16_t* P = (const bf16_t*)(p.ws + WS_C);
    const bf16_t* LD = (const bf16_t*)(p.ws + WS_LD); const bf16_t* AA = (const bf16_t*)(p.ws + WS_AA);
    bf16_t* Y = (bf16_t*)(p.ws + WS_B);
    constexpr int NCH = 129;
    const int ht = tid & 255, ds = ht >> 4, kq = lane & 15, rl = lane >> 4;
    for (int u = BID; u < 256; u += GRD) {
        const int bh = u >> 1, half = u & 1, b = bh >> 4, h = bh & 15;
        const int kcol = h * 64 + 4 * kq;
        const float* mu = p.rwkv_mu + (size_t)jr * RWKV_IN;
        f32x4 mur, muk, muv, kk4, ka4, rk4;
        float* BON = (float*)(p.ws + WS_CUM);
        u32x2 rw, kw, vw, rp, kp_, vp, lw, lwp, aw; size_t drow = 0;
        if (wid >= 4) { mur = *(const f32x4*)(mu + kcol); muk = *(const f32x4*)(mu + 1024 + kcol); muv = *(const f32x4*)(mu + 2048 + kcol);
            kk4 = *(const f32x4*)(p.rwkv_k_k + jr * 1024 + kcol); ka4 = *(const f32x4*)(p.rwkv_k_a + jr * 1024 + kcol); rk4 = *(const f32x4*)(p.rwkv_r_k + jr * 1024 + kcol); }
#define SC_LOADRAW(ch) do { const int t_ = (ch) * 16 + ds; const size_t row_ = (size_t)b * LP + t_; drow = row_; const bf16_t* pr_ = P + row_ * 4096 + kcol; \
        rw = *(const u32x2*)pr_; kw = *(const u32x2*)(pr_ + 1024); vw = *(const u32x2*)(pr_ + 2048); \
        rp = (u32x2){0u, 0u}; kp_ = rp; vp = rp; lwp = rp; \
        if (ds > 0) lwp = *(const u32x2*)(LD + (row_ - 1) * 1024 + kcol); \
        if (t_ > 0) { rp = *(const u32x2*)(pr_ - 4096); kp_ = *(const u32x2*)(pr_ - 4096 + 1024); vp = *(const u32x2*)(pr_ - 4096 + 2048); } \
        lw = *(const u32x2*)(LD + row_ * 1024 + kcol); aw = *(const u32x2*)(AA + row_ * 1024 + kcol); } while (0)
#define SC_DERIVE(buf) do { \
        const f32x4 rc = {bflo(rw.x), bfhi(rw.x), bflo(rw.y), bfhi(rw.y)}, kc_ = {bflo(kw.x), bfhi(kw.x), bflo(kw.y), bfhi(kw.y)}, vc = {bflo(vw.x), bfhi(vw.x), bflo(vw.y), bfhi(vw.y)}; \
        const f32x4 rpv = {bflo(rp.x), bfhi(rp.x), bflo(rp.y), bfhi(rp.y)}, kpv = {bflo(kp_.x), bfhi(kp_.x), bflo(kp_.y), bfhi(kp_.y)}, vpv = {bflo(vp.x), bfhi(vp.x), bflo(vp.y), bfhi(vp.y)}; \
        const unsigned lx_ = lw.x, ly_ = lw.y, qx_ = lwp.x, qy_ = lwp.y;        \
        const pg8::f16x2_t l0_ = __builtin_bit_cast(pg8::f16x2_t, lx_), l1_ = __builtin_bit_cast(pg8::f16x2_t, ly_), q0_ = __builtin_bit_cast(pg8::f16x2_t, qx_), q1_ = __builtin_bit_cast(pg8::f16x2_t, qy_); \
        const f32x4 ldv = {(float)l0_[0], (float)l0_[1], (float)l1_[0], (float)l1_[1]}, ldp = {(float)q0_[0], (float)q0_[1], (float)q1_[0], (float)q1_[1]}, av = {bflo(aw.x), bfhi(aw.x), bflo(aw.y), bfhi(aw.y)}; \
        const f32x4 rlp = rc + (rpv - rc) * mur, klp = kc_ + (kpv - kc_) * muk, vlp = vc + (vpv - vc) * muv; \
        const f32x4 kkv = klp * kk4; \
        float ss = (kkv[0] * kkv[0] + kkv[1] * kkv[1]) + (kkv[2] * kkv[2] + kkv[3] * kkv[3]); \
        ss = red16(ss); \
        const float inv = __builtin_amdgcn_rsqf(fmaxf(ss, 1e-24f));        \
        const f32x4 kkn = kkv * inv; \
        const f32x4 kpr = klp * (1.f + (av - 1.f) * ka4); \
        { const f32x4 bt_ = rlp * kpr * rk4; const float bs_ = red16((bt_[0] + bt_[1]) + (bt_[2] + bt_[3])); if (half == 0 && kq == 0) BON[drow * 16 + h] = bs_; } \
        f32x4 wv, iw, wp; \
        _Pragma("unroll") for (int e_ = 0; e_ < 4; ++e_) { wv[e_] = __builtin_amdgcn_exp2f(ldv[e_]); iw[e_] = __builtin_amdgcn_exp2f(-ldv[e_]); wp[e_] = __builtin_amdgcn_exp2f(ldp[e_]); }     \
        LAS float* vs = vec + (buf) * 6144 + ds * 384 + 4 * kq; \
        *(LAS f32x4*)(vs) = wv; *(LAS f32x4*)(vs + 64) = -kkn * wp; *(LAS f32x4*)(vs + 128) = kkn * av * iw; *(LAS f32x4*)(vs + 192) = kpr * iw; *(LAS f32x4*)(vs + 256) = rlp * wv; *(LAS f32x4*)(vs + 320) = vlp; } while (0)
#define SC_YREDUCE(chunk, buf) do { float pa_ = 0.f, pb_ = 0.f; \
        _Pragma("unroll") for (int j_ = 0; j_ < 8; ++j_) { \
            const f32x4 x_ = *(const LAS f32x4*)(ypart + (buf) * 8192 + j_ * 1024 + (ht & ~15) * 4 + (((ht & 15) + 2 * j_) & 15) * 4); \
            pa_ += x_[0] + x_[2]; pb_ += x_[1] + x_[3]; } \
        { const int s_ = ht >> 4, cw_ = (ht >> 2) & 3, rl_ = ht & 3; \
          *(unsigned*)(Y + ((size_t)b * LP + (chunk) * 16 + s_) * 1024 + h * 64 + 32 * half + 8 * cw_ + 2 * rl_) = pk2(pa_, pb_); } } while (0)
        if (wid >= 4) { SC_LOADRAW(0); SC_DERIVE(0); SC_LOADRAW(1); }
        __syncthreads();
        float SA0 = 0.f, SA1 = 0.f, SA2 = 0.f, SA3 = 0.f, SB0 = 0.f, SB1 = 0.f, SB2 = 0.f, SB3 = 0.f;
        for (int ch = 0; ch < NCH; ++ch) {
            const int buf = ch & 1;
            if (wid < 4) {
                const LAS float* vb = vec + buf * 6144 + 4 * kq;
                const LAS float* vvp = vec + buf * 6144 + 320 + 32 * half + 8 * wid + 2 * rl;
                LAS float* yp = ypart + buf * 8192 + (kq >> 1) * 1024 + ((wid * 4 + rl + 2 * (kq >> 1)) & 15) * 4 + 2 * (kq & 1);
                const f32x4 wend = *(const LAS f32x4*)(vb + 15 * 384);
                f32x4 a4 = *(const LAS f32x4*)(vb + 64), b4 = *(const LAS f32x4*)(vb + 128), k4 = *(const LAS f32x4*)(vb + 192), r4 = *(const LAS f32x4*)(vb + 256);
                f32x2 vv = *(const LAS f32x2*)(vvp);
#pragma unroll
                for (int s = 0; s < 16; ++s) {
                    f32x4 na = a4, nb = b4, nk = k4, nr = r4; f32x2 nv = vv;
                    if (s < 15) { na = *(const LAS f32x4*)(vb + (s + 1) * 384 + 64); nb = *(const LAS f32x4*)(vb + (s + 1) * 384 + 128);
                        nk = *(const LAS f32x4*)(vb + (s + 1) * 384 + 192); nr = *(const LAS f32x4*)(vb + (s + 1) * 384 + 256); nv = *(const LAS f32x2*)(vvp + (s + 1) * 384); }
                    float saA, saB, yA, yB;
#define SC_DPP(r, c) "v_add_f32_dpp " r ", " r ", " r " " c " row_mask:0xf bank_mask:0xf bound_ctrl:1\n\t"
                    asm("v_mul_f32 %0, %2, %10\n\tv_mul_f32 %1, %6, %10\n\tv_fmac_f32 %0, %3, %11\n\tv_fmac_f32 %1, %7, %11\n\t"
                        "v_fmac_f32 %0, %4, %12\n\tv_fmac_f32 %1, %8, %12\n\tv_fmac_f32 %0, %5, %13\n\tv_fmac_f32 %1, %9, %13\n\t"
                        "v_fmac_f32 %2, %18, %14\n\tv_fmac_f32 %6, %19, %14\n\t"
                        SC_DPP("%0", "quad_perm:[1,0,3,2]") SC_DPP("%1", "quad_perm:[1,0,3,2]")
                        "v_fmac_f32 %3, %18, %15\n\tv_fmac_f32 %7, %19, %15\n\t"
                        SC_DPP("%0", "quad_perm:[2,3,0,1]") SC_DPP("%1", "quad_perm:[2,3,0,1]")
                        "v_fmac_f32 %4, %18, %16\n\tv_fmac_f32 %8, %19, %16\n\t"
                        SC_DPP("%0", "row_half_mirror") SC_DPP("%1", "row_half_mirror")
                        "v_fmac_f32 %5, %18, %17\n\tv_fmac_f32 %9, %19, %17\n\t"
                        SC_DPP("%0", "row_mirror") SC_DPP("%1", "row_mirror")
                        : "=&v"(saA), "=&v"(saB), "+v"(SA0), "+v"(SA1), "+v"(SA2), "+v"(SA3), "+v"(SB0), "+v"(SB1), "+v"(SB2), "+v"(SB3)
                        : "v"(a4[0]), "v"(a4[1]), "v"(a4[2]), "v"(a4[3]), "v"(k4[0]), "v"(k4[1]), "v"(k4[2]), "v"(k4[3]), "v"(vv[0]), "v"(vv[1]));
                    asm("v_fmac_f32 %0, %10, %12\n\tv_fmac_f32 %4, %11, %12\n\tv_fmac_f32 %1, %10, %13\n\tv_fmac_f32 %5, %11, %13\n\t"
                        "v_fmac_f32 %2, %10, %14\n\tv_fmac_f32 %6, %11, %14\n\tv_fmac_f32 %3, %10, %15\n\tv_fmac_f32 %7, %11, %15\n\t"
                        "v_mul_f32 %8, %0, %16\n\tv_mul_f32 %9, %4, %16\n\tv_fmac_f32 %8, %1, %17\n\tv_fmac_f32 %9, %5, %17\n\t"
                        "v_fmac_f32 %8, %2, %18\n\tv_fmac_f32 %9, %6, %18\n\tv_fmac_f32 %8, %3, %19\n\tv_fmac_f32 %9, %7, %19"
                        : "+v"(SA0), "+v"(SA1), "+v"(SA2), "+v"(SA3), "+v"(SB0), "+v"(SB1), "+v"(SB2), "+v"(SB3), "=&v"(yA), "=&v"(yB)
                        : "v"(saA), "v"(saB), "v"(b4[0]), "v"(b4[1]), "v"(b4[2]), "v"(b4[3]), "v"(r4[0]), "v"(r4[1]), "v"(r4[2]), "v"(r4[3]));
#undef SC_DPP
                    *(LAS f32x2*)(yp + s * 64) = (f32x2){yA, yB};
                    a4 = na; b4 = nb; k4 = nk; r4 = nr; vv = nv;
                }
                {
                    SA0 *= wend[0]; SA1 *= wend[1]; SA2 *= wend[2]; SA3 *= wend[3]; SB0 *= wend[0]; SB1 *= wend[1]; SB2 *= wend[2]; SB3 *= wend[3]; }
            } else {
                if (ch + 1 < NCH) SC_DERIVE(buf ^ 1);
                if (ch + 2 < NCH) SC_LOADRAW(ch + 2);
                if (ch > 0) SC_YREDUCE(ch - 1, buf ^ 1);
            }
            asm volatile("s_waitcnt lgkmcnt(0)" ::: "memory"); __builtin_amdgcn_s_barrier(); asm volatile("" ::: "memory");
        }
        if (wid >= 4) SC_YREDUCE(NCH - 1, (NCH - 1) & 1);
        __syncthreads();
#undef SC_LOADRAW
#undef SC_DERIVE
#undef SC_YREDUCE
    }
}

__device__ __forceinline__ void phase_r4(const Params& p, int jr) {
    const int tid = opaque_tid(), lane = tid & 63, wave = __builtin_amdgcn_readfirstlane(tid >> 6);
    const int gw = BID * 8 + wave, NGW = GRD * 8;
    const bf16_t* P = (const bf16_t*)(p.ws + WS_C); const bf16_t* Y = (const bf16_t*)(p.ws + WS_B);
    const float* BON = (const float*)(p.ws + WS_CUM);
    bf16_t* YG = (bf16_t*)(p.ws + WS_LD);
    const float* mu = p.rwkv_mu + (size_t)jr * RWKV_IN;
    for (int it = gw; it < 2048; it += NGW) {
        const int tile = it >> 2, q = it & 3, c = 256 * q + 4 * lane, hd = 4 * q + (lane >> 4);
        const f32x4 muv = *(const f32x4*)(mu + 2048 + c), mug = *(const f32x4*)(mu + 3072 + c);
        const f32x4 lnw = *(const f32x4*)(p.rwkv_ln_w + jr * 1024 + c), lnb = *(const f32x4*)(p.rwkv_ln_b + jr * 1024 + c);
        const int m0 = tile * 33;
        f32x4 vp = {0.f, 0.f, 0.f, 0.f}, gp = vp;
        if (m0 % LP != 0) { const bf16_t* pr = P + (size_t)(m0 - 1) * 4096 + c;
            const u32x2 c2 = *(const u32x2*)(pr + 2048), d2 = *(const u32x2*)(pr + 3072);
            vp = (f32x4){bflo(c2.x), bfhi(c2.x), bflo(c2.y), bfhi(c2.y)}; gp = (f32x4){bflo(d2.x), bfhi(d2.x), bflo(d2.y), bfhi(d2.y)}; }
        u32x2 c2a, d2a, ywa, c2b, d2b, ywb, c2c, d2c, ywc; float bona, bonb, bonc;
#define R4_LOAD(C2, D2, YW, BN, i_) do { const size_t rr_ = (size_t)(m0 + ((i_) < 33 ? (i_) : 32)); const bf16_t* pr_ = P + rr_ * 4096 + c; \
        C2 = *(const u32x2*)(pr_ + 2048); D2 = *(const u32x2*)(pr_ + 3072); YW = *(const u32x2*)(Y + rr_ * 1024 + c); BN = BON[rr_ * 16 + hd]; } while (0)
#define R4_COMP(C2, D2, YW, BN, i_) do { const size_t row = (size_t)(m0 + (i_)); \
        const f32x4 vc = {bflo(C2.x), bfhi(C2.x), bflo(C2.y), bfhi(C2.y)}, gc = {bflo(D2.x), bfhi(D2.x), bflo(D2.y), bfhi(D2.y)}; \
        const f32x4 yv = {bflo(YW.x), bfhi(YW.x), bflo(YW.y), bfhi(YW.y)}; \
        const f32x4 vl = vc + (vp - vc) * muv, gl = gc + (gp - gc) * mug; \
        vp = vc; gp = gc; \
        const float mean = red16((yv[0] + yv[1]) + (yv[2] + yv[3])) * (1.f / 64.f); \
        const f32x4 d = yv - mean; \
        const float var = red16((d[0] * d[0] + d[1] * d[1]) + (d[2] * d[2] + d[3] * d[3])) * (1.f / 64.f); \
        const float rstd = __builtin_amdgcn_rsqf(var + GN_EPS); \
        const f32x4 o = (d * rstd * lnw + lnb) + BN * vl; \
        u32x2 w; w.x = pk2(o[0] * gl[0] * sigmoidf_(gl[0]), o[1] * gl[1] * sigmoidf_(gl[1])); w.y = pk2(o[2] * gl[2] * sigmoidf_(gl[2]), o[3] * gl[3] * sigmoidf_(gl[3])); \
        *(u32x2*)(YG + row * 1024 + c) = w; } while (0)
        R4_LOAD(c2a, d2a, ywa, bona, 0); R4_LOAD(c2b, d2b, ywb, bonb, 1);
#pragma unroll 1
        for (int i = 0; i < 33; i += 3) {
            R4_LOAD(c2c, d2c, ywc, bonc, i + 2); R4_COMP(c2a, d2a, ywa, bona, i);
            R4_LOAD(c2a, d2a, ywa, bona, i + 3); R4_COMP(c2b, d2b, ywb, bonb, i + 1);
            R4_LOAD(c2b, d2b, ywb, bonb, i + 4); R4_COMP(c2c, d2c, ywc, bonc, i + 2);
        }
#undef R4_LOAD
#undef R4_COMP
    }
}

__device__ __forceinline__ void mini_gemm_tail(const bf16_t* A, const bf16_t* Wt, bf16_t* O, LAS unsigned char* lds) {
    const int tid = opaque_tid(), lane = tid & 63, w = tid >> 6, wr = w >> 2, wc = w & 3;
    LAS bf16_t* As = (LAS bf16_t*)lds;
    LAS bf16_t* Bs = As + 32 * 520;
    for (int t = BID; t < 256; t += GRD) {
        const int r0 = 16384 + 32 * (t >> 4), c0 = 64 * (t & 15);
        u32x4 stg[12];
#define MT_LOAD(h) do { _Pragma("unroll") for (int j_ = 0; j_ < 12; ++j_) { const int c_ = tid + 512 * j_; \
            const bf16_t* src_ = (c_ < 2048) ? A + (size_t)(r0 + (c_ >> 6)) * 1024 + 512 * (h) + 8 * (c_ & 63) : Wt + (size_t)(c0 + ((c_ - 2048) >> 6)) * 1024 + 512 * (h) + 8 * (c_ & 63); \
            stg[j_] = *(const u32x4*)src_; } } while (0)
#define MT_STORE() do { _Pragma("unroll") for (int j_ = 0; j_ < 12; ++j_) { const int c_ = tid + 512 * j_; \
            LAS bf16_t* dst_ = (c_ < 2048) ? As + (c_ >> 6) * 520 + 8 * (c_ & 63) : Bs + ((c_ - 2048) >> 6) * 520 + 8 * (c_ & 63); \
            *(LAS u32x4*)dst_ = stg[j_]; } } while (0)
        f32x4 acc = {0.f, 0.f, 0.f, 0.f};
        const LAS bf16_t* ap = As + (16 * wr + (lane & 15)) * 520 + 8 * (lane >> 4);
        const LAS bf16_t* bp = Bs + (16 * wc + (lane & 15)) * 520 + 8 * (lane >> 4);
        MT_LOAD(0); MT_STORE(); __syncthreads();
        MT_LOAD(1);
#pragma unroll
        for (int k = 0; k < 16; ++k) { const bf16x8 a = *(const LAS bf16x8*)(ap + 32 * k), b = *(const LAS bf16x8*)(bp + 32 * k); acc = __builtin_amdgcn_mfma_f32_16x16x32_bf16(a, b, acc, 0, 0, 0); }
        __syncthreads();
        MT_STORE(); __syncthreads();
#pragma unroll
        for (int k = 0; k < 16; ++k) { const bf16x8 a = *(const LAS bf16x8*)(ap + 32 * k), b = *(const LAS bf16x8*)(bp + 32 * k); acc = __builtin_amdgcn_mfma_f32_16x16x32_bf16(a, b, acc, 0, 0, 0); }
        __syncthreads();
#undef MT_LOAD
#undef MT_STORE
        bf16_t* op = O + (size_t)(r0 + 16 * wr + 4 * (lane >> 4)) * 1024 + c0 + 16 * wc + (lane & 15);
#pragma unroll
        for (int r = 0; r < 4; ++r) op[(size_t)r * 1024] = (bf16_t)(pk2(acc[r], 0.f) & 0xffffu);
    }
}

#define XB_TMO      128
#define XB_XCNT(j)  (256  + 64 * (j))
#define XB_XSUB(j)  (1280 + 64 * (j))
#define XB_XGEN(j)  (2304 + 64 * (j))
#define XB_TOP      3328
#define XB_TOPGEN   3392
#define XCD_BAR_WORDS 3456
#define XB_SPIN_CAP (1u << 18)

__device__ __forceinline__ unsigned xb_ld(unsigned* p)              { return __hip_atomic_load(p, __ATOMIC_RELAXED, __HIP_MEMORY_SCOPE_AGENT); }
__device__ __forceinline__ unsigned xb_add(unsigned* p, unsigned v) { return __hip_atomic_fetch_add(p, v, __ATOMIC_RELAXED, __HIP_MEMORY_SCOPE_AGENT); }
__device__ __forceinline__ unsigned xb_xcc_id() { return (unsigned)__builtin_amdgcn_s_getreg((3 << 11) | 20) & 0xFu; }
#define XB_SPIN(cond, bar) do { unsigned _sp = 0; while (cond) { __builtin_amdgcn_s_sleep(1); \
    if ((++_sp & 255u) == 0u) { if (xb_ld(&(bar)[XB_TMO])) break; if (_sp > XB_SPIN_CAP) { atomicAdd(&(bar)[XB_TMO], 1u); break; } } } } while (0)

struct XcdBarrier {
    unsigned* bar; unsigned x;
    volatile LAS unsigned* st;
};

__device__ __forceinline__ XcdBarrier xcd_barrier_post(unsigned* bar, volatile LAS unsigned* st) {
    XcdBarrier b; b.bar = bar; b.x = xb_xcc_id(); b.st = st;
    if (threadIdx.x == 0) (void)xb_add(&bar[XB_XCNT(b.x)], 1u);
    return b;
}
__device__ __forceinline__ void xcd_barrier_complete(unsigned* bar, unsigned x, unsigned& nloc, unsigned& nx) {
    const unsigned G = gridDim.x * gridDim.y * gridDim.z;
    unsigned sum, cnt, mine, sp = 0u;
    for (;;) {
        sum = 0u; cnt = 0u; mine = 0u;
#pragma unroll
        for (unsigned j = 0; j < 16; ++j) { const unsigned c = xb_ld(&bar[XB_XCNT(j)]); sum += c; cnt += (c > 0u) ? 1u : 0u; mine = (j == x) ? c : mine; }
        if (sum == G) break;
        __builtin_amdgcn_s_sleep(1);
        if ((++sp & 255u) == 0u) { if (xb_ld(&bar[XB_TMO])) break; if (sp > XB_SPIN_CAP) { atomicAdd(&bar[XB_TMO], 1u); break; } }
    }
    nloc = mine > 0u ? mine : 1u; nx = cnt > 0u ? cnt : 1u;
}

__device__ __forceinline__ void xcd_barrier(const XcdBarrier& b) {
    asm volatile("s_waitcnt vmcnt(0)" ::: "memory");
    __syncthreads();
    if (threadIdx.x == 0) {
        unsigned* bar = b.bar;
        __builtin_amdgcn_s_waitcnt(0);
        unsigned nloc = b.st[0], nx = b.st[1];
        if (nloc == 0u) { xcd_barrier_complete(bar, b.x, nloc, nx); b.st[0] = nloc; b.st[1] = nx; }
        const unsigned old = xb_add(&bar[XB_XSUB(b.x)], 1u);
        const unsigned gen = old / nloc;
        if (old + 1u == (gen + 1u) * nloc) {
            __builtin_amdgcn_fence(__ATOMIC_RELEASE, "agent");
            asm volatile("s_waitcnt vmcnt(0)" ::: "memory");
            const unsigned og = xb_add(&bar[XB_TOP], 1u);
            const unsigned tg = og / nx;
            if (og + 1u == (tg + 1u) * nx) xb_add(&bar[XB_TOPGEN], 1u);
            else XB_SPIN(xb_ld(&bar[XB_TOPGEN]) == tg, bar);
            __builtin_amdgcn_fence(__ATOMIC_ACQUIRE, "agent");
            xb_add(&bar[XB_XGEN(b.x)], 1u);
            asm volatile("s_waitcnt vmcnt(0)" ::: "memory");
        } else {
            XB_SPIN(xb_ld(&bar[XB_XGEN(b.x)]) == gen, bar);
            __builtin_amdgcn_fence(__ATOMIC_ACQUIRE, "agent");
            asm volatile("s_waitcnt vmcnt(0)" ::: "memory");
        }
    }
    __syncthreads();
}

__global__ void __launch_bounds__(512, 2) fwd_megakernel(Params p) {
    extern __shared__ __attribute__((aligned(16))) unsigned char lds_raw[];
    LAS unsigned char* lds = (LAS unsigned char*)lds_raw;
    cg::grid_group grid = cg::this_grid();
    bf16_t* U = (bf16_t*)(p.ws + WS_B); bf16_t* WIN = (bf16_t*)(p.ws + WS_WIN); bf16_t* WOUT = (bf16_t*)(p.ws + WS_WOUT);
    bf16_t* P = (bf16_t*)(p.ws + WS_C); bf16_t* PL = (bf16_t*)(p.ws + WS_PL); float* MB = (float*)(p.ws + WS_C);
    volatile LAS unsigned* st = (volatile LAS unsigned*)(lds + LDS_BYTES - 64);
    if (threadIdx.x < 2) st[threadIdx.x] = 0u;
    __syncthreads();
    XcdBarrier bar = xcd_barrier_post((unsigned*)p.ws + 4096, st);
#define GBAR() do { XcdBarrier bb_ = bar; asm volatile("" : "+s"(bb_.x)); xcd_barrier(bb_); } while (0)
    phase_e<0>(p, lds, 0, -1);
    if (p.out == nullptr) grid.sync();
    GBAR();
#pragma unroll 1
    for (int layer = 0; layer < 4; ++layer) {
        const int jr = layer >> 1; const bool rw = (layer & 1) != 0;
        if (!rw) phase_cumsum(p, lds);
        {   pg8::Gemm g{U, WIN, MROWS, rw ? 4352 : 4096, 1024}; pg8::StaticOrder S; S.init(MROWS, rw ? 4352 : 4096, (int)GRD, (int)BID);
            pg8::EpiP E{P, PL, rw ? 1.f : 0.125f * LOG2E, rw ? 0 : 1024};
            pg8::gemm_phase<pg8::EpiP, pg8::StaticOrder, true, true>(lds, g, S, E); }
        GBAR();
        if (!rw) { phase_attn(p, lds, (unsigned*)p.ws + 8192 + 64 * jr); GBAR(); }
        else { phase_lora_prep(p, jr); GBAR();
            {   int kl_ = 256; asm volatile("" : "+s"(kl_));
                pg8::Gemm g{(const bf16_t*)(p.ws + WS_WIN), (const bf16_t*)(p.ws + WS_CUM), MROWS, 2048, kl_}; pg8::StaticOrder S; S.init(MROWS, 2048, (int)GRD, (int)BID);
                pg8::EpiLora E{(bf16_t*)(p.ws + WS_LD), (bf16_t*)(p.ws + WS_AA)};
                pg8::gemm_phase<pg8::EpiLora, pg8::StaticOrder, true, true>(lds, g, S, E); }
            GBAR(); phase_scan(p, lds, jr); GBAR(); phase_r4(p, jr); GBAR(); }
        {   pg8::Gemm g{rw ? (const bf16_t*)(p.ws + WS_LD) : (const bf16_t*)(p.ws + WS_B), WOUT, 16384, 1024, 1024}; pg8::StaticOrder S; S.init(16384, 1024, (int)GRD, (int)BID);
            pg8::EpiM E{(bf16_t*)MB};
            pg8::gemm_phase<pg8::EpiM, pg8::StaticOrder, true, true>(lds, g, S, E);
            mini_gemm_tail(g.A, WOUT, (bf16_t*)MB, lds); }
        GBAR();
        phase_e<1>(p, lds, layer < 3 ? layer + 1 : -1, layer);
        if (layer < 3) GBAR();
    }
}

extern "C" void kernel_launch(void* const* d_in, const int* in_sizes, int n_in, void* d_out, int out_size, void* d_ws, size_t ws_size, hipStream_t stream) {
    static int grid_blocks = 0;
    if (grid_blocks == 0) {
        if (n_in != 19 || ws_size < WS_END) { fprintf(stderr, "kernel_launch: unexpected inputs (n_in %d, ws %zu)\n", n_in, ws_size); grid_blocks = -1; return; }
        int dev = 0, cus = 0, per_cu = 0;
        hipGetDevice(&dev); hipDeviceGetAttribute(&cus, hipDeviceAttributeMultiprocessorCount, dev);
        if (hipFuncSetAttribute((const void*)fwd_megakernel, hipFuncAttributeMaxDynamicSharedMemorySize, LDS_BYTES) != hipSuccess) { fprintf(stderr, "kernel_launch: hipFuncSetAttribute failed\n"); grid_blocks = -1; return; }
        if (hipOccupancyMaxActiveBlocksPerMultiprocessor(&per_cu, (const void*)fwd_megakernel, 512, LDS_BYTES) != hipSuccess || per_cu < 1) { fprintf(stderr, "kernel_launch: occupancy query failed (%d)\n", per_cu); (void)hipGetLastError(); grid_blocks = -1; return; }
        grid_blocks = cus * (per_cu > 1 ? 1 : per_cu);
    }
    if (grid_blocks < 0) return;
    if (hipMemsetAsync(d_ws, 0, 65536, stream) != hipSuccess) { fprintf(stderr, "kernel_launch: memset failed\n"); return; }
    Params p{};
    const float** f = (const float**)&p;
    for (int i = 0; i < 19; ++i) f[i] = (const float*)d_in[i];
    p.out = (float*)d_out; p.ws = (unsigned char*)d_ws;
    void* args[] = {&p};
    hipError_t e = hipLaunchCooperativeKernel((const void*)fwd_megakernel, dim3(grid_blocks), dim3(512), args, LDS_BYTES, stream);
    if (e != hipSuccess) fprintf(stderr, "cooperative launch failed: %s (grid %d)\n", hipGetErrorString(e), grid_blocks);
}
```

```cpp
#include <hip/hip_runtime.h>
#include <hip/hip_cooperative_groups.h>
#include <cstdio>
#include <cstdint>
namespace cg = cooperative_groups;
__device__ __forceinline__ int opaque_tid() { int t = threadIdx.x; asm volatile("" : "+v"(t)); return t; }
__device__ __forceinline__ int opaque_bid() { int t = blockIdx.x; asm volatile("" : "+s"(t)); return t; }
__device__ __forceinline__ int opaque_grid() { int t = gridDim.x; asm volatile("" : "+s"(t)); return t; }
namespace pg8 {
#define PG8_LAS __attribute__((address_space(3)))
typedef unsigned short bf16_t;
typedef short bf16x8 __attribute__((ext_vector_type(8)));
typedef float f32x4 __attribute__((ext_vector_type(4)));
typedef unsigned u32x4 __attribute__((ext_vector_type(4)));
constexpr int BM = 256, BK = 64, HALF = 128, HTB = HALF * BK * 2  , STAGE_BYTES = 8 * HTB, NXCD = 8, WGM = 8;

__host__ __device__ __forceinline__ int lds_byte(int r, int c) { const int st = (r >> 4) * 2 + (c >> 5), rr = r & 15, cc = c & 31, ob = rr * 64 + cc * 2; return st * 1024 + (ob ^ (((ob >> 9) & 1) << 5)); }
__host__ __device__ __forceinline__ void stage_rc(int b, int& R, int& C) { const int st = b / 1024, sb = b % 1024, swz = sb ^ (((sb >> 9) & 1) << 5); R = (st >> 1) * 16 + swz / 64; C = (st & 1) * 32 + (swz % 64) / 2; }
__host__ __device__ __forceinline__ int perm32(int rho) { const int n = rho >> 4, i = rho & 15; return 8 * (i >> 2) + 4 * n + (i & 3); }

struct Unit { int pm, pn; };
struct Gemm { const bf16_t* A; const bf16_t* Bt; int M, N, K; };

struct StaticOrder {
    int nM, nN, nwg, G, c;
    __host__ __device__ void init(int M, int N, int G_, int c_) { nM = M / BM; nN = N / BM; nwg = nM * nN; G = G_; c = c_; }
    __host__ __device__ bool next(int i, Unit& u) const {
        const long L = (long)i * G + c; if (L >= nwg) return false;
        int wgid = (int)L; { const int q = nwg / NXCD, r = nwg % NXCD, xcd = wgid % NXCD, off = wgid / NXCD; wgid = (xcd < r ? xcd * (q + 1) : r * (q + 1) + (xcd - r) * q) + off; }
        const int nig = WGM * nN, gid = wgid / nig, fm = gid * WGM, gsz = (nM - fm) < WGM ? (nM - fm) : WGM;
        u.pm = fm + ((wgid % nig) % gsz); u.pn = (wgid % nig) / gsz; return true;
    }
    __device__ __forceinline__ void a_ready(const Unit&) const {}
    __device__ __forceinline__ void done(const Unit&) const {}
};

__device__ __forceinline__ unsigned cvt_pk_bf16(float lo, float hi) { unsigned r; asm volatile("v_cvt_pk_bf16_f32 %0, %1, %2" : "=v"(r) : "v"(lo), "v"(hi)); return r; }
typedef float f32x2 __attribute__((ext_vector_type(2)));
typedef __bf16 bf16x2_t __attribute__((ext_vector_type(2)));
__device__ __forceinline__ unsigned pk2(float lo, float hi) { f32x2 v = {lo, hi}; bf16x2_t b = __builtin_convertvector(v, bf16x2_t); return __builtin_bit_cast(unsigned, b); }
struct EpiP {
    static constexpr bool PERM = true, AFTER_DRAIN = false;
    bf16_t* P; bf16_t* PL; float qscale; int qcols;
    __device__ __forceinline__ void operator()(const f32x4 (&acc)[2][2][4][2], const Unit& u, int wr, int wc, int fr, int fq) const {
        const int row0 = u.pm * BM + wr * 64 + fr; const int colt = u.pn * BM;
        bf16_t* base; int ldc, c0;
        if (colt < 4096) { base = P; ldc = 4096; c0 = colt; } else { base = PL; ldc = 256; c0 = colt - 4096; }
        const float sc = (colt < qcols) ? qscale : 1.f;
        const int col0 = c0 + wc * 32 + 8 * fq;
#pragma unroll
        for (int ai = 0; ai < 2; ++ai)
#pragma unroll
            for (int m = 0; m < 4; ++m) { bf16_t* rowp = base + (size_t)(row0 + ai * HALF + m * 16) * ldc + col0;
#pragma unroll
                for (int bj = 0; bj < 2; ++bj) { const f32x4 v0 = acc[ai][bj][m][0] * sc, v1 = acc[ai][bj][m][1] * sc;
                    u32x4 w; w.x = pk2(v0[0], v0[1]); w.y = pk2(v0[2], v0[3]); w.z = pk2(v1[0], v1[1]); w.w = pk2(v1[2], v1[3]);
                    *(u32x4*)(rowp + bj * HALF) = w; } }
    }
};
struct EpiM {
    static constexpr bool PERM = true, AFTER_DRAIN = false;
    bf16_t* O;
    __device__ __forceinline__ void operator()(const f32x4 (&acc)[2][2][4][2], const Unit& u, int wr, int wc, int fr, int fq) const {
        const int row0 = u.pm * BM + wr * 64 + fr; const int col0 = u.pn * BM + wc * 32 + 8 * fq;
#pragma unroll
        for (int ai = 0; ai < 2; ++ai)
#pragma unroll
            for (int m = 0; m < 4; ++m) { bf16_t* rowp = O + (size_t)(row0 + ai * HALF + m * 16) * 1024 + col0;
#pragma unroll
                for (int bj = 0; bj < 2; ++bj) { const f32x4 v0 = acc[ai][bj][m][0], v1 = acc[ai][bj][m][1];
                    u32x4 w; w.x = pk2(v0[0], v0[1]); w.y = pk2(v0[2], v0[3]); w.z = pk2(v1[0], v1[1]); w.w = pk2(v1[2], v1[3]);
                    *(u32x4*)(rowp + bj * HALF) = w; } }
    }
};

template <int CTRL> __device__ __forceinline__ float dppz_(float v) { return __int_as_float(__builtin_amdgcn_update_dpp(0, __float_as_int(v), CTRL, 0xF, 0xF, true)); }
typedef _Float16 f16x2_t __attribute__((ext_vector_type(2)));
__device__ __forceinline__ unsigned pkh2(float lo, float hi) { f16x2_t v = {(_Float16)lo, (_Float16)hi}; return __builtin_bit_cast(unsigned, v); }
struct EpiLora {
    static constexpr bool PERM = true, AFTER_DRAIN = false;
    bf16_t* LD; bf16_t* AA;
    __device__ __forceinline__ void operator()(const f32x4 (&acc)[2][2][4][2], const Unit& u, int wr, int wc, int fr, int fq) const {
        const int row0 = u.pm * BM + wr * 64 + fr; const int colt = u.pn * BM; const int t = colt >> 10;
        const int cbase = (colt & 1023) + wc * 32 + 8 * fq;
        bf16_t* base = t ? AA : LD; const float sc = t ? 1.f : -0.6065306597126334f * 1.4426950408889634f;
#pragma unroll
        for (int ai = 0; ai < 2; ++ai)
#pragma unroll
            for (int m = 0; m < 4; ++m) { bf16_t* rowp = base + (size_t)(row0 + ai * HALF + m * 16) * 1024 + cbase;
#pragma unroll
                for (int bj = 0; bj < 2; ++bj) { f32x4 v0 = acc[ai][bj][m][0], v1 = acc[ai][bj][m][1];
#pragma unroll
                    for (int e = 0; e < 4; ++e) { v0[e] = sc * __builtin_amdgcn_rcpf(1.f + __builtin_amdgcn_exp2f(-1.4426950408889634f * v0[e])); v1[e] = sc * __builtin_amdgcn_rcpf(1.f + __builtin_amdgcn_exp2f(-1.4426950408889634f * v1[e])); }
                    u32x4 w;
                    if (t == 0) {
#pragma unroll
                        for (int e = 0; e < 4; ++e) { float x = v0[e], y = v1[e];
                            x += dppz_<0x111>(x); y += dppz_<0x111>(y); x += dppz_<0x112>(x); y += dppz_<0x112>(y); x += dppz_<0x114>(x); y += dppz_<0x114>(y); x += dppz_<0x118>(x); y += dppz_<0x118>(y);
                            v0[e] = x; v1[e] = y; }
                        w.x = pkh2(v0[0], v0[1]); w.y = pkh2(v0[2], v0[3]); w.z = pkh2(v1[0], v1[1]); w.w = pkh2(v1[2], v1[3]);
                    } else { w.x = pk2(v0[0], v0[1]); w.y = pk2(v0[2], v0[3]); w.z = pk2(v1[0], v1[1]); w.w = pk2(v1[2], v1[3]); }
                    *(u32x4*)(rowp + bj * HALF) = w; __builtin_amdgcn_sched_barrier(0); } }
    }
};
template <class Epi, class Sched, bool ALIGN_EPI = false, bool SP2 = false>
__device__ __forceinline__ void gemm_phase(PG8_LAS unsigned char* lds, const Gemm g, const Sched& S, const Epi& E) {
    const int tid = opaque_tid(), wid = __builtin_amdgcn_readfirstlane(tid >> 6), lane = tid & 63, wr = wid >> 2, wc = wid & 3, fr = lane & 15, fq = lane >> 4;
    const int K = g.K, nt = K / BK;
    unsigned voffA[2], voffB[2];
#pragma unroll
    for (int i = 0; i < 2; ++i) { int R, C; stage_rc(tid * 16 + i * 8192, R, C); const int Rb = Epi::PERM ? ((R & ~31) + perm32(R & 31)) : R;
        voffA[i] = (unsigned)(R * K + C) * 2u; voffB[i] = (unsigned)(Rb * K + C) * 2u; }
    const size_t kstep = (size_t)(BK * 2);
    const size_t hstep = (size_t)HALF * K * 2;
    const size_t tstep = 2 * hstep;
    const unsigned ldsw = (unsigned)wid * 1024u;
    const int aoff = lds_byte(wr * 64 + fr, fq * 8), boff = lds_byte(wc * 32 + fr, fq * 8);
#define PG8_SA(b, h) (((b) * 2 + (h)) * HTB)
#define PG8_SB(b, h) ((4 + (b) * 2 + (h)) * HTB)
#define PG8_STAGE(bufoff, gbase, voff) do { _Pragma("unroll") for (int _i = 0; _i < 2; ++_i) \
        __builtin_amdgcn_global_load_lds((const unsigned*)((const char*)(gbase) + (voff)[_i]), (PG8_LAS unsigned*)(lds + (bufoff) + ldsw + _i * 8192), 16, 0, 0); } while (0)
#define PG8_LDA(dst, b, h) do { _Pragma("unroll") for (int m = 0; m < 4; ++m) _Pragma("unroll") for (int k = 0; k < 2; ++k) dst[m][k] = *(const PG8_LAS bf16x8*)(lds + PG8_SA(b, h) + aoff + m * 2048 + k * 1024); } while (0)
#define PG8_LDB(dst, b, h) do { _Pragma("unroll") for (int n = 0; n < 2; ++n) _Pragma("unroll") for (int k = 0; k < 2; ++k) dst[n][k] = *(const PG8_LAS bf16x8*)(lds + PG8_SB(b, h) + boff + n * 2048 + k * 1024); } while (0)
#define PG8_MMA(ai, bj, At, Bt) do { __builtin_amdgcn_s_setprio(1); _Pragma("unroll") for (int m = 0; m < 4; ++m) _Pragma("unroll") for (int n = 0; n < 2; ++n) _Pragma("unroll") for (int k = 0; k < 2; ++k) \
        acc[ai][bj][m][n] = __builtin_amdgcn_mfma_f32_16x16x32_bf16(Bt[n][k], At[m][k], acc[ai][bj][m][n], 0, 0, 0); __builtin_amdgcn_s_setprio(0); } while (0)
#define PG8_WAIT_V(n) asm volatile("s_waitcnt vmcnt(" #n ")" ::: "memory")
#define PG8_WAIT_L(n) asm volatile("s_waitcnt lgkmcnt(" #n ")" ::: "memory")
#define PG8_BAR __builtin_amdgcn_s_barrier()
#define PG8_SCHED __builtin_amdgcn_sched_barrier(0)
    Unit cur, nxt; int ui = 0;
    if (!S.next(0, cur)) return;
    f32x4 acc[2][2][4][2];
#pragma unroll
    for (int a = 0; a < 2; ++a)
#pragma unroll
        for (int b = 0; b < 2; ++b)
#pragma unroll
            for (int m = 0; m < 4; ++m)
#pragma unroll
                for (int n = 0; n < 2; ++n) acc[a][b][m][n] = (f32x4){0.f, 0.f, 0.f, 0.f};
    bf16x8 At[4][2], B0[2][2], B1[2][2];
    const char* cA = (const char*)g.A + (size_t)cur.pm * tstep; const char* cB = (const char*)g.Bt + (size_t)cur.pn * tstep;
    S.a_ready(cur);
    if constexpr (SP2) {
        PG8_STAGE(PG8_SB(0, 0), cB, voffB); PG8_STAGE(PG8_SB(0, 1), cB + hstep, voffB); PG8_STAGE(PG8_SA(0, 0), cA, voffA); PG8_STAGE(PG8_SA(0, 1), cA + hstep, voffA);
        if (wr == 1) PG8_BAR;
        PG8_WAIT_V(2); PG8_BAR;
        PG8_STAGE(PG8_SB(1, 0), cB + kstep, voffB); PG8_STAGE(PG8_SA(1, 0), cA + kstep, voffA); PG8_STAGE(PG8_SB(1, 1), cB + hstep + kstep, voffB);
        PG8_WAIT_V(6); PG8_BAR;
    } else {
        PG8_STAGE(PG8_SB(0, 0), cB, voffB); PG8_STAGE(PG8_SA(0, 0), cA, voffA); PG8_STAGE(PG8_SB(0, 1), cB + hstep, voffB); PG8_STAGE(PG8_SA(0, 1), cA + hstep, voffA);
        if (wr == 1) PG8_BAR;
        PG8_WAIT_V(4); PG8_BAR;
        PG8_STAGE(PG8_SB(1, 0), cB + kstep, voffB); PG8_STAGE(PG8_SA(1, 0), cA + kstep, voffA); PG8_STAGE(PG8_SB(1, 1), cB + hstep + kstep, voffB);
        PG8_WAIT_V(6); PG8_BAR;
    }
    for (;;) {
        const bool has_next = S.next(ui + 1, nxt);
        const char* nA = has_next ? (const char*)g.A + (size_t)nxt.pm * tstep : cA; const char* nB = has_next ? (const char*)g.Bt + (size_t)nxt.pn * tstep : cB;
        for (int t = 0; t < nt; t += 2) {
            const bool last = (t == nt - 2);
            const char* a1 = cA + (size_t)(t + 1) * kstep;
            const char* a2 = last ? nA : cA + (size_t)(t + 2) * kstep; const char* b2 = last ? nB : cB + (size_t)(t + 2) * kstep;
            const char* a3 = a2 + kstep; const char* b3 = b2 + kstep;
            if (last && has_next) S.a_ready(nxt);
            if constexpr (SP2) {
            PG8_LDB(B0, 0, 0); PG8_LDB(B1, 0, 1); PG8_SCHED; PG8_LDA(At, 0, 0); PG8_STAGE(PG8_SA(1, 1), a1 + hstep, voffA);
            PG8_WAIT_V(8); PG8_WAIT_L(0); PG8_BAR; PG8_MMA(0, 0, At, B0); PG8_MMA(0, 1, At, B1); PG8_BAR; PG8_SCHED;
            PG8_LDA(At, 0, 1); PG8_STAGE(PG8_SB(0, 0), b2, voffB); PG8_STAGE(PG8_SB(0, 1), b2 + hstep, voffB); PG8_STAGE(PG8_SA(0, 0), a2, voffA);
            PG8_WAIT_V(8); PG8_WAIT_L(0); PG8_BAR; PG8_MMA(1, 0, At, B0); PG8_MMA(1, 1, At, B1); PG8_BAR; PG8_SCHED;
            PG8_LDB(B0, 1, 0); PG8_LDB(B1, 1, 1); PG8_SCHED; PG8_LDA(At, 1, 0); PG8_STAGE(PG8_SA(0, 1), a2 + hstep, voffA);
            PG8_WAIT_V(8); PG8_WAIT_L(0); PG8_BAR; PG8_MMA(0, 0, At, B0); PG8_MMA(0, 1, At, B1); PG8_BAR; PG8_SCHED;
            PG8_LDA(At, 1, 1); PG8_STAGE(PG8_SB(1, 0), b3, voffB); PG8_STAGE(PG8_SB(1, 1), b3 + hstep, voffB); PG8_STAGE(PG8_SA(1, 0), a3, voffA);
            PG8_WAIT_V(8); PG8_WAIT_L(0); PG8_BAR; PG8_MMA(1, 0, At, B0); PG8_MMA(1, 1, At, B1); PG8_BAR; PG8_SCHED;
            } else {
            PG8_LDB(B0, 0, 0); PG8_SCHED; PG8_LDA(At, 0, 0); PG8_STAGE(PG8_SA(1, 1), a1 + hstep, voffA);
            PG8_WAIT_L(8); PG8_BAR; PG8_WAIT_L(0); PG8_MMA(0, 0, At, B0); PG8_BAR; PG8_SCHED;
            PG8_LDB(B1, 0, 1); PG8_STAGE(PG8_SB(0, 0), b2, voffB);
            PG8_BAR; PG8_WAIT_L(0); PG8_MMA(0, 1, At, B1); PG8_BAR;
            PG8_LDA(At, 0, 1); PG8_STAGE(PG8_SA(0, 0), a2, voffA);
            PG8_BAR; PG8_WAIT_L(0); PG8_MMA(1, 0, At, B0); PG8_BAR; PG8_SCHED;
            PG8_STAGE(PG8_SB(0, 1), b2 + hstep, voffB);
            PG8_WAIT_V(6); PG8_BAR; PG8_MMA(1, 1, At, B1); PG8_BAR;
            PG8_LDB(B0, 1, 0); PG8_SCHED; PG8_LDA(At, 1, 0); PG8_STAGE(PG8_SA(0, 1), a2 + hstep, voffA);
            PG8_WAIT_L(8); PG8_BAR; PG8_WAIT_L(0); PG8_MMA(0, 0, At, B0); PG8_BAR; PG8_SCHED;
            PG8_LDB(B1, 1, 1); PG8_STAGE(PG8_SB(1, 0), b3, voffB);
            PG8_BAR; PG8_WAIT_L(0); PG8_MMA(0, 1, At, B1); PG8_BAR;
            PG8_LDA(At, 1, 1); PG8_STAGE(PG8_SA(1, 0), a3, voffA);
            PG8_BAR; PG8_WAIT_L(0); PG8_MMA(1, 0, At, B0); PG8_BAR; PG8_SCHED;
            PG8_STAGE(PG8_SB(1, 1), b3 + hstep, voffB);
            PG8_WAIT_V(6); PG8_BAR; PG8_MMA(1, 1, At, B1); PG8_BAR;
            }
        }
        if constexpr (ALIGN_EPI) { if (wr == 0) PG8_BAR; }
        if constexpr (!Epi::AFTER_DRAIN) { E(acc, cur, wr, wc, fr, fq); S.done(cur); }
        if (!has_next) break;
#pragma unroll
        for (int a = 0; a < 2; ++a)
#pragma unroll
            for (int b = 0; b < 2; ++b)
#pragma unroll
                for (int m = 0; m < 4; ++m)
#pragma unroll
                    for (int n = 0; n < 2; ++n) acc[a][b][m][n] = (f32x4){0.f, 0.f, 0.f, 0.f};
        cur = nxt; cA = nA; cB = nB; ++ui;
        if constexpr (ALIGN_EPI) { if (wr == 1) PG8_BAR; }
    }
    PG8_WAIT_V(0);
    if constexpr (!ALIGN_EPI) { if (wr == 0) PG8_BAR; }
    PG8_BAR;
    if constexpr (Epi::AFTER_DRAIN) { E.fused(acc, cur, wr, wc, fr, fq, lds, wid, lane); S.done(cur); }
#undef PG8_SA
#undef PG8_SB
#undef PG8_STAGE
#undef PG8_LDA
#undef PG8_LDB
#undef PG8_MMA
#undef PG8_WAIT_V
#undef PG8_WAIT_L
#undef PG8_BAR
#undef PG8_SCHED
}
}
#define LAS __attribute__((address_space(3)))
#define BID opaque_bid()
#define GRD opaque_grid()
typedef unsigned short bf16_t;
typedef short bf16x8 __attribute__((ext_vector_type(8)));
typedef short s16x4 __attribute__((ext_vector_type(4)));
typedef float f32x4 __attribute__((ext_vector_type(4)));
typedef float f32x2 __attribute__((ext_vector_type(2)));
typedef float f32x16 __attribute__((ext_vector_type(16)));
typedef unsigned u32x4 __attribute__((ext_vector_type(4)));
typedef unsigned u32x2 __attribute__((ext_vector_type(2)));

constexpr int NB = 8, SEQ = 2048, NMETA = 16, LSEQ = SEQ + NMETA  , LP = 2112  , DM = 1024;
constexpr int MROWS = NB * LP;
constexpr int FOX_IN = 4112, RWKV_IN = 4224;
constexpr float NORM_EPS = 1e-6f, GN_EPS = 64e-5f, LOG2E = 1.4426950408889634f;
constexpr float DECAY_SCALE = 0.6065306597126334f;
constexpr int LDS_BYTES = 147456;
constexpr size_t MiB = 1u << 20;
constexpr size_t WS_WIN = 1 * MiB;
constexpr size_t WS_WOUT = 10 * MiB;
constexpr size_t WS_HMETA = 12 * MiB;
constexpr size_t WS_CUM = 13 * MiB;
constexpr size_t WS_PL = 15 * MiB;
constexpr size_t WS_B = 24 * MiB;
constexpr size_t WS_C = 57 * MiB;
constexpr size_t WS_LD = 189 * MiB;
constexpr size_t WS_AA = 222 * MiB;
constexpr size_t WS_END = 255 * MiB;
static_assert(WS_B + (size_t)MROWS * 1024 * 2 <= WS_C && WS_C + (size_t)MROWS * 4096 * 2 <= WS_LD && WS_LD + (size_t)MROWS * 2048 <= WS_AA && WS_AA + (size_t)MROWS * 2048 <= WS_END, "ws map");
static_assert(WS_PL + (size_t)MROWS * 512 <= WS_B && WS_CUM + (size_t)MROWS * 64 <= WS_PL, "ws map 2");

struct Params {
    const float *x, *meta, *norm_pre, *norm_post, *fox_w_in, *fox_b_f, *fox_w_out, *rwkv_w_in, *rwkv_mu, *rwkv_w0, *rwkv_w_up, *rwkv_a0, *rwkv_a_up,
        *rwkv_k_k, *rwkv_k_a, *rwkv_r_k, *rwkv_ln_w, *rwkv_ln_b, *rwkv_w_out;
    float* out; unsigned char* ws;
};

__device__ __forceinline__ float wave_sum(float v) {
#pragma unroll
    for (int o = 1; o < 64; o <<= 1) v += __shfl_xor(v, o);
    return v;
}
__device__ __forceinline__ unsigned pk2(float lo, float hi) { return pg8::pk2(lo, hi); }
__device__ __forceinline__ float bflo(unsigned w) { return __uint_as_float(w << 16); }
__device__ __forceinline__ float bfhi(unsigned w) { return __uint_as_float(w & 0xffff0000u); }
template <int CTRL> __device__ __forceinline__ float dppf(float v) { return __int_as_float(__builtin_amdgcn_update_dpp(0, __float_as_int(v), CTRL, 0xF, 0xF, true)); }
__device__ __forceinline__ float red16(float v) {
    v += dppf<0xB1>(v); v += dppf<0x4E>(v); v += dppf<0x141>(v); v += dppf<0x140>(v); return v;
}
__device__ __forceinline__ float xhalf_max(float m) { auto rr = __builtin_amdgcn_permlane32_swap(__float_as_uint(m), __float_as_uint(m), false, false); return __builtin_fmaxf(__uint_as_float(rr[0]), __uint_as_float(rr[1])); }
__device__ __forceinline__ float xhalf_sum(float m) { auto rr = __builtin_amdgcn_permlane32_swap(__float_as_uint(m), __float_as_uint(m), false, false); return __uint_as_float(rr[0]) + __uint_as_float(rr[1]); }
__device__ __forceinline__ float sigmoidf_(float x) { return 1.f / (1.f + __expf(-x)); }
#define LDS_WAIT() asm volatile("s_waitcnt lgkmcnt(0)" ::: "memory")

__device__ __forceinline__ void transpose_item(const float* W, int ldw, bf16_t* WT, LAS float* scr, int kb, int nb, int lane) {
    const int k0 = 64 * kb, n0 = 32 * nb;
    {   f32x4 wv_[8];
#pragma unroll
        for (int i = 0; i < 8; ++i) wv_[i] = *(const f32x4*)(W + (size_t)(k0 + 8 * i + (lane >> 3)) * ldw + n0 + 4 * (lane & 7));
#pragma unroll
        for (int i = 0; i < 8; ++i) { LAS float* d_ = scr + (8 * i + (lane >> 3)) * 33 + 4 * (lane & 7); d_[0] = wv_[i][0]; d_[1] = wv_[i][1]; d_[2] = wv_[i][2]; d_[3] = wv_[i][3]; } }
    LDS_WAIT();
    const int c = lane & 7;
#pragma unroll
    for (int j = 0; j < 4; ++j) { const int n = (lane >> 3) + 8 * j; const LAS float* s = scr + (8 * c) * 33 + n;
        u32x4 o; o.x = pk2(s[0 * 33], s[1 * 33]); o.y = pk2(s[2 * 33], s[3 * 33]); o.z = pk2(s[4 * 33], s[5 * 33]); o.w = pk2(s[6 * 33], s[7 * 33]);
        *(u32x4*)(WT + (size_t)(n0 + n) * 1024 + k0 + 8 * c) = o; }
    LDS_WAIT();
}

template <int MODE>
__device__ __forceinline__ void phase_e(const Params& p, LAS unsigned char* lds, int next, int prev) {
    const int tid = opaque_tid(), lane = tid & 63, wave = __builtin_amdgcn_readfirstlane(tid >> 6);
    const int G = GRD, gw = BID * 8 + wave, NGW = G * 8;
    bf16_t* U = (bf16_t*)(p.ws + WS_B);
    float* CUM = (float*)(p.ws + WS_CUM);
    float* HMETA = (float*)(p.ws + WS_HMETA);
    const bf16_t* MB = (const bf16_t*)(p.ws + WS_C);
    const bool next_fox = (next >= 0) && ((next & 1) == 0);
    LAS float* WfT = (LAS float*)lds;
    LAS float* scr = (LAS float*)(lds + 65536 + wave * 8448);
    if (next >= 0) {
        const int jn = next >> 1;
        bf16_t* WIN = (bf16_t*)(p.ws + WS_WIN); bf16_t* WOUT = (bf16_t*)(p.ws + WS_WOUT);
        if (next_fox) {
            const float* Wf = p.fox_w_in + (size_t)jn * 1024 * FOX_IN + 4096;
            for (int i = tid; i < 4096; i += 512) { const int k = i >> 2, q = i & 3; const f32x4 v = *(const f32x4*)(Wf + (size_t)k * FOX_IN + 4 * q);
                WfT[(4 * q + 0) * 1024 + k] = v[0]; WfT[(4 * q + 1) * 1024 + k] = v[1]; WfT[(4 * q + 2) * 1024 + k] = v[2]; WfT[(4 * q + 3) * 1024 + k] = v[3]; }
            const float* W = p.fox_w_in + (size_t)jn * 1024 * FOX_IN; const float* Wo = p.fox_w_out + (size_t)jn * 1024 * 1024;
            for (int it = gw; it < 16 * 128 + 16 * 32; it += NGW) {
                if (it < 16 * 128) transpose_item(W, FOX_IN, WIN, scr, it / 128, it % 128, lane);
                else { const int r = it - 16 * 128; transpose_item(Wo, 1024, WOUT, scr, r / 32, r % 32, lane); }
            }
        } else {
            const float* W = p.rwkv_w_in + (size_t)jn * 1024 * RWKV_IN; const float* Wo = p.rwkv_w_out + (size_t)jn * 1024 * 1024;
            for (int it = gw; it < 16 * 132 + 16 * 32; it += NGW) {
                if (it < 16 * 132) transpose_item(W, RWKV_IN, WIN, scr, it / 132, it % 132, lane);
                else { const int r = it - 16 * 132; transpose_item(Wo, 1024, WOUT, scr, r / 32, r % 32, lane); }
            }
            for (int i = BID * 512 + tid; i < 16384; i += G * 512) *(u32x4*)(WIN + (size_t)4224 * 1024 + (size_t)i * 8) = (u32x4){0u, 0u, 0u, 0u};
        }
    }
    __syncthreads();
    f32x4 gpo[4], gpr[4];
#pragma unroll
    for (int j = 0; j < 4; ++j) {
        gpo[j] = (MODE == 1) ? *((const f32x4*)(p.norm_post + (size_t)prev * 1024) + lane + 64 * j) : (f32x4){0.f, 0.f, 0.f, 0.f};
        gpr[j] = (next >= 0) ? *((const f32x4*)(p.norm_pre + (size_t)next * 1024) + lane + 64 * j) : (f32x4){0.f, 0.f, 0.f, 0.f};
    }
    const float bfv = (next_fox && lane < 16) ? p.fox_b_f[(next >> 1) * 16 + lane] : 0.f;
    f32x4 nv[4]; u32x2 nmw[4];
#define PE_ISSUE(mm) do { const int m_ = (mm); if (m_ < MROWS) { const int b_ = m_ / LP, t_ = m_ - b_ * LP; if (t_ < LSEQ) { \
        if (MODE == 0) { const float* src_ = (t_ < NMETA) ? p.meta + (size_t)t_ * 1024 : p.x + ((size_t)b_ * SEQ + (t_ - NMETA)) * 1024; \
            _Pragma("unroll") for (int j_ = 0; j_ < 4; ++j_) nv[j_] = *((const f32x4*)src_ + lane + 64 * j_); } \
        else { const float* hr_ = (prev == 0) ? ((t_ < NMETA) ? p.meta + (size_t)t_ * 1024 : p.x + ((size_t)b_ * SEQ + (t_ - NMETA)) * 1024)        \
                                       : ((t_ < NMETA) ? HMETA + (size_t)(b_ * NMETA + t_) * 1024 : p.out + ((size_t)b_ * SEQ + (t_ - NMETA)) * 1024); \
            _Pragma("unroll") for (int j_ = 0; j_ < 4; ++j_) { nv[j_] = *((const f32x4*)hr_ + lane + 64 * j_); nmw[j_] = *((const u32x2*)(MB + (size_t)m_ * 1024) + lane + 64 * j_); } } } } } while (0)
#pragma unroll
    for (int j = 0; j < 4; ++j) { nv[j] = (f32x4){0.f, 0.f, 0.f, 0.f}; nmw[j] = (u32x2){0u, 0u}; }
    PE_ISSUE(gw);
    for (int m = gw; m < MROWS; m += NGW) {
        const int b = m / LP, t = m - b * LP;
        f32x4 v[4]; u32x2 mw4[4];
#pragma unroll
        for (int j = 0; j < 4; ++j) { v[j] = nv[j]; mw4[j] = nmw[j]; }
        PE_ISSUE(m + NGW);
        if (t >= LSEQ) {
            if (next >= 0) { u32x2* o8 = (u32x2*)(U + (size_t)m * 1024) + lane;
#pragma unroll
                for (int j = 0; j < 4; ++j) o8[64 * j] = (u32x2){0u, 0u};
                if (next_fox && lane < 16) CUM[(size_t)m * 16 + lane] = 0.f; }
            continue;
        }
        float* hrow = (t < NMETA) ? HMETA + (size_t)(b * NMETA + t) * 1024 : p.out + ((size_t)b * SEQ + (t - NMETA)) * 1024;
        if (MODE == 1) {
            f32x4 mv[4]; float ss = 0.f;
#pragma unroll
            for (int j = 0; j < 4; ++j) { mv[j] = (f32x4){bflo(mw4[j].x), bfhi(mw4[j].x), bflo(mw4[j].y), bfhi(mw4[j].y)};
                ss += (mv[j][0] * mv[j][0] + mv[j][1] * mv[j][1]) + (mv[j][2] * mv[j][2] + mv[j][3] * mv[j][3]); }
            const float rs = __builtin_amdgcn_rsqf(wave_sum(ss) * (1.f / 1024.f) + NORM_EPS);
#pragma unroll
            for (int j = 0; j < 4; ++j) v[j] = v[j] + mv[j] * rs * gpo[j];
        }
        if (MODE == 1) {
#pragma unroll
            for (int j = 0; j < 4; ++j) *((f32x4*)hrow + lane + 64 * j) = v[j];
        }
        if (next >= 0) {
            float ss = 0.f;
#pragma unroll
            for (int j = 0; j < 4; ++j) ss += (v[j][0] * v[j][0] + v[j][1] * v[j][1]) + (v[j][2] * v[j][2] + v[j][3] * v[j][3]);
            const float rs = __builtin_amdgcn_rsqf(wave_sum(ss) * (1.f / 1024.f) + NORM_EPS);
            u32x2* o8 = (u32x2*)(U + (size_t)m * 1024) + lane;
#pragma unroll
            for (int j = 0; j < 4; ++j) { v[j] = v[j] * rs * gpr[j]; o8[64 * j] = (u32x2){pk2(v[j][0], v[j][1]), pk2(v[j][2], v[j][3])}; }
            if (next_fox) {
                float mine = 0.f;
#pragma unroll
                for (int hd = 0; hd < 16; ++hd) { float s = 0.f;
#pragma unroll
                    for (int j = 0; j < 4; ++j) { const f32x4 w = *((const LAS f32x4*)(WfT + hd * 1024) + lane + 64 * j); s += (v[j][0] * w[0] + v[j][1] * w[1]) + (v[j][2] * w[2] + v[j][3] * w[3]); }
                    s = wave_sum(s); if (lane == hd) mine = s; }
                if (lane < 16) { const float xp = (mine + bfv) * LOG2E; CUM[(size_t)m * 16 + lane] = fminf(xp, 0.f) - __builtin_amdgcn_logf(1.f + __builtin_amdgcn_exp2f(-fabsf(xp))); }
            }
        }
    }
}

#undef PE_ISSUE
__device__ __forceinline__ void phase_cumsum(const Params& p, LAS unsigned char* lds) {
    const int tid = opaque_tid(); LAS float* s = (LAS float*)lds;
    float* CUM = (float*)(p.ws + WS_CUM);
    for (int j = (GRD >= 256) ? BID - 128 : BID; j < 128; j += GRD) {
        if (j < 0) break;
        const int b = j >> 4, hd = j & 15; float* base = CUM + (size_t)b * LP * 16 + hd;
        float v[5]; float tot = 0.f;
#pragma unroll
        for (int e = 0; e < 5; ++e) { const int t = tid * 5 + e; v[e] = (t < LP) ? base[(size_t)t * 16] : 0.f; tot += v[e]; }
        s[tid] = tot; __syncthreads();
        for (int off = 1; off < 512; off <<= 1) { const float a = (tid >= off) ? s[tid - off] : 0.f; __syncthreads(); s[tid] += a; __syncthreads(); }
        float run = s[tid] - tot;
#pragma unroll
        for (int e = 0; e < 5; ++e) { const int t = tid * 5 + e; run += v[e]; if (t < LP) base[(size_t)t * 16] = run; }
        __syncthreads();
    }
}

__device__ __forceinline__ void phase_attn(const Params& p, LAS unsigned char* lds, unsigned* qctr) {
    const int tid = opaque_tid(), lane = tid & 63, wid = __builtin_amdgcn_readfirstlane(tid >> 6), r32 = lane & 31, hi = lane >> 5;
    LAS bf16_t* Ks = (LAS bf16_t*)lds;
    LAS bf16_t* Vs = Ks + 2 * 64 * 72;
    LAS float* cks = (LAS float*)(lds + 2 * 64 * 72 * 2 + 2 * 64 * 96 * 2);
    typedef short v4i16_t __attribute__((ext_vector_type(4)));
    const int vrd = (4 * hi + ((lane & 15) >> 2)) * 96 + 16 * ((lane >> 4) & 1) + 4 * (lane & 3);
    const bf16_t* P = (const bf16_t*)(p.ws + WS_C);
    const float* CUM = (const float*)(p.ws + WS_CUM);
    bf16_t* OG = (bf16_t*)(p.ws + WS_B);
    const int kr = tid >> 3, kc = tid & 7;
    volatile LAS unsigned* uslot = (volatile LAS unsigned*)(lds + LDS_BYTES - 32);
#define AT_BAR() do { asm volatile("s_waitcnt lgkmcnt(0)" ::: "memory"); __builtin_amdgcn_s_barrier(); asm volatile("" ::: "memory"); } while (0)
#define AT_STORE_K(buf, KR, CR) do { *(LAS u32x4*)(Ks + (buf) * 4608 + kr * 72 + kc * 8) = (KR); if (tid < 64) cks[(buf) * 64 + tid] = -(CR); } while (0)
#define AT_STORE_V(buf, VR) do { *(LAS u32x4*)(Vs + (buf) * 6144 + kr * 96 + kc * 8) = (VR); } while (0)
#define AT_QK(t, P0, P1) do { const LAS bf16_t* Kb_ = Ks + ((t) & 1) * 4608; const LAS float* cb_ = cks + ((t) & 1) * 64; \
        _Pragma("unroll") for (int i_ = 0; i_ < 4; ++i_) { const f32x4 c0_ = *(const LAS f32x4*)(cb_ + 8 * i_ + 4 * hi), c1_ = *(const LAS f32x4*)(cb_ + 32 + 8 * i_ + 4 * hi); \
            _Pragma("unroll") for (int e_ = 0; e_ < 4; ++e_) { P0[4 * i_ + e_] = c0_[e_] - m_run; P1[4 * i_ + e_] = c1_[e_] - m_run; } } \
        _Pragma("unroll") for (int d0_ = 0; d0_ < 4; ++d0_) { \
            const bf16x8 a0_ = *(const LAS bf16x8*)(Kb_ + r32 * 72 + d0_ * 16 + hi * 8), a1_ = *(const LAS bf16x8*)(Kb_ + (32 + r32) * 72 + d0_ * 16 + hi * 8); \
            P0 = __builtin_amdgcn_mfma_f32_32x32x16_bf16(a0_, qr[d0_], P0, 0, 0, 0); P1 = __builtin_amdgcn_mfma_f32_32x32x16_bf16(a1_, qr[d0_], P1, 0, 0, 0); } } while (0)
#define AT_PV(c, PX, B) do { u32x4 pw_; pw_.x = pk2(PX[B + 0], PX[B + 1]); pw_.y = pk2(PX[B + 2], PX[B + 3]); pw_.z = pk2(PX[B + 4], PX[B + 5]); pw_.w = pk2(PX[B + 6], PX[B + 7]); \
        const bf16x8 pf_ = __builtin_bit_cast(bf16x8, pw_); \
        {   const s16x4 lo_ = __builtin_bit_cast(s16x4, __builtin_amdgcn_ds_read_tr16_b64_v4i16((LAS v4i16_t*)(Vb_ + (16 * (c)) * 96))), h4_ = __builtin_bit_cast(s16x4, __builtin_amdgcn_ds_read_tr16_b64_v4i16((LAS v4i16_t*)(Vb_ + (16 * (c) + 8) * 96))); \
            const bf16x8 vf_ = (bf16x8){lo_[0], lo_[1], lo_[2], lo_[3], h4_[0], h4_[1], h4_[2], h4_[3]}; \
            o0 = __builtin_amdgcn_mfma_f32_32x32x16_bf16(vf_, pf_, o0, 0, 0, 0); } \
        {   const s16x4 lo_ = __builtin_bit_cast(s16x4, __builtin_amdgcn_ds_read_tr16_b64_v4i16((LAS v4i16_t*)(Vb_ + (16 * (c)) * 96 + 32))), h4_ = __builtin_bit_cast(s16x4, __builtin_amdgcn_ds_read_tr16_b64_v4i16((LAS v4i16_t*)(Vb_ + (16 * (c) + 8) * 96 + 32))); \
            const bf16x8 vf_ = (bf16x8){lo_[0], lo_[1], lo_[2], lo_[3], h4_[0], h4_[1], h4_[2], h4_[3]}; \
            o1 = __builtin_amdgcn_mfma_f32_32x32x16_bf16(vf_, pf_, o1, 0, 0, 0); } } while (0)
#define AT_TOFF(t) ((t) ? (long)(t) * 64 * 4096 : k0off)
#define AT_COFF(t) ((t) ? (long)(t) * 64 * 16 : c0off)
#define AT_STEP(i, PC0, PC1, PN0, PN1) do { const int i_ = (i), t_ = NT - 1 - i_; \
        if (t_ >= 2) { kreg = *(const u32x4*)(kg + AT_TOFF(t_ - 2)); if (tid < 64) creg = cgp[AT_COFF(t_ - 2)]; } \
        if (t_ >= 1) vreg = *(const u32x4*)(vg + AT_TOFF(t_ - 1)); \
        const bool need_next_ = active && (t_ >= 1) && (t_ - 1 <= jmax); \
        if (need_next_) AT_QK(i_ + 1, PN0, PN1); \
        __builtin_amdgcn_sched_barrier(0); \
        if (active && t_ <= jmax) { \
            const LAS bf16_t* Vb_ = Vs + (i_ & 1) * 6144 + vrd; \
            if (64 * t_ + 63 > qw0 || t_ == 0) { const int qpos_ = qw0 + r32; \
                _Pragma("unroll") for (int r = 0; r < 16; ++r) { const int kv_ = 64 * t_ + (r & 3) + 8 * (r >> 2) + 4 * hi; if (kv_ > qpos_ || kv_ < 48) PC0[r] = -INFINITY; if (kv_ + 32 > qpos_ || kv_ + 32 < 48) PC1[r] = -INFINITY; } } \
            float mxa_ = __builtin_fmaxf(__builtin_fmaxf(PC0[0], PC0[1]), PC1[0]), mxb_ = __builtin_fmaxf(__builtin_fmaxf(PC0[2], PC0[3]), PC1[1]); mxa_ = __builtin_fmaxf(__builtin_fmaxf(mxa_, PC1[2]), PC1[3]); \
            _Pragma("unroll") for (int r = 4; r < 16; r += 4) { mxa_ = __builtin_fmaxf(__builtin_fmaxf(mxa_, PC0[r]), PC0[r + 1]); mxb_ = __builtin_fmaxf(__builtin_fmaxf(mxb_, PC0[r + 2]), PC0[r + 3]); \
                mxa_ = __builtin_fmaxf(__builtin_fmaxf(mxa_, PC1[r]), PC1[r + 1]); mxb_ = __builtin_fmaxf(__builtin_fmaxf(mxb_, PC1[r + 2]), PC1[r + 3]); } \
            float mx_ = xhalf_max(__builtin_fmaxf(mxa_, mxb_)); \
              \
              \
            const bool first_ = (t_ == tfirst); \
            if (first_ || __any(mx_ > -30.f)) { \
            if (first_ || __any(mx_ > 8.f)) { const float dl_ = first_ ? ((mx_ > -1e30f) ? mx_ : 0.f) : fmaxf(mx_, 0.f); m_run += dl_; const float alpha_ = __builtin_amdgcn_exp2f(-dl_); l_run *= alpha_; \
                _Pragma("unroll") for (int r = 0; r < 16; ++r) { PC0[r] -= dl_; PC1[r] -= dl_; o0[r] *= alpha_; o1[r] *= alpha_; } \
                if (need_next_) { _Pragma("unroll") for (int r = 0; r < 16; ++r) { PN0[r] -= dl_; PN1[r] -= dl_; } } } \
            float sa_ = 0.f, sb_ = 0.f, sc_ = 0.f, sd_ = 0.f; \
            _Pragma("unroll") for (int r = 0; r < 16; r += 2) { PC0[r] = __builtin_amdgcn_exp2f(PC0[r]); PC1[r] = __builtin_amdgcn_exp2f(PC1[r]); PC0[r + 1] = __builtin_amdgcn_exp2f(PC0[r + 1]); PC1[r + 1] = __builtin_amdgcn_exp2f(PC1[r + 1]); \
                sa_ += PC0[r]; sb_ += PC1[r]; sc_ += PC0[r + 1]; sd_ += PC1[r + 1]; } \
            l_run += (sa_ + sb_) + (sc_ + sd_); \
            AT_PV(0, PC0, 0); AT_PV(1, PC0, 8); AT_PV(2, PC1, 0); AT_PV(3, PC1, 8); } } \
        if (t_ >= 2) AT_STORE_K(i_ & 1, kreg, creg); \
        if (t_ >= 1) AT_STORE_V((i_ + 1) & 1, vreg); \
        AT_BAR(); } while (0)
    for (;;) {
        if (tid == 0) *uslot = __hip_atomic_fetch_add(qctr, 1u, __ATOMIC_RELAXED, __HIP_MEMORY_SCOPE_AGENT);
        __syncthreads();
        const int u = (int)*uslot;
        if (u >= 1152) break;
        const bool metau = u >= 1024;
        const int qb = metau ? 0 : 7 - u / 128, bh = metau ? u - 1024 : u % 128, b = bh >> 4, h = bh & 15;
        const int q0 = metau ? 48 : 64 + qb * 256;
        const int NT = metau ? 1 : 5 + 4 * qb;
        const int qw0 = q0 + 32 * wid;
        const bool active = metau ? (wid == 0) : true;
        const int jmax = (qw0 + 31) >> 6;
        const int tfirst = (jmax < NT - 1) ? jmax : NT - 1;
        const size_t rowb = (size_t)b * LP;
        bf16x8 qr[4];
#pragma unroll
        for (int d0 = 0; d0 < 4; ++d0) qr[d0] = active ? *(const bf16x8*)(P + (rowb + qw0 - 48 + r32) * 4096 + h * 64 + d0 * 16 + hi * 8) : (bf16x8){0, 0, 0, 0, 0, 0, 0, 0};
        const long krow0 = (long)rowb + kr - 48, crow0 = (long)rowb + (tid & 63) - 48;
        const bf16_t* kg = P + krow0 * 4096 + 1024 + h * 64 + kc * 8;
        const bf16_t* vg = kg + 1024;
        const float* cgp = CUM + crow0 * 16 + h;
        const long k0off = (kr < 48) ? (long)(48 - kr) * 4096 : 0, c0off = ((tid & 63) < 48) ? (long)(48 - (tid & 63)) * 16 : 0;
        u32x4 kreg = (u32x4){0u, 0u, 0u, 0u}, vreg = kreg; float creg = 0.f;
        {   const u32x4 k0 = *(const u32x4*)(kg + AT_TOFF(NT - 1)), v0 = *(const u32x4*)(vg + AT_TOFF(NT - 1)); u32x4 k1 = k0; float c0 = 0.f, c1 = 0.f;
            if (NT >= 2) k1 = *(const u32x4*)(kg + AT_TOFF(NT - 2));
            if (tid < 64) { c0 = cgp[AT_COFF(NT - 1)]; if (NT >= 2) c1 = cgp[AT_COFF(NT - 2)]; }
            AT_STORE_K(0, k0, c0); AT_STORE_K(1, k1, c1); AT_STORE_V(0, v0); }
        AT_BAR();
        float m_run = 0.f, l_run = 0.f;
        f32x16 o0, o1, pa0, pa1, pb0, pb1;
#pragma unroll
        for (int r = 0; r < 16; ++r) { o0[r] = 0.f; o1[r] = 0.f; pa0[r] = 0.f; pa1[r] = 0.f; pb0[r] = 0.f; pb1[r] = 0.f; }
        if (active && NT - 1 <= jmax) AT_QK(0, pa0, pa1);
        for (int j = 0; j < NT; j += 2) {
            AT_STEP(j, pa0, pa1, pb0, pb1);
            if (j + 1 < NT) AT_STEP(j + 1, pb0, pb1, pa0, pa1);
        }
        if (active) {
            const float l = xhalf_sum(l_run); const float inv = 1.f / l;
            const size_t row = rowb + qw0 - 48 + r32;
            if (!metau || r32 < 16) {
#pragma unroll
            for (int dh = 0; dh < 2; ++dh)
#pragma unroll
                for (int i = 0; i < 4; ++i) {
                    const int dcol = h * 64 + 32 * dh + 8 * i + 4 * hi;
                    const u32x2 gw_ = *(const u32x2*)(P + row * 4096 + 3072 + dcol);
                    const float g0 = bflo(gw_.x), g1 = bfhi(gw_.x), g2 = bflo(gw_.y), g3 = bfhi(gw_.y);
                    const float a0 = (dh ? o1[4 * i + 0] : o0[4 * i + 0]) * inv, a1 = (dh ? o1[4 * i + 1] : o0[4 * i + 1]) * inv, a2 = (dh ? o1[4 * i + 2] : o0[4 * i + 2]) * inv, a3 = (dh ? o1[4 * i + 3] : o0[4 * i + 3]) * inv;
                    u32x2 w; w.x = pk2(a0 * g0 * sigmoidf_(g0), a1 * g1 * sigmoidf_(g1)); w.y = pk2(a2 * g2 * sigmoidf_(g2), a3 * g3 * sigmoidf_(g3));
                    *(u32x2*)(OG + row * 1024 + dcol) = w;
                }
            }
        }
    }
#undef AT_BAR
#undef AT_STORE_K
#undef AT_STORE_V
#undef AT_QK
#undef AT_PV
#undef AT_STEP
#undef AT_TOFF
#undef AT_COFF
}

__device__ __forceinline__ void phase_lora_prep(const Params& p, int jr) {
    const int tid = opaque_tid(); const int gt = BID * 512 + tid, NTH = GRD * 512;
    const bf16_t* PL = (const bf16_t*)(p.ws + WS_PL);
    bf16_t* A = (bf16_t*)(p.ws + WS_WIN); bf16_t* Bt = (bf16_t*)(p.ws + WS_CUM);
    const float* mu = p.rwkv_mu + (size_t)jr * RWKV_IN + 4096;
    const float* w_up = p.rwkv_w_up + (size_t)jr * 64 * 1024; const float* a_up = p.rwkv_a_up + (size_t)jr * 64 * 1024;
    for (int it = gt; it < MROWS * 32; it += NTH) {
        const int row = it >> 5, cg8 = it & 31;
        u32x4 o = (u32x4){0u, 0u, 0u, 0u};
        if (cg8 < 16) {
            const int tpos = row % LP;
            const u32x4 cw = *(const u32x4*)(PL + (size_t)row * 256 + 8 * cg8);
            u32x4 pw = (u32x4){0u, 0u, 0u, 0u}; if (tpos > 0) pw = *(const u32x4*)(PL + (size_t)(row - 1) * 256 + 8 * cg8);
            const f32x4 m0 = *(const f32x4*)(mu + 8 * cg8), m1 = *(const f32x4*)(mu + 8 * cg8 + 4);
            float v[8];
            v[0] = bflo(cw.x) + (bflo(pw.x) - bflo(cw.x)) * m0[0]; v[1] = bfhi(cw.x) + (bfhi(pw.x) - bfhi(cw.x)) * m0[1];
            v[2] = bflo(cw.y) + (bflo(pw.y) - bflo(cw.y)) * m0[2]; v[3] = bfhi(cw.y) + (bfhi(pw.y) - bfhi(cw.y)) * m0[3];
            v[4] = bflo(cw.z) + (bflo(pw.z) - bflo(cw.z)) * m1[0]; v[5] = bfhi(cw.z) + (bfhi(pw.z) - bfhi(cw.z)) * m1[1];
            v[6] = bflo(cw.w) + (bflo(pw.w) - bflo(cw.w)) * m1[2]; v[7] = bfhi(cw.w) + (bfhi(pw.w) - bfhi(cw.w)) * m1[3];
            if (cg8 < 8) {
#pragma unroll
                for (int e = 0; e < 8; ++e) v[e] = tanhf(v[e]);
            }
            o.x = pk2(v[0], v[1]); o.y = pk2(v[2], v[3]); o.z = pk2(v[4], v[5]); o.w = pk2(v[6], v[7]);
        }
        if (cg8 == 16) o.x = 0x3F803F80u;
        *(u32x4*)(A + (size_t)row * 256 + 8 * cg8) = o;
    }
    for (int it = gt; it < 2048 * 32; it += NTH) {
        const int n = it & 2047, kg = it >> 11;
        u32x4 o = (u32x4){0u, 0u, 0u, 0u};
        const float* src = nullptr;
        if (n < 1024 && kg < 8) src = w_up + (size_t)(8 * kg) * 1024 + n;
        else if (n >= 1024 && kg >= 8 && kg < 16) src = a_up + (size_t)(8 * (kg - 8)) * 1024 + (n - 1024);
        if (src) { o.x = pk2(src[0], src[1024]); o.y = pk2(src[2048], src[3072]); o.z = pk2(src[4096], src[5120]); o.w = pk2(src[6144], src[7168]); }
        if (kg == 16) { const float bz = (n < 1024) ? p.rwkv_w0[jr * 1024 + n] : p.rwkv_a0[jr * 1024 + n - 1024]; const float bh = bfhi(pk2(0.f, bz)); o.x = pk2(bh, bz - bh); }
        *(u32x4*)(Bt + (size_t)n * 256 + 8 * kg) = o;
    }
}

__device__ __forceinline__ void phase_scan(const Params& p, LAS unsigned char* lds, int jr) {
    const int tid = opaque_tid(), lane = tid & 63, wid = __builtin_amdgcn_readfirstlane(tid >> 6);
    LAS float* vec = (LAS float*)lds;
    LAS float* ypart = vec + 2 * 6144;
    const bf16_t* P = (const bf16_t*)(p.ws + WS_C);
    const bf16_t* LD = (const bf16_t*)(p.ws + WS_LD); const bf16_t* AA = (const bf16_t*)(p.ws + WS_AA);
    bf16_t* Y = (bf16_t*)(p.ws + WS_B);
    constexpr int NCH = 129;
    const int ht = tid & 255, ds = ht >> 4, kq = lane & 15, rl = lane >> 4;
    for (int u = BID; u < 256; u += GRD) {
        const int bh = u >> 1, half = u & 1, b = bh >> 4, h = bh & 15;
        const int kcol = h * 64 + 4 * kq;
        const float* mu = p.rwkv_mu + (size_t)jr * RWKV_IN;
        f32x4 mur, muk, muv, kk4, ka4, rk4;
        float* BON = (float*)(p.ws + WS_CUM);
        u32x2 rw, kw, vw, rp, kp_, vp, lw, lwp, aw; size_t drow = 0;
        if (wid >= 4) { mur = *(const f32x4*)(mu + kcol); muk = *(const f32x4*)(mu + 1024 + kcol); muv = *(const f32x4*)(mu + 2048 + kcol);
            kk4 = *(const f32x4*)(p.rwkv_k_k + jr * 1024 + kcol); ka4 = *(const f32x4*)(p.rwkv_k_a + jr * 1024 + kcol); rk4 = *(const f32x4*)(p.rwkv_r_k + jr * 1024 + kcol); }
#define SC_LOADRAW(ch) do { const int t_ = (ch) * 16 + ds; const size_t row_ = (size_t)b * LP + t_; drow = row_; const bf16_t* pr_ = P + row_ * 4096 + kcol; \
        rw = *(const u32x2*)pr_; kw = *(const u32x2*)(pr_ + 1024); vw = *(const u32x2*)(pr_ + 2048); \
        rp = (u32x2){0u, 0u}; kp_ = rp; vp = rp; lwp = rp; \
        if (ds > 0) lwp = *(const u32x2*)(LD + (row_ - 1) * 1024 + kcol); \
        if (t_ > 0) { rp = *(const u32x2*)(pr_ - 4096); kp_ = *(const u32x2*)(pr_ - 4096 + 1024); vp = *(const u32x2*)(pr_ - 4096 + 2048); } \
        lw = *(const u32x2*)(LD + row_ * 1024 + kcol); aw = *(const u32x2*)(AA + row_ * 1024 + kcol); } while (0)
#define SC_DERIVE(buf) do { \
        const f32x4 rc = {bflo(rw.x), bfhi(rw.x), bflo(rw.y), bfhi(rw.y)}, kc_ = {bflo(kw.x), bfhi(kw.x), bflo(kw.y), bfhi(kw.y)}, vc = {bflo(vw.x), bfhi(vw.x), bflo(vw.y), bfhi(vw.y)}; \
        const f32x4 rpv = {bflo(rp.x), bfhi(rp.x), bflo(rp.y), bfhi(rp.y)}, kpv = {bflo(kp_.x), bfhi(kp_.x), bflo(kp_.y), bfhi(kp_.y)}, vpv = {bflo(vp.x), bfhi(vp.x), bflo(vp.y), bfhi(vp.y)}; \
        const unsigned lx_ = lw.x, ly_ = lw.y, qx_ = lwp.x, qy_ = lwp.y;        \
        const pg8::f16x2_t l0_ = __builtin_bit_cast(pg8::f16x2_t, lx_), l1_ = __builtin_bit_cast(pg8::f16x2_t, ly_), q0_ = __builtin_bit_cast(pg8::f16x2_t, qx_), q1_ = __builtin_bit_cast(pg8::f16x2_t, qy_); \
        const f32x4 ldv = {(float)l0_[0], (float)l0_[1], (float)l1_[0], (float)l1_[1]}, ldp = {(float)q0_[0], (float)q0_[1], (float)q1_[0], (float)q1_[1]}, av = {bflo(aw.x), bfhi(aw.x), bflo(aw.y), bfhi(aw.y)}; \
        const f32x4 rlp = rc + (rpv - rc) * mur, klp = kc_ + (kpv - kc_) * muk, vlp = vc + (vpv - vc) * muv; \
        const f32x4 kkv = klp * kk4; \
        float ss = (kkv[0] * kkv[0] + kkv[1] * kkv[1]) + (kkv[2] * kkv[2] + kkv[3] * kkv[3]); \
        ss = red16(ss); \
        const float inv = __builtin_amdgcn_rsqf(fmaxf(ss, 1e-24f));        \
        const f32x4 kkn = kkv * inv; \
        const f32x4 kpr = klp * (1.f + (av - 1.f) * ka4); \
        { const f32x4 bt_ = rlp * kpr * rk4; const float bs_ = red16((bt_[0] + bt_[1]) + (bt_[2] + bt_[3])); if (half == 0 && kq == 0) BON[drow * 16 + h] = bs_; } \
        f32x4 wv, iw, wp; \
        _Pragma("unroll") for (int e_ = 0; e_ < 4; ++e_) { wv[e_] = __builtin_amdgcn_exp2f(ldv[e_]); iw[e_] = __builtin_amdgcn_exp2f(-ldv[e_]); wp[e_] = __builtin_amdgcn_exp2f(ldp[e_]); }     \
        LAS float* vs = vec + (buf) * 6144 + ds * 384 + 4 * kq; \
        *(LAS f32x4*)(vs) = wv; *(LAS f32x4*)(vs + 64) = -kkn * wp; *(LAS f32x4*)(vs + 128) = kkn * av * iw; *(LAS f32x4*)(vs + 192) = kpr * iw; *(LAS f32x4*)(vs + 256) = rlp * wv; *(LAS f32x4*)(vs + 320) = vlp; } while (0)
#define SC_YREDUCE(chunk, buf) do { float pa_ = 0.f, pb_ = 0.f; \
        _Pragma("unroll") for (int j_ = 0; j_ < 8; ++j_) { \
            const f32x4 x_ = *(const LAS f32x4*)(ypart + (buf) * 8192 + j_ * 1024 + (ht & ~15) * 4 + (((ht & 15) + 2 * j_) & 15) * 4); \
            pa_ += x_[0] + x_[2]; pb_ += x_[1] + x_[3]; } \
        { const int s_ = ht >> 4, cw_ = (ht >> 2) & 3, rl_ = ht & 3; \
          *(unsigned*)(Y + ((size_t)b * LP + (chunk) * 16 + s_) * 1024 + h * 64 + 32 * half + 8 * cw_ + 2 * rl_) = pk2(pa_, pb_); } } while (0)
        if (wid >= 4) { SC_LOADRAW(0); SC_DERIVE(0); SC_LOADRAW(1); }
        __syncthreads();
        float SA0 = 0.f, SA1 = 0.f, SA2 = 0.f, SA3 = 0.f, SB0 = 0.f, SB1 = 0.f, SB2 = 0.f, SB3 = 0.f;
        for (int ch = 0; ch < NCH; ++ch) {
            const int buf = ch & 1;
            if (wid < 4) {
                const LAS float* vb = vec + buf * 6144 + 4 * kq;
                const LAS float* vvp = vec + buf * 6144 + 320 + 32 * half + 8 * wid + 2 * rl;
                LAS float* yp = ypart + buf * 8192 + (kq >> 1) * 1024 + ((wid * 4 + rl + 2 * (kq >> 1)) & 15) * 4 + 2 * (kq & 1);
                const f32x4 wend = *(const LAS f32x4*)(vb + 15 * 384);
                f32x4 a4 = *(const LAS f32x4*)(vb + 64), b4 = *(const LAS f32x4*)(vb + 128), k4 = *(const LAS f32x4*)(vb + 192), r4 = *(const LAS f32x4*)(vb + 256);
                f32x2 vv = *(const LAS f32x2*)(vvp);
#pragma unroll
                for (int s = 0; s < 16; ++s) {
                    f32x4 na = a4, nb = b4, nk = k4, nr = r4; f32x2 nv = vv;
                    if (s < 15) { na = *(const LAS f32x4*)(vb + (s + 1) * 384 + 64); nb = *(const LAS f32x4*)(vb + (s + 1) * 384 + 128);
                        nk = *(const LAS f32x4*)(vb + (s + 1) * 384 + 192); nr = *(const LAS f32x4*)(vb + (s + 1) * 384 + 256); nv = *(const LAS f32x2*)(vvp + (s + 1) * 384); }
                    float saA, saB, yA, yB;
#define SC_DPP(r, c) "v_add_f32_dpp " r ", " r ", " r " " c " row_mask:0xf bank_mask:0xf bound_ctrl:1\n\t"
                    asm("v_mul_f32 %0, %2, %10\n\tv_mul_f32 %1, %6, %10\n\tv_fmac_f32 %0, %3, %11\n\tv_fmac_f32 %1, %7, %11\n\t"
                        "v_fmac_f32 %0, %4, %12\n\tv_fmac_f32 %1, %8, %12\n\tv_fmac_f32 %0, %5, %13\n\tv_fmac_f32 %1, %9, %13\n\t"
                        "v_fmac_f32 %2, %18, %14\n\tv_fmac_f32 %6, %19, %14\n\t"
                        SC_DPP("%0", "quad_perm:[1,0,3,2]") SC_DPP("%1", "quad_perm:[1,0,3,2]")
                        "v_fmac_f32 %3, %18, %15\n\tv_fmac_f32 %7, %19, %15\n\t"
                        SC_DPP("%0", "quad_perm:[2,3,0,1]") SC_DPP("%1", "quad_perm:[2,3,0,1]")
                        "v_fmac_f32 %4, %18, %16\n\tv_fmac_f32 %8, %19, %16\n\t"
                        SC_DPP("%0", "row_half_mirror") SC_DPP("%1", "row_half_mirror")
                        "v_fmac_f32 %5, %18, %17\n\tv_fmac_f32 %9, %19, %17\n\t"
                        SC_DPP("%0", "row_mirror") SC_DPP("%1", "row_mirror")
                        : "=&v"(saA), "=&v"(saB), "+v"(SA0), "+v"(SA1), "+v"(SA2), "+v"(SA3), "+v"(SB0), "+v"(SB1), "+v"(SB2), "+v"(SB3)
                        : "v"(a4[0]), "v"(a4[1]), "v"(a4[2]), "v"(a4[3]), "v"(k4[0]), "v"(k4[1]), "v"(k4[2]), "v"(k4[3]), "v"(vv[0]), "v"(vv[1]));
                    asm("v_fmac_f32 %0, %10, %12\n\tv_fmac_f32 %4, %11, %12\n\tv_fmac_f32 %1, %10, %13\n\tv_fmac_f32 %5, %11, %13\n\t"
                        "v_fmac_f32 %2, %10, %14\n\tv_fmac_f32 %6, %11, %14\n\tv_fmac_f32 %3, %10, %15\n\tv_fmac_f32 %7, %11, %15\n\t"
                        "v_mul_f32 %8, %0, %16\n\tv_mul_f32 %9, %4, %16\n\tv_fmac_f32 %8, %1, %17\n\tv_fmac_f32 %9, %5, %17\n\t"
                        "v_fmac_f32 %8, %2, %18\n\tv_fmac_f32 %9, %6, %18\n\tv_fmac_f32 %8, %3, %19\n\tv_fmac_f32 %9, %7, %19"
                        : "+v"(SA0), "+v"(SA1), "+v"(SA2), "+v"(SA3), "+v"(SB0), "+v"(SB1), "+v"(SB2), "+v"(SB3), "=&v"(yA), "=&v"(yB)
                        : "v"(saA), "v"(saB), "v"(b4[0]), "v"(b4[1]), "v"(b4[2]), "v"(b4[3]), "v"(r4[0]), "v"(r4[1]), "v"(r4[2]), "v"(r4[3]));
#undef SC_DPP
                    *(LAS f32x2*)(yp + s * 64) = (f32x2){yA, yB};
                    a4 = na; b4 = nb; k4 = nk; r4 = nr; vv = nv;
                }
                {
                    SA0 *= wend[0]; SA1 *= wend[1]; SA2 *= wend[2]; SA3 *= wend[3]; SB0 *= wend[0]; SB1 *= wend[1]; SB2 *= wend[2]; SB3 *= wend[3]; }
            } else {
                if (ch + 1 < NCH) SC_DERIVE(buf ^ 1);
                if (ch + 2 < NCH) SC_LOADRAW(ch + 2);
                if (ch > 0) SC_YREDUCE(ch - 1, buf ^ 1);
            }
            asm volatile("s_waitcnt lgkmcnt(0)" ::: "memory"); __builtin_amdgcn_s_barrier(); asm volatile("" ::: "memory");
        }
        if (wid >= 4) SC_YREDUCE(NCH - 1, (NCH - 1) & 1);
        __syncthreads();
#undef SC_LOADRAW
#undef SC_DERIVE
#undef SC_YREDUCE
    }
}

__device__ __forceinline__ void phase_r4(const Params& p, int jr) {
    const int tid = opaque_tid(), lane = tid & 63, wave = __builtin_amdgcn_readfirstlane(tid >> 6);
    const int gw = BID * 8 + wave, NGW = GRD * 8;
    const bf16_t* P = (const bf16_t*)(p.ws + WS_C); const bf16_t* Y = (const bf16_t*)(p.ws + WS_B);
    const float* BON = (const float*)(p.ws + WS_CUM);
    bf16_t* YG = (bf16_t*)(p.ws + WS_LD);
    const float* mu = p.rwkv_mu + (size_t)jr * RWKV_IN;
    for (int it = gw; it < 2048; it += NGW) {
        const int tile = it >> 2, q = it & 3, c = 256 * q + 4 * lane, hd = 4 * q + (lane >> 4);
        const f32x4 muv = *(const f32x4*)(mu + 2048 + c), mug = *(const f32x4*)(mu + 3072 + c);
        const f32x4 lnw = *(const f32x4*)(p.rwkv_ln_w + jr * 1024 + c), lnb = *(const f32x4*)(p.rwkv_ln_b + jr * 1024 + c);
        const int m0 = tile * 33;
        f32x4 vp = {0.f, 0.f, 0.f, 0.f}, gp = vp;
        if (m0 % LP != 0) { const bf16_t* pr = P + (size_t)(m0 - 1) * 4096 + c;
            const u32x2 c2 = *(const u32x2*)(pr + 2048), d2 = *(const u32x2*)(pr + 3072);
            vp = (f32x4){bflo(c2.x), bfhi(c2.x), bflo(c2.y), bfhi(c2.y)}; gp = (f32x4){bflo(d2.x), bfhi(d2.x), bflo(d2.y), bfhi(d2.y)}; }
        u32x2 c2a, d2a, ywa, c2b, d2b, ywb, c2c, d2c, ywc; float bona, bonb, bonc;
#define R4_LOAD(C2, D2, YW, BN, i_) do { const size_t rr_ = (size_t)(m0 + ((i_) < 33 ? (i_) : 32)); const bf16_t* pr_ = P + rr_ * 4096 + c; \
        C2 = *(const u32x2*)(pr_ + 2048); D2 = *(const u32x2*)(pr_ + 3072); YW = *(const u32x2*)(Y + rr_ * 1024 + c); BN = BON[rr_ * 16 + hd]; } while (0)
#define R4_COMP(C2, D2, YW, BN, i_) do { const size_t row = (size_t)(m0 + (i_)); \
        const f32x4 vc = {bflo(C2.x), bfhi(C2.x), bflo(C2.y), bfhi(C2.y)}, gc = {bflo(D2.x), bfhi(D2.x), bflo(D2.y), bfhi(D2.y)}; \
        const f32x4 yv = {bflo(YW.x), bfhi(YW.x), bflo(YW.y), bfhi(YW.y)}; \
        const f32x4 vl = vc + (vp - vc) * muv, gl = gc + (gp - gc) * mug; \
        vp = vc; gp = gc; \
        const float mean = red16((yv[0] + yv[1]) + (yv[2] + yv[3])) * (1.f / 64.f); \
        const f32x4 d = yv - mean; \
        const float var = red16((d[0] * d[0] + d[1] * d[1]) + (d[2] * d[2] + d[3] * d[3])) * (1.f / 64.f); \
        const float rstd = __builtin_amdgcn_rsqf(var + GN_EPS); \
        const f32x4 o = (d * rstd * lnw + lnb) + BN * vl; \
        u32x2 w; w.x = pk2(o[0] * gl[0] * sigmoidf_(gl[0]), o[1] * gl[1] * sigmoidf_(gl[1])); w.y = pk2(o[2] * gl[2] * sigmoidf_(gl[2]), o[3] * gl[3] * sigmoidf_(gl[3])); \
        *(u32x2*)(YG + row * 1024 + c) = w; } while (0)
        R4_LOAD(c2a, d2a, ywa, bona, 0); R4_LOAD(c2b, d2b, ywb, bonb, 1);
#pragma unroll 1
        for (int i = 0; i < 33; i += 3) {
            R4_LOAD(c2c, d2c, ywc, bonc, i + 2); R4_COMP(c2a, d2a, ywa, bona, i);
            R4_LOAD(c2a, d2a, ywa, bona, i + 3); R4_COMP(c2b, d2b, ywb, bonb, i + 1);
            R4_LOAD(c2b, d2b, ywb, bonb, i + 4); R4_COMP(c2c, d2c, ywc, bonc, i + 2);
        }
#undef R4_LOAD
#undef R4_COMP
    }
}

__device__ __forceinline__ void mini_gemm_tail(const bf16_t* A, const bf16_t* Wt, bf16_t* O, LAS unsigned char* lds) {
    const int tid = opaque_tid(), lane = tid & 63, w = tid >> 6, wr = w >> 2, wc = w & 3;
    LAS bf16_t* As = (LAS bf16_t*)lds;
    LAS bf16_t* Bs = As + 32 * 520;
    for (int t = BID; t < 256; t += GRD) {
        const int r0 = 16384 + 32 * (t >> 4), c0 = 64 * (t & 15);
        u32x4 stg[12];
#define MT_LOAD(h) do { _Pragma("unroll") for (int j_ = 0; j_ < 12; ++j_) { const int c_ = tid + 512 * j_; \
            const bf16_t* src_ = (c_ < 2048) ? A + (size_t)(r0 + (c_ >> 6)) * 1024 + 512 * (h) + 8 * (c_ & 63) : Wt + (size_t)(c0 + ((c_ - 2048) >> 6)) * 1024 + 512 * (h) + 8 * (c_ & 63); \
            stg[j_] = *(const u32x4*)src_; } } while (0)
#define MT_STORE() do { _Pragma("unroll") for (int j_ = 0; j_ < 12; ++j_) { const int c_ = tid + 512 * j_; \
            LAS bf16_t* dst_ = (c_ < 2048) ? As + (c_ >> 6) * 520 + 8 * (c_ & 63) : Bs + ((c_ - 2048) >> 6) * 520 + 8 * (c_ & 63); \
            *(LAS u32x4*)dst_ = stg[j_]; } } while (0)
        f32x4 acc = {0.f, 0.f, 0.f, 0.f};
        const LAS bf16_t* ap = As + (16 * wr + (lane & 15)) * 520 + 8 * (lane >> 4);
        const LAS bf16_t* bp = Bs + (16 * wc + (lane & 15)) * 520 + 8 * (lane >> 4);
        MT_LOAD(0); MT_STORE(); __syncthreads();
        MT_LOAD(1);
#pragma unroll
        for (int k = 0; k < 16; ++k) { const bf16x8 a = *(const LAS bf16x8*)(ap + 32 * k), b = *(const LAS bf16x8*)(bp + 32 * k); acc = __builtin_amdgcn_mfma_f32_16x16x32_bf16(a, b, acc, 0, 0, 0); }
        __syncthreads();
        MT_STORE(); __syncthreads();
#pragma unroll
        for (int k = 0; k < 16; ++k) { const bf16x8 a = *(const LAS bf16x8*)(ap + 32 * k), b = *(const LAS bf16x8*)(bp + 32 * k); acc = __builtin_amdgcn_mfma_f32_16x16x32_bf16(a, b, acc, 0, 0, 0); }
        __syncthreads();
#undef MT_LOAD
#undef MT_STORE
        bf16_t* op = O + (size_t)(r0 + 16 * wr + 4 * (lane >> 4)) * 1024 + c0 + 16 * wc + (lane & 15);
#pragma unroll
        for (int r = 0; r < 4; ++r) op[(size_t)r * 1024] = (bf16_t)(pk2(acc[r], 0.f) & 0xffffu);
    }
}

#define XB_TMO      128
#define XB_XCNT(j)  (256  + 64 * (j))
#define XB_XSUB(j)  (1280 + 64 * (j))
#define XB_XGEN(j)  (2304 + 64 * (j))
#define XB_TOP      3328
#define XB_TOPGEN   3392
#define XCD_BAR_WORDS 3456
#define XB_SPIN_CAP (1u << 18)

__device__ __forceinline__ unsigned xb_ld(unsigned* p)              { return __hip_atomic_load(p, __ATOMIC_RELAXED, __HIP_MEMORY_SCOPE_AGENT); }
__device__ __forceinline__ unsigned xb_add(unsigned* p, unsigned v) { return __hip_atomic_fetch_add(p, v, __ATOMIC_RELAXED, __HIP_MEMORY_SCOPE_AGENT); }
__device__ __forceinline__ unsigned xb_xcc_id() { return (unsigned)__builtin_amdgcn_s_getreg((3 << 11) | 20) & 0xFu; }
#define XB_SPIN(cond, bar) do { unsigned _sp = 0; while (cond) { __builtin_amdgcn_s_sleep(1); \
    if ((++_sp & 255u) == 0u) { if (xb_ld(&(bar)[XB_TMO])) break; if (_sp > XB_SPIN_CAP) { atomicAdd(&(bar)[XB_TMO], 1u); break; } } } } while (0)

struct XcdBarrier {
    unsigned* bar; unsigned x;
    volatile LAS unsigned* st;
};

__device__ __forceinline__ XcdBarrier xcd_barrier_post(unsigned* bar, volatile LAS unsigned* st) {
    XcdBarrier b; b.bar = bar; b.x = xb_xcc_id(); b.st = st;
    if (threadIdx.x == 0) (void)xb_add(&bar[XB_XCNT(b.x)], 1u);
    return b;
}
__device__ __forceinline__ void xcd_barrier_complete(unsigned* bar, unsigned x, unsigned& nloc, unsigned& nx) {
    const unsigned G = gridDim.x * gridDim.y * gridDim.z;
    unsigned sum, cnt, mine, sp = 0u;
    for (;;) {
        sum = 0u; cnt = 0u; mine = 0u;
#pragma unroll
        for (unsigned j = 0; j < 16; ++j) { const unsigned c = xb_ld(&bar[XB_XCNT(j)]); sum += c; cnt += (c > 0u) ? 1u : 0u; mine = (j == x) ? c : mine; }
        if (sum == G) break;
        __builtin_amdgcn_s_sleep(1);
        if ((++sp & 255u) == 0u) { if (xb_ld(&bar[XB_TMO])) break; if (sp > XB_SPIN_CAP) { atomicAdd(&bar[XB_TMO], 1u); break; } }
    }
    nloc = mine > 0u ? mine : 1u; nx = cnt > 0u ? cnt : 1u;
}

__device__ __forceinline__ void xcd_barrier(const XcdBarrier& b) {
    asm volatile("s_waitcnt vmcnt(0)" ::: "memory");
    __syncthreads();
    if (threadIdx.x == 0) {
        unsigned* bar = b.bar;
        __builtin_amdgcn_s_waitcnt(0);
        unsigned nloc = b.st[0], nx = b.st[1];
        if (nloc == 0u) { xcd_barrier_complete(bar, b.x, nloc, nx); b.st[0] = nloc; b.st[1] = nx; }
        const unsigned old = xb_add(&bar[XB_XSUB(b.x)], 1u);
        const unsigned gen = old / nloc;
        if (old + 1u == (gen + 1u) * nloc) {
            __builtin_amdgcn_fence(__ATOMIC_RELEASE, "agent");
            asm volatile("s_waitcnt vmcnt(0)" ::: "memory");
            const unsigned og = xb_add(&bar[XB_TOP], 1u);
            const unsigned tg = og / nx;
            if (og + 1u == (tg + 1u) * nx) xb_add(&bar[XB_TOPGEN], 1u);
            else XB_SPIN(xb_ld(&bar[XB_TOPGEN]) == tg, bar);
            __builtin_amdgcn_fence(__ATOMIC_ACQUIRE, "agent");
            xb_add(&bar[XB_XGEN(b.x)], 1u);
            asm volatile("s_waitcnt vmcnt(0)" ::: "memory");
        } else {
            XB_SPIN(xb_ld(&bar[XB_XGEN(b.x)]) == gen, bar);
            __builtin_amdgcn_fence(__ATOMIC_ACQUIRE, "agent");
            asm volatile("s_waitcnt vmcnt(0)" ::: "memory");
        }
    }
    __syncthreads();
}

__global__ void __launch_bounds__(512, 2) fwd_megakernel(Params p) {
    extern __shared__ __attribute__((aligned(16))) unsigned char lds_raw[];
    LAS unsigned char* lds = (LAS unsigned char*)lds_raw;
    cg::grid_group grid = cg::this_grid();
    bf16_t* U = (bf16_t*)(p.ws + WS_B); bf16_t* WIN = (bf16_t*)(p.ws + WS_WIN); bf16_t* WOUT = (bf16_t*)(p.ws + WS_WOUT);
    bf16_t* P = (bf16_t*)(p.ws + WS_C); bf16_t* PL = (bf16_t*)(p.ws + WS_PL); float* MB = (float*)(p.ws + WS_C);
    volatile LAS unsigned* st = (volatile LAS unsigned*)(lds + LDS_BYTES - 64);
    if (threadIdx.x < 2) st[threadIdx.x] = 0u;
    __syncthreads();
    XcdBarrier bar = xcd_barrier_post((unsigned*)p.ws + 4096, st);
#define GBAR() do { XcdBarrier bb_ = bar; asm volatile("" : "+s"(bb_.x)); xcd_barrier(bb_); } while (0)
    phase_e<0>(p, lds, 0, -1);
    if (p.out == nullptr) grid.sync();
    GBAR();
#pragma unroll 1
    for (int layer = 0; layer < 4; ++layer) {
        const int jr = layer >> 1; const bool rw = (layer & 1) != 0;
        if (!rw) phase_cumsum(p, lds);
        {   pg8::Gemm g{U, WIN, MROWS, rw ? 4352 : 4096, 1024}; pg8::StaticOrder S; S.init(MROWS, rw ? 4352 : 4096, (int)GRD, (int)BID);
            pg8::EpiP E{P, PL, rw ? 1.f : 0.125f * LOG2E, rw ? 0 : 1024};
            pg8::gemm_phase<pg8::EpiP, pg8::StaticOrder, true, true>(lds, g, S, E); }
        GBAR();
        if (!rw) { phase_attn(p, lds, (unsigned*)p.ws + 8192 + 64 * jr); GBAR(); }
        else { phase_lora_prep(p, jr); GBAR();
            {   int kl_ = 256; asm volatile("" : "+s"(kl_));
                pg8::Gemm g{(const bf16_t*)(p.ws + WS_WIN), (const bf16_t*)(p.ws + WS_CUM), MROWS, 2048, kl_}; pg8::StaticOrder S; S.init(MROWS, 2048, (int)GRD, (int)BID);
                pg8::EpiLora E{(bf16_t*)(p.ws + WS_LD), (bf16_t*)(p.ws + WS_AA)};
                pg8::gemm_phase<pg8::EpiLora, pg8::StaticOrder, true, true>(lds, g, S, E); }
            GBAR(); phase_scan(p, lds, jr); GBAR(); phase_r4(p, jr); GBAR(); }
        {   pg8::Gemm g{rw ? (const bf16_t*)(p.ws + WS_LD) : (const bf16_t*)(p.ws + WS_B), WOUT, 16384, 1024, 1024}; pg8::StaticOrder S; S.init(16384, 1024, (int)GRD, (int)BID);
            pg8::EpiM E{(bf16_t*)MB};
            pg8::gemm_phase<pg8::EpiM, pg8::StaticOrder, true, true>(lds, g, S, E);
            mini_gemm_tail(g.A, WOUT, (bf16_t*)MB, lds); }
        GBAR();
        phase_e<1>(p, lds, layer < 3 ? layer + 1 : -1, layer);
        if (layer < 3) GBAR();
    }
}

extern "C" void kernel_launch(void* const* d_in, const int* in_sizes, int n_in, void* d_out, int out_size, void* d_ws, size_t ws_size, hipStream_t stream) {
    static int grid_blocks = 0;
    if (grid_blocks == 0) {
        if (n_in != 19 || ws_size < WS_END) { fprintf(stderr, "kernel_launch: unexpected inputs (n_in %d, ws %zu)\n", n_in, ws_size); grid_blocks = -1; return; }
        int dev = 0, cus = 0, per_cu = 0;
        hipGetDevice(&dev); hipDeviceGetAttribute(&cus, hipDeviceAttributeMultiprocessorCount, dev);
        if (hipFuncSetAttribute((const void*)fwd_megakernel, hipFuncAttributeMaxDynamicSharedMemorySize, LDS_BYTES) != hipSuccess) { fprintf(stderr, "kernel_launch: hipFuncSetAttribute failed\n"); grid_blocks = -1; return; }
        if (hipOccupancyMaxActiveBlocksPerMultiprocessor(&per_cu, (const void*)fwd_megakernel, 512, LDS_BYTES) != hipSuccess || per_cu < 1) { fprintf(stderr, "kernel_launch: occupancy query failed (%d)\n", per_cu); (void)hipGetLastError(); grid_blocks = -1; return; }
        grid_blocks = cus * (per_cu > 1 ? 1 : per_cu);
    }
    if (grid_blocks < 0) return;
    if (hipMemsetAsync(d_ws, 0, 65536, stream) != hipSuccess) { fprintf(stderr, "kernel_launch: memset failed\n"); return; }
    Params p{};
    const float** f = (const float**)&p;
    for (int i = 0; i < 19; ++i) f[i] = (const float*)d_in[i];
    p.out = (float*)d_out; p.ws = (unsigned char*)d_ws;
    void* args[] = {&p};
    hipError_t e = hipLaunchCooperativeKernel((const void*)fwd_megakernel, dim3(grid_blocks), dim3(512), args, LDS_BYTES, stream);
    if (e != hipSuccess) fprintf(stderr, "cooperative launch failed: %s (grid %d)\n", hipGetErrorString(e), grid_blocks);
}
```

```cpp
#include <hip/hip_runtime.h>
#include <hip/hip_cooperative_groups.h>
#include <cstdio>
#include <cstdint>
namespace cg = cooperative_groups;
__device__ __forceinline__ int opaque_tid() { int t = threadIdx.x; asm volatile("" : "+v"(t)); return t; }
__device__ __forceinline__ int opaque_bid() { int t = blockIdx.x; asm volatile("" : "+s"(t)); return t; }
__device__ __forceinline__ int opaque_grid() { int t = gridDim.x; asm volatile("" : "+s"(t)); return t; }
namespace pg8 {
#define PG8_LAS __attribute__((address_space(3)))
typedef unsigned short bf16_t;
typedef short bf16x8 __attribute__((ext_vector_type(8)));
typedef float f32x4 __attribute__((ext_vector_type(4)));
typedef unsigned u32x4 __attribute__((ext_vector_type(4)));
constexpr int BM = 256, BK = 64, HALF = 128, HTB = HALF * BK * 2  , STAGE_BYTES = 8 * HTB, NXCD = 8, WGM = 8;

__host__ __device__ __forceinline__ int lds_byte(int r, int c) { const int st = (r >> 4) * 2 + (c >> 5), rr = r & 15, cc = c & 31, ob = rr * 64 + cc * 2; return st * 1024 + (ob ^ (((ob >> 9) & 1) << 5)); }
__host__ __device__ __forceinline__ void stage_rc(int b, int& R, int& C) { const int st = b / 1024, sb = b % 1024, swz = sb ^ (((sb >> 9) & 1) << 5); R = (st >> 1) * 16 + swz / 64; C = (st & 1) * 32 + (swz % 64) / 2; }
__host__ __device__ __forceinline__ int perm32(int rho) { const int n = rho >> 4, i = rho & 15; return 8 * (i >> 2) + 4 * n + (i & 3); }

struct Unit { int pm, pn; };
struct Gemm { const bf16_t* A; const bf16_t* Bt; int M, N, K; };

struct StaticOrder {
    int nM, nN, nwg, G, c;
    __host__ __device__ void init(int M, int N, int G_, int c_) { nM = M / BM; nN = N / BM; nwg = nM * nN; G = G_; c = c_; }
    __host__ __device__ bool next(int i, Unit& u) const {
        const long L = (long)i * G + c; if (L >= nwg) return false;
        int wgid = (int)L; { const int q = nwg / NXCD, r = nwg % NXCD, xcd = wgid % NXCD, off = wgid / NXCD; wgid = (xcd < r ? xcd * (q + 1) : r * (q + 1) + (xcd - r) * q) + off; }
        const int nig = WGM * nN, gid = wgid / nig, fm = gid * WGM, gsz = (nM - fm) < WGM ? (nM - fm) : WGM;
        u.pm = fm + ((wgid % nig) % gsz); u.pn = (wgid % nig) / gsz; return true;
    }
    __device__ __forceinline__ void a_ready(const Unit&) const {}
    __device__ __forceinline__ void done(const Unit&) const {}
};

__device__ __forceinline__ unsigned cvt_pk_bf16(float lo, float hi) { unsigned r; asm volatile("v_cvt_pk_bf16_f32 %0, %1, %2" : "=v"(r) : "v"(lo), "v"(hi)); return r; }
typedef float f32x2 __attribute__((ext_vector_type(2)));
typedef __bf16 bf16x2_t __attribute__((ext_vector_type(2)));
__device__ __forceinline__ unsigned pk2(float lo, float hi) { f32x2 v = {lo, hi}; bf16x2_t b = __builtin_convertvector(v, bf16x2_t); return __builtin_bit_cast(unsigned, b); }
struct EpiP {
    static constexpr bool PERM = true, AFTER_DRAIN = false;
    bf16_t* P; bf16_t* PL; float qscale; int qcols;
    __device__ __forceinline__ void operator()(const f32x4 (&acc)[2][2][4][2], const Unit& u, int wr, int wc, int fr, int fq) const {
        const int row0 = u.pm * BM + wr * 64 + fr; const int colt = u.pn * BM;
        bf16_t* base; int ldc, c0;
        if (colt < 4096) { base = P; ldc = 4096; c0 = colt; } else { base = PL; ldc = 256; c0 = colt - 4096; }
        const float sc = (colt < qcols) ? qscale : 1.f;
        const int col0 = c0 + wc * 32 + 8 * fq;
#pragma unroll
        for (int ai = 0; ai < 2; ++ai)
#pragma unroll
            for (int m = 0; m < 4; ++m) { bf16_t* rowp = base + (size_t)(row0 + ai * HALF + m * 16) * ldc + col0;
#pragma unroll
                for (int bj = 0; bj < 2; ++bj) { const f32x4 v0 = acc[ai][bj][m][0] * sc, v1 = acc[ai][bj][m][1] * sc;
                    u32x4 w; w.x = pk2(v0[0], v0[1]); w.y = pk2(v0[2], v0[3]); w.z = pk2(v1[0], v1[1]); w.w = pk2(v1[2], v1[3]);
                    *(u32x4*)(rowp + bj * HALF) = w; } }
    }
};
struct EpiM {
    static constexpr bool PERM = true, AFTER_DRAIN = false;
    bf16_t* O;
    __device__ __forceinline__ void operator()(const f32x4 (&acc)[2][2][4][2], const Unit& u, int wr, int wc, int fr, int fq) const {
        const int row0 = u.pm * BM + wr * 64 + fr; const int col0 = u.pn * BM + wc * 32 + 8 * fq;
#pragma unroll
        for (int ai = 0; ai < 2; ++ai)
#pragma unroll
            for (int m = 0; m < 4; ++m) { bf16_t* rowp = O + (size_t)(row0 + ai * HALF + m * 16) * 1024 + col0;
#pragma unroll
                for (int bj = 0; bj < 2; ++bj) { const f32x4 v0 = acc[ai][bj][m][0], v1 = acc[ai][bj][m][1];
                    u32x4 w; w.x = pk2(v0[0], v0[1]); w.y = pk2(v0[2], v0[3]); w.z = pk2(v1[0], v1[1]); w.w = pk2(v1[2], v1[3]);
                    *(u32x4*)(rowp + bj * HALF) = w; } }
    }
};

template <int CTRL> __device__ __forceinline__ float dppz_(float v) { return __int_as_float(__builtin_amdgcn_update_dpp(0, __float_as_int(v), CTRL, 0xF, 0xF, true)); }
typedef _Float16 f16x2_t __attribute__((ext_vector_type(2)));
__device__ __forceinline__ unsigned pkh2(float lo, float hi) { f16x2_t v = {(_Float16)lo, (_Float16)hi}; return __builtin_bit_cast(unsigned, v); }
struct EpiLora {
    static constexpr bool PERM = true, AFTER_DRAIN = false;
    bf16_t* LD; bf16_t* AA;
    __device__ __forceinline__ void operator()(const f32x4 (&acc)[2][2][4][2], const Unit& u, int wr, int wc, int fr, int fq) const {
        const int row0 = u.pm * BM + wr * 64 + fr; const int colt = u.pn * BM; const int t = colt >> 10;
        const int cbase = (colt & 1023) + wc * 32 + 8 * fq;
        bf16_t* base = t ? AA : LD; const float sc = t ? 1.f : -0.6065306597126334f * 1.4426950408889634f;
#pragma unroll
        for (int ai = 0; ai < 2; ++ai)
#pragma unroll
            for (int m = 0; m < 4; ++m) { bf16_t* rowp = base + (size_t)(row0 + ai * HALF + m * 16) * 1024 + cbase;
#pragma unroll
                for (int bj = 0; bj < 2; ++bj) { f32x4 v0 = acc[ai][bj][m][0], v1 = acc[ai][bj][m][1];
#pragma unroll
                    for (int e = 0; e < 4; ++e) { v0[e] = sc * __builtin_amdgcn_rcpf(1.f + __builtin_amdgcn_exp2f(-1.4426950408889634f * v0[e])); v1[e] = sc * __builtin_amdgcn_rcpf(1.f + __builtin_amdgcn_exp2f(-1.4426950408889634f * v1[e])); }
                    u32x4 w;
                    if (t == 0) {
#pragma unroll
                        for (int e = 0; e < 4; ++e) { float x = v0[e], y = v1[e];
                            x += dppz_<0x111>(x); y += dppz_<0x111>(y); x += dppz_<0x112>(x); y += dppz_<0x112>(y); x += dppz_<0x114>(x); y += dppz_<0x114>(y); x += dppz_<0x118>(x); y += dppz_<0x118>(y);
                            v0[e] = x; v1[e] = y; }
                        w.x = pkh2(v0[0], v0[1]); w.y = pkh2(v0[2], v0[3]); w.z = pkh2(v1[0], v1[1]); w.w = pkh2(v1[2], v1[3]);
                    } else { w.x = pk2(v0[0], v0[1]); w.y = pk2(v0[2], v0[3]); w.z = pk2(v1[0], v1[1]); w.w = pk2(v1[2], v1[3]); }
                    *(u32x4*)(rowp + bj * HALF) = w; __builtin_amdgcn_sched_barrier(0); } }
    }
};
template <class Epi, class Sched, bool ALIGN_EPI = false, bool SP2 = false>
__device__ __forceinline__ void gemm_phase(PG8_LAS unsigned char* lds, const Gemm g, const Sched& S, const Epi& E) {
    const int tid = opaque_tid(), wid = __builtin_amdgcn_readfirstlane(tid >> 6), lane = tid & 63, wr = wid >> 2, wc = wid & 3, fr = lane & 15, fq = lane >> 4;
    const int K = g.K, nt = K / BK;
    unsigned voffA[2], voffB[2];
#pragma unroll
    for (int i = 0; i < 2; ++i) { int R, C; stage_rc(tid * 16 + i * 8192, R, C); const int Rb = Epi::PERM ? ((R & ~31) + perm32(R & 31)) : R;
        voffA[i] = (unsigned)(R * K + C) * 2u; voffB[i] = (unsigned)(Rb * K + C) * 2u; }
    const size_t kstep = (size_t)(BK * 2);
    const size_t hstep = (size_t)HALF * K * 2;
    const size_t tstep = 2 * hstep;
    const unsigned ldsw = (unsigned)wid * 1024u;
    const int aoff = lds_byte(wr * 64 + fr, fq * 8), boff = lds_byte(wc * 32 + fr, fq * 8);
#define PG8_SA(b, h) (((b) * 2 + (h)) * HTB)
#define PG8_SB(b, h) ((4 + (b) * 2 + (h)) * HTB)
#define PG8_STAGE(bufoff, gbase, voff) do { _Pragma("unroll") for (int _i = 0; _i < 2; ++_i) \
        __builtin_amdgcn_global_load_lds((const unsigned*)((const char*)(gbase) + (voff)[_i]), (PG8_LAS unsigned*)(lds + (bufoff) + ldsw + _i * 8192), 16, 0, 0); } while (0)
#define PG8_LDA(dst, b, h) do { _Pragma("unroll") for (int m = 0; m < 4; ++m) _Pragma("unroll") for (int k = 0; k < 2; ++k) dst[m][k] = *(const PG8_LAS bf16x8*)(lds + PG8_SA(b, h) + aoff + m * 2048 + k * 1024); } while (0)
#define PG8_LDB(dst, b, h) do { _Pragma("unroll") for (int n = 0; n < 2; ++n) _Pragma("unroll") for (int k = 0; k < 2; ++k) dst[n][k] = *(const PG8_LAS bf16x8*)(lds + PG8_SB(b, h) + boff + n * 2048 + k * 1024); } while (0)
#define PG8_MMA(ai, bj, At, Bt) do { __builtin_amdgcn_s_setprio(1); _Pragma("unroll") for (int m = 0; m < 4; ++m) _Pragma("unroll") for (int n = 0; n < 2; ++n) _Pragma("unroll") for (int k = 0; k < 2; ++k) \
        acc[ai][bj][m][n] = __builtin_amdgcn_mfma_f32_16x16x32_bf16(Bt[n][k], At[m][k], acc[ai][bj][m][n], 0, 0, 0); __builtin_amdgcn_s_setprio(0); } while (0)
#define PG8_WAIT_V(n) asm volatile("s_waitcnt vmcnt(" #n ")" ::: "memory")
#define PG8_WAIT_L(n) asm volatile("s_waitcnt lgkmcnt(" #n ")" ::: "memory")
#define PG8_BAR __builtin_amdgcn_s_barrier()
#define PG8_SCHED __builtin_amdgcn_sched_barrier(0)
    Unit cur, nxt; int ui = 0;
    if (!S.next(0, cur)) return;
    f32x4 acc[2][2][4][2];
#pragma unroll
    for (int a = 0; a < 2; ++a)
#pragma unroll
        for (int b = 0; b < 2; ++b)
#pragma unroll
            for (int m = 0; m < 4; ++m)
#pragma unroll
                for (int n = 0; n < 2; ++n) acc[a][b][m][n] = (f32x4){0.f, 0.f, 0.f, 0.f};
    bf16x8 At[4][2], B0[2][2], B1[2][2];
    const char* cA = (const char*)g.A + (size_t)cur.pm * tstep; const char* cB = (const char*)g.Bt + (size_t)cur.pn * tstep;
    S.a_ready(cur);
    if constexpr (SP2) {
        PG8_STAGE(PG8_SB(0, 0), cB, voffB); PG8_STAGE(PG8_SB(0, 1), cB + hstep, voffB); PG8_STAGE(PG8_SA(0, 0), cA, voffA); PG8_STAGE(PG8_SA(0, 1), cA + hstep, voffA);
        if (wr == 1) PG8_BAR;
        PG8_WAIT_V(2); PG8_BAR;
        PG8_STAGE(PG8_SB(1, 0), cB + kstep, voffB); PG8_STAGE(PG8_SA(1, 0), cA + kstep, voffA); PG8_STAGE(PG8_SB(1, 1), cB + hstep + kstep, voffB);
        PG8_WAIT_V(6); PG8_BAR;
    } else {
        PG8_STAGE(PG8_SB(0, 0), cB, voffB); PG8_STAGE(PG8_SA(0, 0), cA, voffA); PG8_STAGE(PG8_SB(0, 1), cB + hstep, voffB); PG8_STAGE(PG8_SA(0, 1), cA + hstep, voffA);
        if (wr == 1) PG8_BAR;
        PG8_WAIT_V(4); PG8_BAR;
        PG8_STAGE(PG8_SB(1, 0), cB + kstep, voffB); PG8_STAGE(PG8_SA(1, 0), cA + kstep, voffA); PG8_STAGE(PG8_SB(1, 1), cB + hstep + kstep, voffB);
        PG8_WAIT_V(6); PG8_BAR;
    }
    for (;;) {
        const bool has_next = S.next(ui + 1, nxt);
        const char* nA = has_next ? (const char*)g.A + (size_t)nxt.pm * tstep : cA; const char* nB = has_next ? (const char*)g.Bt + (size_t)nxt.pn * tstep : cB;
        for (int t = 0; t < nt; t += 2) {
            const bool last = (t == nt - 2);
            const char* a1 = cA + (size_t)(t + 1) * kstep;
            const char* a2 = last ? nA : cA + (size_t)(t + 2) * kstep; const char* b2 = last ? nB : cB + (size_t)(t + 2) * kstep;
            const char* a3 = a2 + kstep; const char* b3 = b2 + kstep;
            if (last && has_next) S.a_ready(nxt);
            if constexpr (SP2) {
            PG8_LDB(B0, 0, 0); PG8_LDB(B1, 0, 1); PG8_SCHED; PG8_LDA(At, 0, 0); PG8_STAGE(PG8_SA(1, 1), a1 + hstep, voffA);
            PG8_WAIT_V(8); PG8_WAIT_L(0); PG8_BAR; PG8_MMA(0, 0, At, B0); PG8_MMA(0, 1, At, B1); PG8_BAR; PG8_SCHED;
            PG8_LDA(At, 0, 1); PG8_STAGE(PG8_SB(0, 0), b2, voffB); PG8_STAGE(PG8_SB(0, 1), b2 + hstep, voffB); PG8_STAGE(PG8_SA(0, 0), a2, voffA);
            PG8_WAIT_V(8); PG8_WAIT_L(0); PG8_BAR; PG8_MMA(1, 0, At, B0); PG8_MMA(1, 1, At, B1); PG8_BAR; PG8_SCHED;
            PG8_LDB(B0, 1, 0); PG8_LDB(B1, 1, 1); PG8_SCHED; PG8_LDA(At, 1, 0); PG8_STAGE(PG8_SA(0, 1), a2 + hstep, voffA);
            PG8_WAIT_V(8); PG8_WAIT_L(0); PG8_BAR; PG8_MMA(0, 0, At, B0); PG8_MMA(0, 1, At, B1); PG8_BAR; PG8_SCHED;
            PG8_LDA(At, 1, 1); PG8_STAGE(PG8_SB(1, 0), b3, voffB); PG8_STAGE(PG8_SB(1, 1), b3 + hstep, voffB); PG8_STAGE(PG8_SA(1, 0), a3, voffA);
            PG8_WAIT_V(8); PG8_WAIT_L(0); PG8_BAR; PG8_MMA(1, 0, At, B0); PG8_MMA(1, 1, At, B1); PG8_BAR; PG8_SCHED;
            } else {
            PG8_LDB(B0, 0, 0); PG8_SCHED; PG8_LDA(At, 0, 0); PG8_STAGE(PG8_SA(1, 1), a1 + hstep, voffA);
            PG8_WAIT_L(8); PG8_BAR; PG8_WAIT_L(0); PG8_MMA(0, 0, At, B0); PG8_BAR; PG8_SCHED;
            PG8_LDB(B1, 0, 1); PG8_STAGE(PG8_SB(0, 0), b2, voffB);
            PG8_BAR; PG8_WAIT_L(0); PG8_MMA(0, 1, At, B1); PG8_BAR;
            PG8_LDA(At, 0, 1); PG8_STAGE(PG8_SA(0, 0), a2, voffA);
            PG8_BAR; PG8_WAIT_L(0); PG8_MMA(1, 0, At, B0); PG8_BAR; PG8_SCHED;
            PG8_STAGE(PG8_SB(0, 1), b2 + hstep, voffB);
            PG8_WAIT_V(6); PG8_BAR; PG8_MMA(1, 1, At, B1); PG8_BAR;
            PG8_LDB(B0, 1, 0); PG8_SCHED; PG8_LDA(At, 1, 0); PG8_STAGE(PG8_SA(0, 1), a2 + hstep, voffA);
            PG8_WAIT_L(8); PG8_BAR; PG8_WAIT_L(0); PG8_MMA(0, 0, At, B0); PG8_BAR; PG8_SCHED;
            PG8_LDB(B1, 1, 1); PG8_STAGE(PG8_SB(1, 0), b3, voffB);
            PG8_BAR; PG8_WAIT_L(0); PG8_MMA(0, 1, At, B1); PG8_BAR;
            PG8_LDA(At, 1, 1); PG8_STAGE(PG8_SA(1, 0), a3, voffA);
            PG8_BAR; PG8_WAIT_L(0); PG8_MMA(1, 0, At, B0); PG8_BAR; PG8_SCHED;
            PG8_STAGE(PG8_SB(1, 1), b3 + hstep, voffB);
            PG8_WAIT_V(6); PG8_BAR; PG8_MMA(1, 1, At, B1); PG8_BAR;
            }
        }
        if constexpr (ALIGN_EPI) { if (wr == 0) PG8_BAR; }
        if constexpr (!Epi::AFTER_DRAIN) { E(acc, cur, wr, wc, fr, fq); S.done(cur); }
        if (!has_next) break;
#pragma unroll
        for (int a = 0; a < 2; ++a)
#pragma unroll
            for (int b = 0; b < 2; ++b)
#pragma unroll
                for (int m = 0; m < 4; ++m)
#pragma unroll
                    for (int n = 0; n < 2; ++n) acc[a][b][m][n] = (f32x4){0.f, 0.f, 0.f, 0.f};
        cur = nxt; cA = nA; cB = nB; ++ui;
        if constexpr (ALIGN_EPI) { if (wr == 1) PG8_BAR; }
    }
    PG8_WAIT_V(0);
    if constexpr (!ALIGN_EPI) { if (wr == 0) PG8_BAR; }
    PG8_BAR;
    if constexpr (Epi::AFTER_DRAIN) { E.fused(acc, cur, wr, wc, fr, fq, lds, wid, lane); S.done(cur); }
#undef PG8_SA
#undef PG8_SB
#undef PG8_STAGE
#undef PG8_LDA
#undef PG8_LDB
#undef PG8_MMA
#undef PG8_WAIT_V
#undef PG8_WAIT_L
#undef PG8_BAR
#undef PG8_SCHED
}
}
#define LAS __attribute__((address_space(3)))
#define BID opaque_bid()
#define GRD opaque_grid()
typedef unsigned short bf16_t;
typedef short bf16x8 __attribute__((ext_vector_type(8)));
typedef short s16x4 __attribute__((ext_vector_type(4)));
typedef float f32x4 __attribute__((ext_vector_type(4)));
typedef float f32x2 __attribute__((ext_vector_type(2)));
typedef float f32x16 __attribute__((ext_vector_type(16)));
typedef unsigned u32x4 __attribute__((ext_vector_type(4)));
typedef unsigned u32x2 __attribute__((ext_vector_type(2)));

constexpr int NB = 8, SEQ = 2048, NMETA = 16, LSEQ = SEQ + NMETA  , LP = 2112  , DM = 1024;
constexpr int MROWS = NB * LP;
constexpr int FOX_IN = 4112, RWKV_IN = 4224;
constexpr float NORM_EPS = 1e-6f, GN_EPS = 64e-5f, LOG2E = 1.4426950408889634f;
constexpr float DECAY_SCALE = 0.6065306597126334f;
constexpr int LDS_BYTES = 147456;
constexpr size_t MiB = 1u << 20;
constexpr size_t WS_WIN = 1 * MiB;
constexpr size_t WS_WOUT = 10 * MiB;
constexpr size_t WS_HMETA = 12 * MiB;
constexpr size_t WS_CUM = 13 * MiB;
constexpr size_t WS_PL = 15 * MiB;
constexpr size_t WS_B = 24 * MiB;
constexpr size_t WS_C = 57 * MiB;
constexpr size_t WS_LD = 189 * MiB;
constexpr size_t WS_AA = 222 * MiB;
constexpr size_t WS_END = 255 * MiB;
static_assert(WS_B + (size_t)MROWS * 1024 * 2 <= WS_C && WS_C + (size_t)MROWS * 4096 * 2 <= WS_LD && WS_LD + (size_t)MROWS * 2048 <= WS_AA && WS_AA + (size_t)MROWS * 2048 <= WS_END, "ws map");
static_assert(WS_PL + (size_t)MROWS * 512 <= WS_B && WS_CUM + (size_t)MROWS * 64 <= WS_PL, "ws map 2");

struct Params {
    const float *x, *meta, *norm_pre, *norm_post, *fox_w_in, *fox_b_f, *fox_w_out, *rwkv_w_in, *rwkv_mu, *rwkv_w0, *rwkv_w_up, *rwkv_a0, *rwkv_a_up,
        *rwkv_k_k, *rwkv_k_a, *rwkv_r_k, *rwkv_ln_w, *rwkv_ln_b, *rwkv_w_out;
    float* out; unsigned char* ws;
};

__device__ __forceinline__ float wave_sum(float v) {
#pragma unroll
    for (int o = 1; o < 64; o <<= 1) v += __shfl_xor(v, o);
    return v;
}
__device__ __forceinline__ unsigned pk2(float lo, float hi) { return pg8::pk2(lo, hi); }
__device__ __forceinline__ float bflo(unsigned w) { return __uint_as_float(w << 16); }
__device__ __forceinline__ float bfhi(unsigned w) { return __uint_as_float(w & 0xffff0000u); }
template <int CTRL> __device__ __forceinline__ float dppf(float v) { return __int_as_float(__builtin_amdgcn_update_dpp(0, __float_as_int(v), CTRL, 0xF, 0xF, true)); }
__device__ __forceinline__ float red16(float v) {
    v += dppf<0xB1>(v); v += dppf<0x4E>(v); v += dppf<0x141>(v); v += dppf<0x140>(v); return v;
}
__device__ __forceinline__ float xhalf_max(float m) { auto rr = __builtin_amdgcn_permlane32_swap(__float_as_uint(m), __float_as_uint(m), false, false); return __builtin_fmaxf(__uint_as_float(rr[0]), __uint_as_float(rr[1])); }
__device__ __forceinline__ float xhalf_sum(float m) { auto rr = __builtin_amdgcn_permlane32_swap(__float_as_uint(m), __float_as_uint(m), false, false); return __uint_as_float(rr[0]) + __uint_as_float(rr[1]); }
__device__ __forceinline__ float sigmoidf_(float x) { return 1.f / (1.f + __expf(-x)); }
#define LDS_WAIT() asm volatile("s_waitcnt lgkmcnt(0)" ::: "memory")

__device__ __forceinline__ void transpose_item(const float* W, int ldw, bf16_t* WT, LAS float* scr, int kb, int nb, int lane) {
    const int k0 = 64 * kb, n0 = 32 * nb;
    {   f32x4 wv_[8];
#pragma unroll
        for (int i = 0; i < 8; ++i) wv_[i] = *(const f32x4*)(W + (size_t)(k0 + 8 * i + (lane >> 3)) * ldw + n0 + 4 * (lane & 7));
#pragma unroll
        for (int i = 0; i < 8; ++i) { LAS float* d_ = scr + (8 * i + (lane >> 3)) * 33 + 4 * (lane & 7); d_[0] = wv_[i][0]; d_[1] = wv_[i][1]; d_[2] = wv_[i][2]; d_[3] = wv_[i][3]; } }
    LDS_WAIT();
    const int c = lane & 7;
#pragma unroll
    for (int j = 0; j < 4; ++j) { const int n = (lane >> 3) + 8 * j; const LAS float* s = scr + (8 * c) * 33 + n;
        u32x4 o; o.x = pk2(s[0 * 33], s[1 * 33]); o.y = pk2(s[2 * 33], s[3 * 33]); o.z = pk2(s[4 * 33], s[5 * 33]); o.w = pk2(s[6 * 33], s[7 * 33]);
        *(u32x4*)(WT + (size_t)(n0 + n) * 1024 + k0 + 8 * c) = o; }
    LDS_WAIT();
}

template <int MODE>
__device__ __forceinline__ void phase_e(const Params& p, LAS unsigned char* lds, int next, int prev) {
    const int tid = opaque_tid(), lane = tid & 63, wave = __builtin_amdgcn_readfirstlane(tid >> 6);
    const int G = GRD, gw = BID * 8 + wave, NGW = G * 8;
    bf16_t* U = (bf16_t*)(p.ws + WS_B);
    float* CUM = (float*)(p.ws + WS_CUM);
    float* HMETA = (float*)(p.ws + WS_HMETA);
    const bf16_t* MB = (const bf16_t*)(p.ws + WS_C);
    const bool next_fox = (next >= 0) && ((next & 1) == 0);
    LAS float* WfT = (LAS float*)lds;
    LAS float* scr = (LAS float*)(lds + 65536 + wave * 8448);
    if (next >= 0) {
        const int jn = next >> 1;
        bf16_t* WIN = (bf16_t*)(p.ws + WS_WIN); bf16_t* WOUT = (bf16_t*)(p.ws + WS_WOUT);
        if (next_fox) {
            const float* Wf = p.fox_w_in + (size_t)jn * 1024 * FOX_IN + 4096;
            for (int i = tid; i < 4096; i += 512) { const int k = i >> 2, q = i & 3; const f32x4 v = *(const f32x4*)(Wf + (size_t)k * FOX_IN + 4 * q);
                WfT[(4 * q + 0) * 1024 + k] = v[0]; WfT[(4 * q + 1) * 1024 + k] = v[1]; WfT[(4 * q + 2) * 1024 + k] = v[2]; WfT[(4 * q + 3) * 1024 + k] = v[3]; }
            __syncthreads();
            const float* W = p.fox_w_in + (size_t)jn * 1024 * FOX_IN; const float* Wo = p.fox_w_out + (size_t)jn * 1024 * 1024;
            for (int it = gw; it < 16 * 128 + 16 * 32; it += NGW) {
                if (it < 16 * 128) transpose_item(W, FOX_IN, WIN, scr, it / 128, it % 128, lane);
                else { const int r = it - 16 * 128; transpose_item(Wo, 1024, WOUT, scr, r / 32, r % 32, lane); }
            }
        } else {
            const float* W = p.rwkv_w_in + (size_t)jn * 1024 * RWKV_IN; const float* Wo = p.rwkv_w_out + (size_t)jn * 1024 * 1024;
            for (int it = gw; it < 16 * 132 + 16 * 32; it += NGW) {
                if (it < 16 * 132) transpose_item(W, RWKV_IN, WIN, scr, it / 132, it % 132, lane);
                else { const int r = it - 16 * 132; transpose_item(Wo, 1024, WOUT, scr, r / 32, r % 32, lane); }
            }
            for (int i = BID * 512 + tid; i < 16384; i += G * 512) *(u32x4*)(WIN + (size_t)4224 * 1024 + (size_t)i * 8) = (u32x4){0u, 0u, 0u, 0u};
        }
    }
    f32x4 gpo[4], gpr[4];
#pragma unroll
    for (int j = 0; j < 4; ++j) {
        gpo[j] = (MODE == 1) ? *((const f32x4*)(p.norm_post + (size_t)prev * 1024) + lane + 64 * j) : (f32x4){0.f, 0.f, 0.f, 0.f};
        gpr[j] = (next >= 0) ? *((const f32x4*)(p.norm_pre + (size_t)next * 1024) + lane + 64 * j) : (f32x4){0.f, 0.f, 0.f, 0.f};
    }
    const float bfv = (next_fox && lane < 16) ? p.fox_b_f[(next >> 1) * 16 + lane] : 0.f;
    f32x4 nv[4]; u32x2 nmw[4];
#define PE_ISSUE(mm) do { const int m_ = (mm); if (m_ < MROWS) { const int b_ = m_ / LP, t_ = m_ - b_ * LP; if (t_ < LSEQ) { \
        if (MODE == 0) { const float* src_ = (t_ < NMETA) ? p.meta + (size_t)t_ * 1024 : p.x + ((size_t)b_ * SEQ + (t_ - NMETA)) * 1024; \
            _Pragma("unroll") for (int j_ = 0; j_ < 4; ++j_) nv[j_] = *((const f32x4*)src_ + lane + 64 * j_); } \
        else { const float* hr_ = (prev == 0) ? ((t_ < NMETA) ? p.meta + (size_t)t_ * 1024 : p.x + ((size_t)b_ * SEQ + (t_ - NMETA)) * 1024)        \
                                       : ((t_ < NMETA) ? HMETA + (size_t)(b_ * NMETA + t_) * 1024 : p.out + ((size_t)b_ * SEQ + (t_ - NMETA)) * 1024); \
            _Pragma("unroll") for (int j_ = 0; j_ < 4; ++j_) { nv[j_] = *((const f32x4*)hr_ + lane + 64 * j_); nmw[j_] = *((const u32x2*)(MB + (size_t)m_ * 1024) + lane + 64 * j_); } } } } } while (0)
#pragma unroll
    for (int j = 0; j < 4; ++j) { nv[j] = (f32x4){0.f, 0.f, 0.f, 0.f}; nmw[j] = (u32x2){0u, 0u}; }
    PE_ISSUE(gw);
    for (int m = gw; m < MROWS; m += NGW) {
        const int b = m / LP, t = m - b * LP;
        f32x4 v[4]; u32x2 mw4[4];
#pragma unroll
        for (int j = 0; j < 4; ++j) { v[j] = nv[j]; mw4[j] = nmw[j]; }
        PE_ISSUE(m + NGW);
        if (t >= LSEQ) {
            if (next >= 0) { u32x2* o8 = (u32x2*)(U + (size_t)m * 1024) + lane;
#pragma unroll
                for (int j = 0; j < 4; ++j) o8[64 * j] = (u32x2){0u, 0u};
                if (next_fox && lane < 16) CUM[(size_t)m * 16 + lane] = 0.f; }
            continue;
        }
        float* hrow = (t < NMETA) ? HMETA + (size_t)(b * NMETA + t) * 1024 : p.out + ((size_t)b * SEQ + (t - NMETA)) * 1024;
        if (MODE == 1) {
            f32x4 mv[4]; float ss = 0.f;
#pragma unroll
            for (int j = 0; j < 4; ++j) { mv[j] = (f32x4){bflo(mw4[j].x), bfhi(mw4[j].x), bflo(mw4[j].y), bfhi(mw4[j].y)};
                ss += (mv[j][0] * mv[j][0] + mv[j][1] * mv[j][1]) + (mv[j][2] * mv[j][2] + mv[j][3] * mv[j][3]); }
            const float rs = __builtin_amdgcn_rsqf(wave_sum(ss) * (1.f / 1024.f) + NORM_EPS);
#pragma unroll
            for (int j = 0; j < 4; ++j) v[j] = v[j] + mv[j] * rs * gpo[j];
        }
        if (MODE == 1) {
#pragma unroll
            for (int j = 0; j < 4; ++j) *((f32x4*)hrow + lane + 64 * j) = v[j];
        }
        if (next >= 0) {
            float ss = 0.f;
#pragma unroll
            for (int j = 0; j < 4; ++j) ss += (v[j][0] * v[j][0] + v[j][1] * v[j][1]) + (v[j][2] * v[j][2] + v[j][3] * v[j][3]);
            const float rs = __builtin_amdgcn_rsqf(wave_sum(ss) * (1.f / 1024.f) + NORM_EPS);
            u32x2* o8 = (u32x2*)(U + (size_t)m * 1024) + lane;
#pragma unroll
            for (int j = 0; j < 4; ++j) { v[j] = v[j] * rs * gpr[j]; o8[64 * j] = (u32x2){pk2(v[j][0], v[j][1]), pk2(v[j][2], v[j][3])}; }
            if (next_fox) {
                float mine = 0.f;
#pragma unroll
                for (int hd = 0; hd < 16; ++hd) { float s = 0.f;
#pragma unroll
                    for (int j = 0; j < 4; ++j) { const f32x4 w = *((const LAS f32x4*)(WfT + hd * 1024) + lane + 64 * j); s += (v[j][0] * w[0] + v[j][1] * w[1]) + (v[j][2] * w[2] + v[j][3] * w[3]); }
                    s = wave_sum(s); if (lane == hd) mine = s; }
                if (lane < 16) { const float xp = (mine + bfv) * LOG2E; CUM[(size_t)m * 16 + lane] = fminf(xp, 0.f) - __builtin_amdgcn_logf(1.f + __builtin_amdgcn_exp2f(-fabsf(xp))); }
            }
        }
    }
}

#undef PE_ISSUE
__device__ __forceinline__ void phase_cumsum(const Params& p, LAS unsigned char* lds) {
    const int tid = opaque_tid(); LAS float* s = (LAS float*)lds;
    float* CUM = (float*)(p.ws + WS_CUM);
    for (int j = (GRD >= 256) ? BID - 128 : BID; j < 128; j += GRD) {
        if (j < 0) break;
        const int b = j >> 4, hd = j & 15; float* base = CUM + (size_t)b * LP * 16 + hd;
        float v[5]; float tot = 0.f;
#pragma unroll
        for (int e = 0; e < 5; ++e) { const int t = tid * 5 + e; v[e] = (t < LP) ? base[(size_t)t * 16] : 0.f; tot += v[e]; }
        s[tid] = tot; __syncthreads();
        for (int off = 1; off < 512; off <<= 1) { const float a = (tid >= off) ? s[tid - off] : 0.f; __syncthreads(); s[tid] += a; __syncthreads(); }
        float run = s[tid] - tot;
#pragma unroll
        for (int e = 0; e < 5; ++e) { const int t = tid * 5 + e; run += v[e]; if (t < LP) base[(size_t)t * 16] = run; }
        __syncthreads();
    }
}

__device__ __forceinline__ void phase_attn(const Params& p, LAS unsigned char* lds, unsigned* qctr) {
    const int tid = opaque_tid(), lane = tid & 63, wid = __builtin_amdgcn_readfirstlane(tid >> 6), r32 = lane & 31, hi = lane >> 5;
    LAS bf16_t* Ks = (LAS bf16_t*)lds;
    LAS bf16_t* Vs = Ks + 2 * 64 * 72;
    LAS float* cks = (LAS float*)(lds + 2 * 64 * 72 * 2 + 2 * 64 * 96 * 2);
    typedef short v4i16_t __attribute__((ext_vector_type(4)));
    const int vrd = (4 * hi + ((lane & 15) >> 2)) * 96 + 16 * ((lane >> 4) & 1) + 4 * (lane & 3);
    const bf16_t* P = (const bf16_t*)(p.ws + WS_C);
    const float* CUM = (const float*)(p.ws + WS_CUM);
    bf16_t* OG = (bf16_t*)(p.ws + WS_B);
    const int kr = tid >> 3, kc = tid & 7;
    volatile LAS unsigned* uslot = (volatile LAS unsigned*)(lds + LDS_BYTES - 32);
#define AT_BAR() do { asm volatile("s_waitcnt lgkmcnt(0)" ::: "memory"); __builtin_amdgcn_s_barrier(); asm volatile("" ::: "memory"); } while (0)
#define AT_STORE_K(buf, KR, CR) do { *(LAS u32x4*)(Ks + (buf) * 4608 + kr * 72 + kc * 8) = (KR); if (tid < 64) cks[(buf) * 64 + tid] = -(CR); } while (0)
#define AT_STORE_V(buf, VR) do { *(LAS u32x4*)(Vs + (buf) * 6144 + kr * 96 + kc * 8) = (VR); } while (0)
#define AT_QK(t, P0, P1) do { const LAS bf16_t* Kb_ = Ks + ((t) & 1) * 4608; const LAS float* cb_ = cks + ((t) & 1) * 64; \
        _Pragma("unroll") for (int i_ = 0; i_ < 4; ++i_) { const f32x4 c0_ = *(const LAS f32x4*)(cb_ + 8 * i_ + 4 * hi), c1_ = *(const LAS f32x4*)(cb_ + 32 + 8 * i_ + 4 * hi); \
            _Pragma("unroll") for (int e_ = 0; e_ < 4; ++e_) { P0[4 * i_ + e_] = c0_[e_] - m_run; P1[4 * i_ + e_] = c1_[e_] - m_run; } } \
        _Pragma("unroll") for (int d0_ = 0; d0_ < 4; ++d0_) { \
            const bf16x8 a0_ = *(const LAS bf16x8*)(Kb_ + r32 * 72 + d0_ * 16 + hi * 8), a1_ = *(const LAS bf16x8*)(Kb_ + (32 + r32) * 72 + d0_ * 16 + hi * 8); \
            P0 = __builtin_amdgcn_mfma_f32_32x32x16_bf16(a0_, qr[d0_], P0, 0, 0, 0); P1 = __builtin_amdgcn_mfma_f32_32x32x16_bf16(a1_, qr[d0_], P1, 0, 0, 0); } } while (0)
#define AT_PV(c, PX, B) do { u32x4 pw_; pw_.x = pk2(PX[B + 0], PX[B + 1]); pw_.y = pk2(PX[B + 2], PX[B + 3]); pw_.z = pk2(PX[B + 4], PX[B + 5]); pw_.w = pk2(PX[B + 6], PX[B + 7]); \
        const bf16x8 pf_ = __builtin_bit_cast(bf16x8, pw_); \
        {   const s16x4 lo_ = __builtin_bit_cast(s16x4, __builtin_amdgcn_ds_read_tr16_b64_v4i16((LAS v4i16_t*)(Vb_ + (16 * (c)) * 96))), h4_ = __builtin_bit_cast(s16x4, __builtin_amdgcn_ds_read_tr16_b64_v4i16((LAS v4i16_t*)(Vb_ + (16 * (c) + 8) * 96))); \
            const bf16x8 vf_ = (bf16x8){lo_[0], lo_[1], lo_[2], lo_[3], h4_[0], h4_[1], h4_[2], h4_[3]}; \
            o0 = __builtin_amdgcn_mfma_f32_32x32x16_bf16(vf_, pf_, o0, 0, 0, 0); } \
        {   const s16x4 lo_ = __builtin_bit_cast(s16x4, __builtin_amdgcn_ds_read_tr16_b64_v4i16((LAS v4i16_t*)(Vb_ + (16 * (c)) * 96 + 32))), h4_ = __builtin_bit_cast(s16x4, __builtin_amdgcn_ds_read_tr16_b64_v4i16((LAS v4i16_t*)(Vb_ + (16 * (c) + 8) * 96 + 32))); \
            const bf16x8 vf_ = (bf16x8){lo_[0], lo_[1], lo_[2], lo_[3], h4_[0], h4_[1], h4_[2], h4_[3]}; \
            o1 = __builtin_amdgcn_mfma_f32_32x32x16_bf16(vf_, pf_, o1, 0, 0, 0); } } while (0)
#define AT_TOFF(t) ((t) ? (long)(t) * 64 * 4096 : k0off)
#define AT_COFF(t) ((t) ? (long)(t) * 64 * 16 : c0off)
#define AT_STEP(i, PC0, PC1, PN0, PN1) do { const int i_ = (i), t_ = NT - 1 - i_; \
        if (t_ >= 2) { kreg = *(const u32x4*)(kg + AT_TOFF(t_ - 2)); if (tid < 64) creg = cgp[AT_COFF(t_ - 2)]; } \
        if (t_ >= 1) vreg = *(const u32x4*)(vg + AT_TOFF(t_ - 1)); \
        const bool need_next_ = active && (t_ >= 1) && (t_ - 1 <= jmax); \
        if (need_next_) AT_QK(i_ + 1, PN0, PN1); \
        __builtin_amdgcn_sched_barrier(0); \
        if (active && t_ <= jmax) { \
            const LAS bf16_t* Vb_ = Vs + (i_ & 1) * 6144 + vrd; \
            if (64 * t_ + 63 > qw0 || t_ == 0) { const int qpos_ = qw0 + r32; \
                _Pragma("unroll") for (int r = 0; r < 16; ++r) { const int kv_ = 64 * t_ + (r & 3) + 8 * (r >> 2) + 4 * hi; if (kv_ > qpos_ || kv_ < 48) PC0[r] = -INFINITY; if (kv_ + 32 > qpos_ || kv_ + 32 < 48) PC1[r] = -INFINITY; } } \
            float mxa_ = __builtin_fmaxf(__builtin_fmaxf(PC0[0], PC0[1]), PC1[0]), mxb_ = __builtin_fmaxf(__builtin_fmaxf(PC0[2], PC0[3]), PC1[1]); mxa_ = __builtin_fmaxf(__builtin_fmaxf(mxa_, PC1[2]), PC1[3]); \
            _Pragma("unroll") for (int r = 4; r < 16; r += 4) { mxa_ = __builtin_fmaxf(__builtin_fmaxf(mxa_, PC0[r]), PC0[r + 1]); mxb_ = __builtin_fmaxf(__builtin_fmaxf(mxb_, PC0[r + 2]), PC0[r + 3]); \
                mxa_ = __builtin_fmaxf(__builtin_fmaxf(mxa_, PC1[r]), PC1[r + 1]); mxb_ = __builtin_fmaxf(__builtin_fmaxf(mxb_, PC1[r + 2]), PC1[r + 3]); } \
            float mx_ = xhalf_max(__builtin_fmaxf(mxa_, mxb_)); \
              \
              \
            const bool first_ = (t_ == tfirst); \
            if (first_ || __any(mx_ > -30.f)) { \
            if (first_ || __any(mx_ > 8.f)) { const float dl_ = first_ ? ((mx_ > -1e30f) ? mx_ : 0.f) : fmaxf(mx_, 0.f); m_run += dl_; const float alpha_ = __builtin_amdgcn_exp2f(-dl_); l_run *= alpha_; \
                _Pragma("unroll") for (int r = 0; r < 16; ++r) { PC0[r] -= dl_; PC1[r] -= dl_; o0[r] *= alpha_; o1[r] *= alpha_; } \
                if (need_next_) { _Pragma("unroll") for (int r = 0; r < 16; ++r) { PN0[r] -= dl_; PN1[r] -= dl_; } } } \
            float sa_ = 0.f, sb_ = 0.f, sc_ = 0.f, sd_ = 0.f; \
            _Pragma("unroll") for (int r = 0; r < 16; r += 2) { PC0[r] = __builtin_amdgcn_exp2f(PC0[r]); PC1[r] = __builtin_amdgcn_exp2f(PC1[r]); PC0[r + 1] = __builtin_amdgcn_exp2f(PC0[r + 1]); PC1[r + 1] = __builtin_amdgcn_exp2f(PC1[r + 1]); \
                sa_ += PC0[r]; sb_ += PC1[r]; sc_ += PC0[r + 1]; sd_ += PC1[r + 1]; } \
            l_run += (sa_ + sb_) + (sc_ + sd_); \
            AT_PV(0, PC0, 0); AT_PV(1, PC0, 8); AT_PV(2, PC1, 0); AT_PV(3, PC1, 8); } } \
        if (t_ >= 2) AT_STORE_K(i_ & 1, kreg, creg); \
        if (t_ >= 1) AT_STORE_V((i_ + 1) & 1, vreg); \
        AT_BAR(); } while (0)
    for (;;) {
        if (tid == 0) *uslot = __hip_atomic_fetch_add(qctr, 1u, __ATOMIC_RELAXED, __HIP_MEMORY_SCOPE_AGENT);
        __syncthreads();
        const int u = (int)*uslot;
        if (u >= 1152) break;
        const bool metau = u >= 1024;
        const int qb = metau ? 0 : 7 - u / 128, bh = metau ? u - 1024 : u % 128, b = bh >> 4, h = bh & 15;
        const int q0 = metau ? 48 : 64 + qb * 256;
        const int NT = metau ? 1 : 5 + 4 * qb;
        const int qw0 = q0 + 32 * wid;
        const bool active = metau ? (wid == 0) : true;
        const int jmax = (qw0 + 31) >> 6;
        const int tfirst = (jmax < NT - 1) ? jmax : NT - 1;
        const size_t rowb = (size_t)b * LP;
        bf16x8 qr[4];
#pragma unroll
        for (int d0 = 0; d0 < 4; ++d0) qr[d0] = active ? *(const bf16x8*)(P + (rowb + qw0 - 48 + r32) * 4096 + h * 64 + d0 * 16 + hi * 8) : (bf16x8){0, 0, 0, 0, 0, 0, 0, 0};
        const long krow0 = (long)rowb + kr - 48, crow0 = (long)rowb + (tid & 63) - 48;
        const bf16_t* kg = P + krow0 * 4096 + 1024 + h * 64 + kc * 8;
        const bf16_t* vg = kg + 1024;
        const float* cgp = CUM + crow0 * 16 + h;
        const long k0off = (kr < 48) ? (long)(48 - kr) * 4096 : 0, c0off = ((tid & 63) < 48) ? (long)(48 - (tid & 63)) * 16 : 0;
        u32x4 kreg = (u32x4){0u, 0u, 0u, 0u}, vreg = kreg; float creg = 0.f;
        {   const u32x4 k0 = *(const u32x4*)(kg + AT_TOFF(NT - 1)), v0 = *(const u32x4*)(vg + AT_TOFF(NT - 1)); u32x4 k1 = k0; float c0 = 0.f, c1 = 0.f;
            if (NT >= 2) k1 = *(const u32x4*)(kg + AT_TOFF(NT - 2));
            if (tid < 64) { c0 = cgp[AT_COFF(NT - 1)]; if (NT >= 2) c1 = cgp[AT_COFF(NT - 2)]; }
            AT_STORE_K(0, k0, c0); AT_STORE_K(1, k1, c1); AT_STORE_V(0, v0); }
        AT_BAR();
        float m_run = 0.f, l_run = 0.f;
        f32x16 o0, o1, pa0, pa1, pb0, pb1;
#pragma unroll
        for (int r = 0; r < 16; ++r) { o0[r] = 0.f; o1[r] = 0.f; pa0[r] = 0.f; pa1[r] = 0.f; pb0[r] = 0.f; pb1[r] = 0.f; }
        if (active && NT - 1 <= jmax) AT_QK(0, pa0, pa1);
        for (int j = 0; j < NT; j += 2) {
            AT_STEP(j, pa0, pa1, pb0, pb1);
            if (j + 1 < NT) AT_STEP(j + 1, pb0, pb1, pa0, pa1);
        }
        if (active) {
            const float l = xhalf_sum(l_run); const float inv = 1.f / l;
            const size_t row = rowb + qw0 - 48 + r32;
            if (!metau || r32 < 16) {
#pragma unroll
            for (int dh = 0; dh < 2; ++dh)
#pragma unroll
                for (int i = 0; i < 4; ++i) {
                    const int dcol = h * 64 + 32 * dh + 8 * i + 4 * hi;
                    const u32x2 gw_ = *(const u32x2*)(P + row * 4096 + 3072 + dcol);
                    const float g0 = bflo(gw_.x), g1 = bfhi(gw_.x), g2 = bflo(gw_.y), g3 = bfhi(gw_.y);
                    const float a0 = (dh ? o1[4 * i + 0] : o0[4 * i + 0]) * inv, a1 = (dh ? o1[4 * i + 1] : o0[4 * i + 1]) * inv, a2 = (dh ? o1[4 * i + 2] : o0[4 * i + 2]) * inv, a3 = (dh ? o1[4 * i + 3] : o0[4 * i + 3]) * inv;
                    u32x2 w; w.x = pk2(a0 * g0 * sigmoidf_(g0), a1 * g1 * sigmoidf_(g1)); w.y = pk2(a2 * g2 * sigmoidf_(g2), a3 * g3 * sigmoidf_(g3));
                    *(u32x2*)(OG + row * 1024 + dcol) = w;
                }
            }
        }
    }
#undef AT_BAR
#undef AT_STORE_K
#undef AT_STORE_V
#undef AT_QK
#undef AT_PV
#undef AT_STEP
#undef AT_TOFF
#undef AT_COFF
}

__device__ __forceinline__ void phase_lora_prep(const Params& p, int jr) {
    const int tid = opaque_tid(); const int gt = BID * 512 + tid, NTH = GRD * 512;
    const bf16_t* PL = (const bf16_t*)(p.ws + WS_PL);
    bf16_t* A = (bf16_t*)(p.ws + WS_WIN); bf16_t* Bt = (bf16_t*)(p.ws + WS_CUM);
    const float* mu = p.rwkv_mu + (size_t)jr * RWKV_IN + 4096;
    const float* w_up = p.rwkv_w_up + (size_t)jr * 64 * 1024; const float* a_up = p.rwkv_a_up + (size_t)jr * 64 * 1024;
    for (int it = gt; it < MROWS * 32; it += NTH) {
        const int row = it >> 5, cg8 = it & 31;
        u32x4 o = (u32x4){0u, 0u, 0u, 0u};
        if (cg8 < 16) {
            const int tpos = row % LP;
            const u32x4 cw = *(const u32x4*)(PL + (size_t)row * 256 + 8 * cg8);
            u32x4 pw = (u32x4){0u, 0u, 0u, 0u}; if (tpos > 0) pw = *(const u32x4*)(PL + (size_t)(row - 1) * 256 + 8 * cg8);
            const f32x4 m0 = *(const f32x4*)(mu + 8 * cg8), m1 = *(const f32x4*)(mu + 8 * cg8 + 4);
            float v[8];
            v[0] = bflo(cw.x) + (bflo(pw.x) - bflo(cw.x)) * m0[0]; v[1] = bfhi(cw.x) + (bfhi(pw.x) - bfhi(cw.x)) * m0[1];
            v[2] = bflo(cw.y) + (bflo(pw.y) - bflo(cw.y)) * m0[2]; v[3] = bfhi(cw.y) + (bfhi(pw.y) - bfhi(cw.y)) * m0[3];
            v[4] = bflo(cw.z) + (bflo(pw.z) - bflo(cw.z)) * m1[0]; v[5] = bfhi(cw.z) + (bfhi(pw.z) - bfhi(cw.z)) * m1[1];
            v[6] = bflo(cw.w) + (bflo(pw.w) - bflo(cw.w)) * m1[2]; v[7] = bfhi(cw.w) + (bfhi(pw.w) - bfhi(cw.w)) * m1[3];
            if (cg8 < 8) {
#pragma unroll
                for (int e = 0; e < 8; ++e) v[e] = tanhf(v[e]);
            }
            o.x = pk2(v[0], v[1]); o.y = pk2(v[2], v[3]); o.z = pk2(v[4], v[5]); o.w = pk2(v[6], v[7]);
        }
        if (cg8 == 16) o.x = 0x3F803F80u;
        *(u32x4*)(A + (size_t)row * 256 + 8 * cg8) = o;
    }
    for (int it = gt; it < 2048 * 32; it += NTH) {
        const int n = it & 2047, kg = it >> 11;
        u32x4 o = (u32x4){0u, 0u, 0u, 0u};
        const float* src = nullptr;
        if (n < 1024 && kg < 8) src = w_up + (size_t)(8 * kg) * 1024 + n;
        else if (n >= 1024 && kg >= 8 && kg < 16) src = a_up + (size_t)(8 * (kg - 8)) * 1024 + (n - 1024);
        if (src) { o.x = pk2(src[0], src[1024]); o.y = pk2(src[2048], src[3072]); o.z = pk2(src[4096], src[5120]); o.w = pk2(src[6144], src[7168]); }
        if (kg == 16) { const float bz = (n < 1024) ? p.rwkv_w0[jr * 1024 + n] : p.rwkv_a0[jr * 1024 + n - 1024]; const float bh = bfhi(pk2(0.f, bz)); o.x = pk2(bh, bz - bh); }
        *(u32x4*)(Bt + (size_t)n * 256 + 8 * kg) = o;
    }
}

__device__ __forceinline__ void phase_scan(const Params& p, LAS unsigned char* lds, int jr) {
    const int tid = opaque_tid(), lane = tid & 63, wid = __builtin_amdgcn_readfirstlane(tid >> 6);
    LAS float* vec = (LAS float*)lds;
    LAS float* ypart = vec + 2 * 6144;
    const bf16_t* P = (const bf16_t*)(p.ws + WS_C);
    const bf16_t* LD = (const bf16_t*)(p.ws + WS_LD); const bf16_t* AA = (const bf16_t*)(p.ws + WS_AA);
    bf16_t* Y = (bf16_t*)(p.ws + WS_B);
    constexpr int NCH = 129;
    const int ht = tid & 255, ds = ht >> 4, kq = lane & 15, rl = lane >> 4;
    for (int u = BID; u < 256; u += GRD) {
        const int bh = u >> 1, half = u & 1, b = bh >> 4, h = bh & 15;
        const int kcol = h * 64 + 4 * kq;
        const float* mu = p.rwkv_mu + (size_t)jr * RWKV_IN;
        f32x4 mur, muk, muv, kk4, ka4, rk4;
        float* BON = (float*)(p.ws + WS_CUM);
        u32x2 rw, kw, vw, rp, kp_, vp, lw, lwp, aw; size_t drow = 0;
        if (wid >= 4) { mur = *(const f32x4*)(mu + kcol); muk = *(const f32x4*)(mu + 1024 + kcol); muv = *(const f32x4*)(mu + 2048 + kcol);
            kk4 = *(const f32x4*)(p.rwkv_k_k + jr * 1024 + kcol); ka4 = *(const f32x4*)(p.rwkv_k_a + jr * 1024 + kcol); rk4 = *(const f32x4*)(p.rwkv_r_k + jr * 1024 + kcol); }
#define SC_LOADRAW(ch) do { const int t_ = (ch) * 16 + ds; const size_t row_ = (size_t)b * LP + t_; drow = row_; const bf16_t* pr_ = P + row_ * 4096 + kcol; \
        rw = *(const u32x2*)pr_; kw = *(const u32x2*)(pr_ + 1024); vw = *(const u32x2*)(pr_ + 2048); \
        rp = (u32x2){0u, 0u}; kp_ = rp; vp = rp; lwp = rp; \
        if (ds > 0) lwp = *(const u32x2*)(LD + (row_ - 1) * 1024 + kcol); \
        if (t_ > 0) { rp = *(const u32x2*)(pr_ - 4096); kp_ = *(const u32x2*)(pr_ - 4096 + 1024); vp = *(const u32x2*)(pr_ - 4096 + 2048); } \
        lw = *(const u32x2*)(LD + row_ * 1024 + kcol); aw = *(const u32x2*)(AA + row_ * 1024 + kcol); } while (0)
#define SC_DERIVE(buf) do { \
        const f32x4 rc = {bflo(rw.x), bfhi(rw.x), bflo(rw.y), bfhi(rw.y)}, kc_ = {bflo(kw.x), bfhi(kw.x), bflo(kw.y), bfhi(kw.y)}, vc = {bflo(vw.x), bfhi(vw.x), bflo(vw.y), bfhi(vw.y)}; \
        const f32x4 rpv = {bflo(rp.x), bfhi(rp.x), bflo(rp.y), bfhi(rp.y)}, kpv = {bflo(kp_.x), bfhi(kp_.x), bflo(kp_.y), bfhi(kp_.y)}, vpv = {bflo(vp.x), bfhi(vp.x), bflo(vp.y), bfhi(vp.y)}; \
        const unsigned lx_ = lw.x, ly_ = lw.y, qx_ = lwp.x, qy_ = lwp.y;        \
        const pg8::f16x2_t l0_ = __builtin_bit_cast(pg8::f16x2_t, lx_), l1_ = __builtin_bit_cast(pg8::f16x2_t, ly_), q0_ = __builtin_bit_cast(pg8::f16x2_t, qx_), q1_ = __builtin_bit_cast(pg8::f16x2_t, qy_); \
        const f32x4 ldv = {(float)l0_[0], (float)l0_[1], (float)l1_[0], (float)l1_[1]}, ldp = {(float)q0_[0], (float)q0_[1], (float)q1_[0], (float)q1_[1]}, av = {bflo(aw.x), bfhi(aw.x), bflo(aw.y), bfhi(aw.y)}; \
        const f32x4 rlp = rc + (rpv - rc) * mur, klp = kc_ + (kpv - kc_) * muk, vlp = vc + (vpv - vc) * muv; \
        const f32x4 kkv = klp * kk4; \
        float ss = (kkv[0] * kkv[0] + kkv[1] * kkv[1]) + (kkv[2] * kkv[2] + kkv[3] * kkv[3]); \
        ss = red16(ss); \
        const float inv = __builtin_amdgcn_rsqf(fmaxf(ss, 1e-24f));        \
        const f32x4 kkn = kkv * inv; \
        const f32x4 kpr = klp * (1.f + (av - 1.f) * ka4); \
        { const f32x4 bt_ = rlp * kpr * rk4; const float bs_ = red16((bt_[0] + bt_[1]) + (bt_[2] + bt_[3])); if (half == 0 && kq == 0) BON[drow * 16 + h] = bs_; } \
        f32x4 wv, iw, wp; \
        _Pragma("unroll") for (int e_ = 0; e_ < 4; ++e_) { wv[e_] = __builtin_amdgcn_exp2f(ldv[e_]); iw[e_] = __builtin_amdgcn_exp2f(-ldv[e_]); wp[e_] = __builtin_amdgcn_exp2f(ldp[e_]); }     \
        LAS float* vs = vec + (buf) * 6144 + ds * 384 + 4 * kq; \
        *(LAS f32x4*)(vs) = wv; *(LAS f32x4*)(vs + 64) = -kkn * wp; *(LAS f32x4*)(vs + 128) = kkn * av * iw; *(LAS f32x4*)(vs + 192) = kpr * iw; *(LAS f32x4*)(vs + 256) = rlp * wv; *(LAS f32x4*)(vs + 320) = vlp; } while (0)
#define SC_YREDUCE(chunk, buf) do { float pa_ = 0.f, pb_ = 0.f; \
        _Pragma("unroll") for (int j_ = 0; j_ < 8; ++j_) { \
            const f32x4 x_ = *(const LAS f32x4*)(ypart + (buf) * 8192 + j_ * 1024 + (ht & ~15) * 4 + (((ht & 15) + 2 * j_) & 15) * 4); \
            pa_ += x_[0] + x_[2]; pb_ += x_[1] + x_[3]; } \
        { const int s_ = ht >> 4, cw_ = (ht >> 2) & 3, rl_ = ht & 3; \
          *(unsigned*)(Y + ((size_t)b * LP + (chunk) * 16 + s_) * 1024 + h * 64 + 32 * half + 8 * cw_ + 2 * rl_) = pk2(pa_, pb_); } } while (0)
        if (wid >= 4) { SC_LOADRAW(0); SC_DERIVE(0); SC_LOADRAW(1); }
        __syncthreads();
        float SA0 = 0.f, SA1 = 0.f, SA2 = 0.f, SA3 = 0.f, SB0 = 0.f, SB1 = 0.f, SB2 = 0.f, SB3 = 0.f;
        for (int ch = 0; ch < NCH; ++ch) {
            const int buf = ch & 1;
            if (wid < 4) {
                const LAS float* vb = vec + buf * 6144 + 4 * kq;
                const LAS float* vvp = vec + buf * 6144 + 320 + 32 * half + 8 * wid + 2 * rl;
                LAS float* yp = ypart + buf * 8192 + (kq >> 1) * 1024 + ((wid * 4 + rl + 2 * (kq >> 1)) & 15) * 4 + 2 * (kq & 1);
                const f32x4 wend = *(const LAS f32x4*)(vb + 15 * 384);
                f32x4 a4 = *(const LAS f32x4*)(vb + 64), b4 = *(const LAS f32x4*)(vb + 128), k4 = *(const LAS f32x4*)(vb + 192), r4 = *(const LAS f32x4*)(vb + 256);
                f32x2 vv = *(const LAS f32x2*)(vvp);
#pragma unroll
                for (int s = 0; s < 16; ++s) {
                    f32x4 na = a4, nb = b4, nk = k4, nr = r4; f32x2 nv = vv;
                    if (s < 15) { na = *(const LAS f32x4*)(vb + (s + 1) * 384 + 64); nb = *(const LAS f32x4*)(vb + (s + 1) * 384 + 128);
                        nk = *(const LAS f32x4*)(vb + (s + 1) * 384 + 192); nr = *(const LAS f32x4*)(vb + (s + 1) * 384 + 256); nv = *(const LAS f32x2*)(vvp + (s + 1) * 384); }
                    float saA, saB, yA, yB;
#define SC_DPP(r, c) "v_add_f32_dpp " r ", " r ", " r " " c " row_mask:0xf bank_mask:0xf bound_ctrl:1\n\t"
                    asm("v_mul_f32 %0, %2, %10\n\tv_mul_f32 %1, %6, %10\n\tv_fmac_f32 %0, %3, %11\n\tv_fmac_f32 %1, %7, %11\n\t"
                        "v_fmac_f32 %0, %4, %12\n\tv_fmac_f32 %1, %8, %12\n\tv_fmac_f32 %0, %5, %13\n\tv_fmac_f32 %1, %9, %13\n\t"
                        "v_fmac_f32 %2, %18, %14\n\tv_fmac_f32 %6, %19, %14\n\t"
                        SC_DPP("%0", "quad_perm:[1,0,3,2]") SC_DPP("%1", "quad_perm:[1,0,3,2]")
                        "v_fmac_f32 %3, %18, %15\n\tv_fmac_f32 %7, %19, %15\n\t"
                        SC_DPP("%0", "quad_perm:[2,3,0,1]") SC_DPP("%1", "quad_perm:[2,3,0,1]")
                        "v_fmac_f32 %4, %18, %16\n\tv_fmac_f32 %8, %19, %16\n\t"
                        SC_DPP("%0", "row_half_mirror") SC_DPP("%1", "row_half_mirror")
                        "v_fmac_f32 %5, %18, %17\n\tv_fmac_f32 %9, %19, %17\n\t"
                        SC_DPP("%0", "row_mirror") SC_DPP("%1", "row_mirror")
                        : "=&v"(saA), "=&v"(saB), "+v"(SA0), "+v"(SA1), "+v"(SA2), "+v"(SA3), "+v"(SB0), "+v"(SB1), "+v"(SB2), "+v"(SB3)
                        : "v"(a4[0]), "v"(a4[1]), "v"(a4[2]), "v"(a4[3]), "v"(k4[0]), "v"(k4[1]), "v"(k4[2]), "v"(k4[3]), "v"(vv[0]), "v"(vv[1]));
                    asm("v_fmac_f32 %0, %10, %12\n\tv_fmac_f32 %4, %11, %12\n\tv_fmac_f32 %1, %10, %13\n\tv_fmac_f32 %5, %11, %13\n\t"
                        "v_fmac_f32 %2, %10, %14\n\tv_fmac_f32 %6, %11, %14\n\tv_fmac_f32 %3, %10, %15\n\tv_fmac_f32 %7, %11, %15\n\t"
                        "v_mul_f32 %8, %0, %16\n\tv_mul_f32 %9, %4, %16\n\tv_fmac_f32 %8, %1, %17\n\tv_fmac_f32 %9, %5, %17\n\t"
                        "v_fmac_f32 %8, %2, %18\n\tv_fmac_f32 %9, %6, %18\n\tv_fmac_f32 %8, %3, %19\n\tv_fmac_f32 %9, %7, %19"
                        : "+v"(SA0), "+v"(SA1), "+v"(SA2), "+v"(SA3), "+v"(SB0), "+v"(SB1), "+v"(SB2), "+v"(SB3), "=&v"(yA), "=&v"(yB)
                        : "v"(saA), "v"(saB), "v"(b4[0]), "v"(b4[1]), "v"(b4[2]), "v"(b4[3]), "v"(r4[0]), "v"(r4[1]), "v"(r4[2]), "v"(r4[3]));
#undef SC_DPP
                    *(LAS f32x2*)(yp + s * 64) = (f32x2){yA, yB};
                    a4 = na; b4 = nb; k4 = nk; r4 = nr; vv = nv;
                }
                {
                    SA0 *= wend[0]; SA1 *= wend[1]; SA2 *= wend[2]; SA3 *= wend[3]; SB0 *= wend[0]; SB1 *= wend[1]; SB2 *= wend[2]; SB3 *= wend[3]; }
            } else {
                if (ch + 1 < NCH) SC_DERIVE(buf ^ 1);
                if (ch + 2 < NCH) SC_LOADRAW(ch + 2);
                if (ch > 0) SC_YREDUCE(ch - 1, buf ^ 1);
            }
            asm volatile("s_waitcnt lgkmcnt(0)" ::: "memory"); __builtin_amdgcn_s_barrier(); asm volatile("" ::: "memory");
        }
        if (wid >= 4) SC_YREDUCE(NCH - 1, (NCH - 1) & 1);
        __syncthreads();
#undef SC_LOADRAW
#undef SC_DERIVE
#undef SC_YREDUCE
    }
}

__device__ __forceinline__ void phase_r4(const Params& p, int jr) {
    const int tid = opaque_tid(), lane = tid & 63, wave = __builtin_amdgcn_readfirstlane(tid >> 6);
    const int gw = BID * 8 + wave, NGW = GRD * 8;
    const bf16_t* P = (const bf16_t*)(p.ws + WS_C); const bf16_t* Y = (const bf16_t*)(p.ws + WS_B);
    const float* BON = (const float*)(p.ws + WS_CUM);
    bf16_t* YG = (bf16_t*)(p.ws + WS_LD);
    const float* mu = p.rwkv_mu + (size_t)jr * RWKV_IN;
    for (int it = gw; it < 2048; it += NGW) {
        const int tile = it >> 2, q = it & 3, c = 256 * q + 4 * lane, hd = 4 * q + (lane >> 4);
        const f32x4 muv = *(const f32x4*)(mu + 2048 + c), mug = *(const f32x4*)(mu + 3072 + c);
        const f32x4 lnw = *(const f32x4*)(p.rwkv_ln_w + jr * 1024 + c), lnb = *(const f32x4*)(p.rwkv_ln_b + jr * 1024 + c);
        const int m0 = tile * 33;
        f32x4 vp = {0.f, 0.f, 0.f, 0.f}, gp = vp;
        if (m0 % LP != 0) { const bf16_t* pr = P + (size_t)(m0 - 1) * 4096 + c;
            const u32x2 c2 = *(const u32x2*)(pr + 2048), d2 = *(const u32x2*)(pr + 3072);
            vp = (f32x4){bflo(c2.x), bfhi(c2.x), bflo(c2.y), bfhi(c2.y)}; gp = (f32x4){bflo(d2.x), bfhi(d2.x), bflo(d2.y), bfhi(d2.y)}; }
        u32x2 c2a, d2a, ywa, c2b, d2b, ywb, c2c, d2c, ywc; float bona, bonb, bonc;
#define R4_LOAD(C2, D2, YW, BN, i_) do { const size_t rr_ = (size_t)(m0 + ((i_) < 33 ? (i_) : 32)); const bf16_t* pr_ = P + rr_ * 4096 + c; \
        C2 = *(const u32x2*)(pr_ + 2048); D2 = *(const u32x2*)(pr_ + 3072); YW = *(const u32x2*)(Y + rr_ * 1024 + c); BN = BON[rr_ * 16 + hd]; } while (0)
#define R4_COMP(C2, D2, YW, BN, i_) do { const size_t row = (size_t)(m0 + (i_)); \
        const f32x4 vc = {bflo(C2.x), bfhi(C2.x), bflo(C2.y), bfhi(C2.y)}, gc = {bflo(D2.x), bfhi(D2.x), bflo(D2.y), bfhi(D2.y)}; \
        const f32x4 yv = {bflo(YW.x), bfhi(YW.x), bflo(YW.y), bfhi(YW.y)}; \
        const f32x4 vl = vc + (vp - vc) * muv, gl = gc + (gp - gc) * mug; \
        vp = vc; gp = gc; \
        const float mean = red16((yv[0] + yv[1]) + (yv[2] + yv[3])) * (1.f / 64.f); \
        const f32x4 d = yv - mean; \
        const float var = red16((d[0] * d[0] + d[1] * d[1]) + (d[2] * d[2] + d[3] * d[3])) * (1.f / 64.f); \
        const float rstd = __builtin_amdgcn_rsqf(var + GN_EPS); \
        const f32x4 o = (d * rstd * lnw + lnb) + BN * vl; \
        u32x2 w; w.x = pk2(o[0] * gl[0] * sigmoidf_(gl[0]), o[1] * gl[1] * sigmoidf_(gl[1])); w.y = pk2(o[2] * gl[2] * sigmoidf_(gl[2]), o[3] * gl[3] * sigmoidf_(gl[3])); \
        *(u32x2*)(YG + row * 1024 + c) = w; } while (0)
        R4_LOAD(c2a, d2a, ywa, bona, 0); R4_LOAD(c2b, d2b, ywb, bonb, 1);
#pragma unroll 1
        for (int i = 0; i < 33; i += 3) {
            R4_LOAD(c2c, d2c, ywc, bonc, i + 2); R4_COMP(c2a, d2a, ywa, bona, i);
            R4_LOAD(c2a, d2a, ywa, bona, i + 3); R4_COMP(c2b, d2b, ywb, bonb, i + 1);
            R4_LOAD(c2b, d2b, ywb, bonb, i + 4); R4_COMP(c2c, d2c, ywc, bonc, i + 2);
        }
#undef R4_LOAD
#undef R4_COMP
    }
}

__device__ __forceinline__ void mini_gemm_tail(const bf16_t* A, const bf16_t* Wt, bf16_t* O, LAS unsigned char* lds) {
    const int tid = opaque_tid(), lane = tid & 63, w = tid >> 6, wr = w >> 2, wc = w & 3;
    LAS bf16_t* As = (LAS bf16_t*)lds;
    LAS bf16_t* Bs = As + 32 * 520;
    for (int t = BID; t < 256; t += GRD) {
        const int r0 = 16384 + 32 * (t >> 4), c0 = 64 * (t & 15);
        u32x4 stg[12];
#define MT_LOAD(h) do { _Pragma("unroll") for (int j_ = 0; j_ < 12; ++j_) { const int c_ = tid + 512 * j_; \
            const bf16_t* src_ = (c_ < 2048) ? A + (size_t)(r0 + (c_ >> 6)) * 1024 + 512 * (h) + 8 * (c_ & 63) : Wt + (size_t)(c0 + ((c_ - 2048) >> 6)) * 1024 + 512 * (h) + 8 * (c_ & 63); \
            stg[j_] = *(const u32x4*)src_; } } while (0)
#define MT_STORE() do { _Pragma("unroll") for (int j_ = 0; j_ < 12; ++j_) { const int c_ = tid + 512 * j_; \
            LAS bf16_t* dst_ = (c_ < 2048) ? As + (c_ >> 6) * 520 + 8 * (c_ & 63) : Bs + ((c_ - 2048) >> 6) * 520 + 8 * (c_ & 63); \
            *(LAS u32x4*)dst_ = stg[j_]; } } while (0)
        f32x4 acc = {0.f, 0.f, 0.f, 0.f};
        const LAS bf16_t* ap = As + (16 * wr + (lane & 15)) * 520 + 8 * (lane >> 4);
        const LAS bf16_t* bp = Bs + (16 * wc + (lane & 15)) * 520 + 8 * (lane >> 4);
        MT_LOAD(0); MT_STORE(); __syncthreads();
        MT_LOAD(1);
#pragma unroll
        for (int k = 0; k < 16; ++k) { const bf16x8 a = *(const LAS bf16x8*)(ap + 32 * k), b = *(const LAS bf16x8*)(bp + 32 * k); acc = __builtin_amdgcn_mfma_f32_16x16x32_bf16(a, b, acc, 0, 0, 0); }
        __syncthreads();
        MT_STORE(); __syncthreads();
#pragma unroll
        for (int k = 0; k < 16; ++k) { const bf16x8 a = *(const LAS bf16x8*)(ap + 32 * k), b = *(const LAS bf16x8*)(bp + 32 * k); acc = __builtin_amdgcn_mfma_f32_16x16x32_bf16(a, b, acc, 0, 0, 0); }
        __syncthreads();
#undef MT_LOAD
#undef MT_STORE
        bf16_t* op = O + (size_t)(r0 + 16 * wr + 4 * (lane >> 4)) * 1024 + c0 + 16 * wc + (lane & 15);
#pragma unroll
        for (int r = 0; r < 4; ++r) op[(size_t)r * 1024] = (bf16_t)(pk2(acc[r], 0.f) & 0xffffu);
    }
}

#define XB_TMO      128
#define XB_XCNT(j)  (256  + 64 * (j))
#define XB_XSUB(j)  (1280 + 64 * (j))
#define XB_XGEN(j)  (2304 + 64 * (j))
#define XB_TOP      3328
#define XB_TOPGEN   3392
#define XCD_BAR_WORDS 3456
#define XB_SPIN_CAP (1u << 18)

__device__ __forceinline__ unsigned xb_ld(unsigned* p)              { return __hip_atomic_load(p, __ATOMIC_RELAXED, __HIP_MEMORY_SCOPE_AGENT); }
__device__ __forceinline__ unsigned xb_add(unsigned* p, unsigned v) { return __hip_atomic_fetch_add(p, v, __ATOMIC_RELAXED, __HIP_MEMORY_SCOPE_AGENT); }
__device__ __forceinline__ unsigned xb_xcc_id() { return (unsigned)__builtin_amdgcn_s_getreg((3 << 11) | 20) & 0xFu; }
#define XB_SPIN(cond, bar) do { unsigned _sp = 0; while (cond) { __builtin_amdgcn_s_sleep(1); \
    if ((++_sp & 255u) == 0u) { if (xb_ld(&(bar)[XB_TMO])) break; if (_sp > XB_SPIN_CAP) { atomicAdd(&(bar)[XB_TMO], 1u); break; } } } } while (0)

struct XcdBarrier {
    unsigned* bar; unsigned x;
    volatile LAS unsigned* st;
};

__device__ __forceinline__ XcdBarrier xcd_barrier_post(unsigned* bar, volatile LAS unsigned* st) {
    XcdBarrier b; b.bar = bar; b.x = xb_xcc_id(); b.st = st;
    if (threadIdx.x == 0) (void)xb_add(&bar[XB_XCNT(b.x)], 1u);
    return b;
}
__device__ __forceinline__ void xcd_barrier_complete(unsigned* bar, unsigned x, unsigned& nloc, unsigned& nx) {
    const unsigned G = gridDim.x * gridDim.y * gridDim.z;
    unsigned sum, cnt, mine, sp = 0u;
    for (;;) {
        sum = 0u; cnt = 0u; mine = 0u;
#pragma unroll
        for (unsigned j = 0; j < 16; ++j) { const unsigned c = xb_ld(&bar[XB_XCNT(j)]); sum += c; cnt += (c > 0u) ? 1u : 0u; mine = (j == x) ? c : mine; }
        if (sum == G) break;
        __builtin_amdgcn_s_sleep(1);
        if ((++sp & 255u) == 0u) { if (xb_ld(&bar[XB_TMO])) break; if (sp > XB_SPIN_CAP) { atomicAdd(&bar[XB_TMO], 1u); break; } }
    }
    nloc = mine > 0u ? mine : 1u; nx = cnt > 0u ? cnt : 1u;
}

__device__ __forceinline__ void xcd_barrier(const XcdBarrier& b) {
    asm volatile("s_waitcnt vmcnt(0)" ::: "memory");
    __syncthreads();
    if (threadIdx.x == 0) {
        unsigned* bar = b.bar;
        __builtin_amdgcn_s_waitcnt(0);
        unsigned nloc = b.st[0], nx = b.st[1];
        if (nloc == 0u) { xcd_barrier_complete(bar, b.x, nloc, nx); b.st[0] = nloc; b.st[1] = nx; }
        const unsigned old = xb_add(&bar[XB_XSUB(b.x)], 1u);
        const unsigned gen = old / nloc;
        if (old + 1u == (gen + 1u) * nloc) {
            __builtin_amdgcn_fence(__ATOMIC_RELEASE, "agent");
            asm volatile("s_waitcnt vmcnt(0)" ::: "memory");
            const unsigned og = xb_add(&bar[XB_TOP], 1u);
            const unsigned tg = og / nx;
            if (og + 1u == (tg + 1u) * nx) xb_add(&bar[XB_TOPGEN], 1u);
            else XB_SPIN(xb_ld(&bar[XB_TOPGEN]) == tg, bar);
            __builtin_amdgcn_fence(__ATOMIC_ACQUIRE, "agent");
            xb_add(&bar[XB_XGEN(b.x)], 1u);
            asm volatile("s_waitcnt vmcnt(0)" ::: "memory");
        } else {
            XB_SPIN(xb_ld(&bar[XB_XGEN(b.x)]) == gen, bar);
            __builtin_amdgcn_fence(__ATOMIC_ACQUIRE, "agent");
            asm volatile("s_waitcnt vmcnt(0)" ::: "memory");
        }
    }
    __syncthreads();
}

__global__ void __launch_bounds__(512, 2) fwd_megakernel(Params p) {
    extern __shared__ __attribute__((aligned(16))) unsigned char lds_raw[];
    LAS unsigned char* lds = (LAS unsigned char*)lds_raw;
    cg::grid_group grid = cg::this_grid();
    bf16_t* U = (bf16_t*)(p.ws + WS_B); bf16_t* WIN = (bf16_t*)(p.ws + WS_WIN); bf16_t* WOUT = (bf16_t*)(p.ws + WS_WOUT);
    bf16_t* P = (bf16_t*)(p.ws + WS_C); bf16_t* PL = (bf16_t*)(p.ws + WS_PL); float* MB = (float*)(p.ws + WS_C);
    volatile LAS unsigned* st = (volatile LAS unsigned*)(lds + LDS_BYTES - 64);
    if (threadIdx.x < 2) st[threadIdx.x] = 0u;
    __syncthreads();
    XcdBarrier bar = xcd_barrier_post((unsigned*)p.ws + 4096, st);
#define GBAR() do { XcdBarrier bb_ = bar; asm volatile("" : "+s"(bb_.x)); xcd_barrier(bb_); } while (0)
    phase_e<0>(p, lds, 0, -1);
    if (p.out == nullptr) grid.sync();
    GBAR();
#pragma unroll 1
    for (int layer = 0; layer < 4; ++layer) {
        const int jr = layer >> 1; const bool rw = (layer & 1) != 0;
        if (!rw) phase_cumsum(p, lds);
        {   pg8::Gemm g{U, WIN, MROWS, rw ? 4352 : 4096, 1024}; pg8::StaticOrder S; S.init(MROWS, rw ? 4352 : 4096, (int)GRD, (int)BID);
            pg8::EpiP E{P, PL, rw ? 1.f : 0.125f * LOG2E, rw ? 0 : 1024};
            pg8::gemm_phase<pg8::EpiP, pg8::StaticOrder, true, true>(lds, g, S, E); }
        GBAR();
        if (!rw) { phase_attn(p, lds, (unsigned*)p.ws + 8192 + 64 * jr); GBAR(); }
        else { phase_lora_prep(p, jr); GBAR();
            {   int kl_ = 256; asm volatile("" : "+s"(kl_));
                pg8::Gemm g{(const bf16_t*)(p.ws + WS_WIN), (const bf16_t*)(p.ws + WS_CUM), MROWS, 2048, kl_}; pg8::StaticOrder S; S.init(MROWS, 2048, (int)GRD, (int)BID);
                pg8::EpiLora E{(bf16_t*)(p.ws + WS_LD), (bf16_t*)(p.ws + WS_AA)};
                pg8::gemm_phase<pg8::EpiLora, pg8::StaticOrder, true, true>(lds, g, S, E); }
            GBAR(); phase_scan(p, lds, jr); GBAR(); phase_r4(p, jr); GBAR(); }
        {   pg8::Gemm g{rw ? (const bf16_t*)(p.ws + WS_LD) : (const bf16_t*)(p.ws + WS_B), WOUT, 16384, 1024, 1024}; pg8::StaticOrder S; S.init(16384, 1024, (int)GRD, (int)BID);
            pg8::EpiM E{(bf16_t*)MB};
            pg8::gemm_phase<pg8::EpiM, pg8::StaticOrder, true, true>(lds, g, S, E);
            mini_gemm_tail(g.A, WOUT, (bf16_t*)MB, lds); }
        GBAR();
        phase_e<1>(p, lds, layer < 3 ? layer + 1 : -1, layer);
        if (layer < 3) GBAR();
    }
}

extern "C" void kernel_launch(void* const* d_in, const int* in_sizes, int n_in, void* d_out, int out_size, void* d_ws, size_t ws_size, hipStream_t stream) {
    static int grid_blocks = 0;
    if (grid_blocks == 0) {
        if (n_in != 19 || ws_size < WS_END) { fprintf(stderr, "kernel_launch: unexpected inputs (n_in %d, ws %zu)\n", n_in, ws_size); grid_blocks = -1; return; }
        int dev = 0, cus = 0, per_cu = 0;
        hipGetDevice(&dev); hipDeviceGetAttribute(&cus, hipDeviceAttributeMultiprocessorCount, dev);
        if (hipFuncSetAttribute((const void*)fwd_megakernel, hipFuncAttributeMaxDynamicSharedMemorySize, LDS_BYTES) != hipSuccess) { fprintf(stderr, "kernel_launch: hipFuncSetAttribute failed\n"); grid_blocks = -1; return; }
        if (hipOccupancyMaxActiveBlocksPerMultiprocessor(&per_cu, (const void*)fwd_megakernel, 512, LDS_BYTES) != hipSuccess || per_cu < 1) { fprintf(stderr, "kernel_launch: occupancy query failed (%d)\n", per_cu); (void)hipGetLastError(); grid_blocks = -1; return; }
        grid_blocks = cus * (per_cu > 1 ? 1 : per_cu);
    }
    if (grid_blocks < 0) return;
    if (hipMemsetAsync(d_ws, 0, 65536, stream) != hipSuccess) { fprintf(stderr, "kernel_launch: memset failed\n"); return; }
    Params p{};
    const float** f = (const float**)&p;
    for (int i = 0; i < 19; ++i) f[i] = (const float*)d_in[i];
    p.out = (float*)d_out; p.ws = (unsigned char*)d_ws;
    void* args[] = {&p};
    hipError_t e = hipLaunchCooperativeKernel((const void*)fwd_megakernel, dim3(grid_blocks), dim3(512), args, LDS_BYTES, stream);
    if (e != hipSuccess) fprintf(stderr, "cooperative launch failed: %s (grid %d)\n", hipGetErrorString(e), grid_blocks);
}
```
